# Optimizing an MI355X kernel written in HIP

```python
import jax
import jax.numpy as jnp
from jax import lax
import numpy as np

D_MODEL = 2048
BATCH = 2
SEQ = 4096
DEPTH = 2

GRID_W = 64
CTX_LEN = 256
NORM_EPS = 1e-6

RWKV_HEAD_DIM = 64
RWKV_WIDTH = D_MODEL // 2
RWKV_HEADS = RWKV_WIDTH // RWKV_HEAD_DIM
DECAY_LORA = 64
ICLR_LORA = 64
GATE_LORA = 128
RWKV_GN_EPS = 64e-5
RWKV_COLS = 3 * RWKV_WIDTH + 2 * DECAY_LORA + 2 * ICLR_LORA + GATE_LORA

NA_HEAD_DIM = 64
NA_WIDTH = D_MODEL - RWKV_WIDTH
NA_HEADS = NA_WIDTH // NA_HEAD_DIM
NA_KH_MAX = 8
NA_KW = 16
L0_IN_COLS = RWKV_COLS + 3 * NA_WIDTH

GLA_HEADS = 4
GLA_KEY_WIDTH = D_MODEL // 2
GLA_VAL_WIDTH = D_MODEL
GLA_DK = GLA_KEY_WIDTH // GLA_HEADS
GLA_DV = GLA_VAL_WIDTH // GLA_HEADS
GLA_GATE_RANK = 16
GLA_GATE_NORMALIZER = 16.0
GLA_CHUNK = 64
GLA_STATE_COLS = GLA_KEY_WIDTH + GLA_VAL_WIDTH + 2 * GLA_GATE_RANK
L1_IN_COLS = GLA_STATE_COLS + GLA_KEY_WIDTH + GLA_VAL_WIDTH

FFN_DIM = 5632
N_EXPERTS = 8
TOP_K = 2
EXPERT_DIM = 7168

kernel_name = 'hybrid_rwkv7_natten_gla_moe_dit_block'


def rms_norm(x, gain):
    xf = x.astype(jnp.float32)
    y = xf * lax.rsqrt(jnp.mean(xf * xf, axis=-1, keepdims=True) + NORM_EPS)
    return (y * gain.astype(jnp.float32)).astype(x.dtype)


def adaln(cond, w_mod, b_mod):
    return jnp.split(jax.nn.silu(cond) @ w_mod + b_mod, 6, axis=-1)


def modulate(h, shift, scale):
    return h * (1 + scale) + shift


def swiglu(h, w_gate, w_up, w_down):
    return (jax.nn.silu(h @ w_gate) * (h @ w_up)) @ w_down


def bidir_token_shift(p, mu):
    prev = jnp.pad(p[:, :-1], ((0, 0), (1, 0), (0, 0)))
    nxt = jnp.pad(p[:, 1:], ((0, 0), (0, 1), (0, 0)))
    return p + mu * (0.5 * (prev + nxt) - p)


def rwkv7_prepare(pr, decay_w0, decay_w2, iclr_a0, iclr_a2, gate_g2, k_k, k_a):
    B, T, _ = pr.shape
    W = RWKV_WIDTH

    def heads(t):
        return t.reshape(B, T, RWKV_HEADS, RWKV_HEAD_DIM)

    r, k, v = pr[..., :W], pr[..., W:2 * W], pr[..., 2 * W:3 * W]
    o = 3 * W
    dec_in = (pr[..., o:o + DECAY_LORA], pr[..., o + DECAY_LORA:o + 2 * DECAY_LORA])
    o += 2 * DECAY_LORA
    icl_in = (pr[..., o:o + ICLR_LORA], pr[..., o + ICLR_LORA:o + 2 * ICLR_LORA])
    o += 2 * ICLR_LORA
    g = jax.nn.sigmoid(pr[..., o:o + GATE_LORA]) @ gate_g2
    kk = heads(k * k_k).astype(jnp.float32)
    kk = kk * lax.rsqrt(jnp.sum(kk * kk, axis=-1, keepdims=True) + 1e-12)
    dirs = []
    for d in range(2):
        w_log = -jax.nn.softplus(-(decay_w0[d] + jnp.tanh(dec_in[d]) @ decay_w2[d])) - 0.5
        decay = jnp.exp(-jnp.exp(w_log.astype(jnp.float32)))
        a = jax.nn.sigmoid(iclr_a0[d] + icl_in[d] @ iclr_a2[d])
        k_d = k * (1 + (a - 1) * k_a)
        dirs.append((heads(decay), heads(k_d), heads(a)))
    return heads(r), heads(v), kk, g, dirs


def rwkv7_scan(r, decay, k, v, kk, a, s0, reverse):
    def step(S, inp):
        r_t, w_t, k_t, v_t, kk_t, a_t = inp
        sa = jnp.einsum('bhvk,bhk->bhv', S, -kk_t)
        S = (S * w_t[:, :, None, :] + sa[..., None] * (kk_t * a_t)[:, :, None, :]
             + v_t[..., None] * k_t[:, :, None, :])
        return S, jnp.einsum('bhvk,bhk->bhv', S, r_t)

    xs = tuple(jnp.moveaxis(t.astype(jnp.float32), 1, 0) for t in (r, decay, k, v, kk, a))
    s_final, ys = lax.scan(step, s0, xs, reverse=reverse)
    return jnp.moveaxis(ys, 0, 1), s_final


def rwkv7_output(y, r, k_bonus, v, g, r_k, lnx_g, lnx_b):
    B, T, H, N = y.shape
    mu = jnp.mean(y, axis=-1, keepdims=True)
    var = jnp.mean(jnp.square(y - mu), axis=-1, keepdims=True)
    yn = ((y - mu) * lax.rsqrt(var + RWKV_GN_EPS)).astype(r.dtype).reshape(B, T, H * N)
    yn = yn * lnx_g + lnx_b
    bonus = (jnp.sum(r * k_bonus * r_k, axis=-1, keepdims=True) * v).reshape(B, T, H * N)
    return (yn + bonus) * g


def rwkv7_group(pr_l, pr_c, decay_w0, decay_w2, iclr_a0, iclr_a2, gate_g2, k_k, k_a, r_k, lnx_g, lnx_b):
    lora = (decay_w0, decay_w2, iclr_a0, iclr_a2, gate_g2, k_k, k_a)
    r_l, v_l, kk_l, g_l, dirs_l = rwkv7_prepare(pr_l, *lora)
    r_c, v_c, kk_c, g_c, dirs_c = rwkv7_prepare(pr_c, *lora)
    B = pr_l.shape[0]
    y_l = 0.0
    y_c = 0.0
    for d, reverse in enumerate((False, True)):
        s0 = jnp.zeros((B, RWKV_HEADS, RWKV_HEAD_DIM, RWKV_HEAD_DIM), jnp.float32)
        dec_c, k_dc, a_c = dirs_c[d]
        yc, s_ctx = rwkv7_scan(r_c, dec_c, k_dc, v_c, kk_c, a_c, s0, reverse)
        dec_l, k_dl, a_l = dirs_l[d]
        yl, _ = rwkv7_scan(r_l, dec_l, k_dl, v_l, kk_l, a_l, s_ctx, reverse)
        y_c = y_c + yc
        y_l = y_l + yl
    out_l = rwkv7_output(y_l, r_l, 0.5 * (dirs_l[0][1] + dirs_l[1][1]), v_l, g_l, r_k, lnx_g, lnx_b)
    out_c = rwkv7_output(y_c, r_c, 0.5 * (dirs_c[0][1] + dirs_c[1][1]), v_c, g_c, r_k, lnx_g, lnx_b)
    return out_l, out_c


def na_qkv(p, q_norm, k_norm):
    B, T, _ = p.shape
    q, k, v = jnp.split(p, 3, axis=-1)
    sh = (B, T, NA_HEADS, NA_HEAD_DIM)
    return rms_norm(q.reshape(sh), q_norm), rms_norm(k.reshape(sh), k_norm), v.reshape(sh)


def neighbourhood_attention(q, k, v, k_ctx, v_ctx, rpb):
    B, T, H, N = q.shape
    rows = T // GRID_W
    kh = min(NA_KH_MAX, rows)
    kw = min(NA_KW, GRID_W)
    scale = N ** -0.5
    qg = q.reshape(B, rows, GRID_W, H, N)
    kg = k.reshape(B, rows, GRID_W, H, N)
    vg = v.reshape(B, rows, GRID_W, H, N)
    row_start = jnp.clip(jnp.arange(rows) - kh // 2, 0, rows - kh)
    col_pos = jnp.arange(GRID_W)
    col_idx = jnp.clip(col_pos - kw // 2, 0, GRID_W - kw)[:, None] + jnp.arange(kw)[None, :]
    col_bias_idx = col_idx - col_pos[:, None] + NA_KW - 1

    def one_row(args):
        q_row, r, r0 = args
        k_band = lax.dynamic_slice_in_dim(kg, r0, kh, axis=1)
        v_band = lax.dynamic_slice_in_dim(vg, r0, kh, axis=1)
        k_win = k_band[:, :, col_idx]
        v_win = v_band[:, :, col_idx]
        row_bias_idx = r0 + jnp.arange(kh) - r + NA_KH_MAX - 1
        bias = rpb[:, row_bias_idx[:, None, None], col_bias_idx[None, :, :]]
        s_win = (jnp.einsum('bqhn,biqjhn->bhqij', q_row, k_win).astype(jnp.float32) * scale
                 + bias.transpose(0, 2, 1, 3).astype(jnp.float32)[None])
        s_ctx = jnp.einsum('bqhn,bchn->bhqc', q_row, k_ctx).astype(jnp.float32) * scale
        s = jnp.concatenate([s_win.reshape(B, H, GRID_W, kh * kw), s_ctx], axis=-1)
        p = jax.nn.softmax(s, axis=-1).astype(v.dtype)
        p_win = p[..., :kh * kw].reshape(B, H, GRID_W, kh, kw)
        p_ctx = p[..., kh * kw:]
        return (jnp.einsum('bhqij,biqjhn->bqhn', p_win, v_win)
                + jnp.einsum('bhqc,bchn->bqhn', p_ctx, v_ctx))

    out = lax.map(one_row, (jnp.moveaxis(qg, 1, 0), jnp.arange(rows), row_start))
    return jnp.moveaxis(out, 0, 1).reshape(B, T, H * N)


def context_attention(q, k, v):
    B, C, H, N = q.shape
    s = jnp.einsum('bqhn,bkhn->bhqk', q, k).astype(jnp.float32) * (N ** -0.5)
    p = jax.nn.softmax(s, axis=-1).astype(v.dtype)
    return jnp.einsum('bhqk,bkhn->bqhn', p, v).reshape(B, C, H * N)


def gla_forget_gate(lr, w2, b):
    return jax.nn.log_sigmoid((lr @ w2 + b).astype(jnp.float32)) / GLA_GATE_NORMALIZER


def gla_final_state(k, v, g):
    b = jnp.cumsum(g.astype(jnp.float32), axis=1)
    return jnp.einsum('bthd,bthv->bhdv', k.astype(jnp.float32) * jnp.exp(b[:, -1:] - b), v.astype(jnp.float32))


def chunked_gla(q, k, v, g, s0):
    B, T, H, DK = q.shape
    DV = v.shape[-1]
    n = T // GLA_CHUNK

    def chunks(t):
        return t.astype(jnp.float32).reshape(B, n, GLA_CHUNK, H, t.shape[-1]).transpose(1, 0, 3, 2, 4)

    lower = jnp.tril(jnp.ones((GLA_CHUNK, GLA_CHUNK), dtype=bool))

    def step(S, inp):
        qc, kc, vc, gc = inp
        b = jnp.cumsum(gc, axis=2)
        o_inter = jnp.einsum('bhtd,bhdv->bhtv', qc * jnp.exp(b), S)
        rel = jnp.where(lower[:, :, None], b[:, :, :, None, :] - b[:, :, None, :, :], -jnp.inf)
        att = jnp.einsum('bhtd,bhsd,bhtsd->bhts', qc, kc, jnp.exp(rel))
        o = o_inter + jnp.einsum('bhts,bhsv->bhtv', att, vc)
        b_end = b[:, :, -1:, :]
        S = (jnp.exp(b_end)[:, :, 0, :, None] * S
             + jnp.einsum('bhsd,bhsv->bhdv', kc * jnp.exp(b_end - b), vc))
        return S, o

    s_final, o = lax.scan(step, s0, (chunks(q), chunks(k), chunks(v), chunks(g)))
    return o.transpose(1, 0, 3, 2, 4).reshape(B, T, H, DV), s_final


def gla_group(h_l, h_c, w_in, gate_w2, gate_b, o_norm):
    B, T, _ = h_l.shape
    C = h_c.shape[1]
    p_l = h_l @ w_in
    p_c = h_c @ w_in[:, :GLA_STATE_COLS]

    def split_state(p):
        Bp, Tp, _ = p.shape
        k = p[..., :GLA_KEY_WIDTH].reshape(Bp, Tp, GLA_HEADS, GLA_DK)
        v = p[..., GLA_KEY_WIDTH:GLA_KEY_WIDTH + GLA_VAL_WIDTH].reshape(Bp, Tp, GLA_HEADS, GLA_DV)
        o = GLA_KEY_WIDTH + GLA_VAL_WIDTH
        lr = (p[..., o:o + GLA_GATE_RANK], p[..., o + GLA_GATE_RANK:o + 2 * GLA_GATE_RANK])
        return k, v, lr

    k_l, v_l, lr_l = split_state(p_l)
    k_c, v_c, lr_c = split_state(p_c)
    q_l = p_l[..., GLA_STATE_COLS:GLA_STATE_COLS + GLA_KEY_WIDTH].reshape(B, T, GLA_HEADS, GLA_DK) * (GLA_DK ** -0.5)
    out_gate = p_l[..., GLA_STATE_COLS + GLA_KEY_WIDTH:]
    o = 0.0
    for d in range(2):
        if d == 0:
            tdir = lambda t: t
        else:
            tdir = lambda t: jnp.flip(t, axis=1)
        g_l = gla_forget_gate(lr_l[d], gate_w2[d], gate_b[d]).reshape(B, T, GLA_HEADS, GLA_DK)
        g_c = gla_forget_gate(lr_c[d], gate_w2[d], gate_b[d]).reshape(B, C, GLA_HEADS, GLA_DK)
        s_ctx = gla_final_state(tdir(k_c), tdir(v_c), tdir(g_c))
        o_d, _ = chunked_gla(tdir(q_l), tdir(k_l), tdir(v_l), tdir(g_l), s_ctx)
        o = o + tdir(o_d)
    o = rms_norm(o, o_norm).reshape(B, T, GLA_VAL_WIDTH)
    return (o * jax.nn.silu(out_gate.astype(jnp.float32))).astype(h_l.dtype)


def moe_swiglu(h, router, exp_wg, exp_wu, exp_wd):
    B, T, D = h.shape
    hf = h.reshape(B * T, D)
    logits = (hf @ router).astype(jnp.float32)
    top_val, top_idx = lax.top_k(logits, TOP_K)
    top_w = jax.nn.softmax(top_val, axis=-1)
    combine = jnp.sum(jax.nn.one_hot(top_idx, N_EXPERTS, dtype=jnp.float32) * top_w[..., None], axis=1)
    y = jnp.zeros_like(hf)
    for e in range(N_EXPERTS):
        y = y + combine[:, e:e + 1].astype(h.dtype) * swiglu(hf, exp_wg[e], exp_wu[e], exp_wd[e])
    return y.reshape(B, T, D)


def even_layer(x, ctx, c, c_ctx, w_mod, b_mod, norm1, norm2, w_in, mu_shift,
               decay_w0, decay_w2, iclr_a0, iclr_a2, gate_g2, k_k, k_a, r_k, lnx_g, lnx_b,
               q_norm, k_norm, rpb, w_out, ffn_wg, ffn_wu, ffn_wd):
    sh1, sc1, gt1, sh2, sc2, gt2 = [m[:, None, :] for m in adaln(c, w_mod, b_mod)]
    csh1, csc1, cgt1, csh2, csc2, cgt2 = adaln(c_ctx, w_mod, b_mod)
    h_l = modulate(rms_norm(x, norm1), sh1, sc1)
    h_c = modulate(rms_norm(ctx, norm1), csh1, csc1)
    p_l = h_l @ w_in
    p_c = h_c @ w_in
    a_l, a_c = rwkv7_group(bidir_token_shift(p_l[..., :RWKV_COLS], mu_shift),
                           bidir_token_shift(p_c[..., :RWKV_COLS], mu_shift),
                           decay_w0, decay_w2, iclr_a0, iclr_a2, gate_g2, k_k, k_a, r_k, lnx_g, lnx_b)
    q_l, k_l, v_l = na_qkv(p_l[..., RWKV_COLS:], q_norm, k_norm)
    q_c, k_c, v_c = na_qkv(p_c[..., RWKV_COLS:], q_norm, k_norm)
    b_l = neighbourhood_attention(q_l, k_l, v_l, k_c, v_c, rpb)
    b_c = context_attention(q_c, k_c, v_c)
    x = x + gt1 * (jnp.concatenate([a_l, b_l], axis=-1) @ w_out)
    ctx = ctx + cgt1 * (jnp.concatenate([a_c, b_c], axis=-1) @ w_out)
    x = x + gt2 * swiglu(modulate(rms_norm(x, norm2), sh2, sc2), ffn_wg, ffn_wu, ffn_wd)
    ctx = ctx + cgt2 * swiglu(modulate(rms_norm(ctx, norm2), csh2, csc2), ffn_wg, ffn_wu, ffn_wd)
    return x, ctx


def odd_layer(x, ctx, c, c_ctx, w_mod, b_mod, norm1, norm2, w_in, gate_w2, gate_b, o_norm, w_out,
              router, exp_wg, exp_wu, exp_wd):
    D = x.shape[-1]
    sh1, sc1, gt1, sh2, sc2, gt2 = [m[:, None, :] for m in adaln(c, w_mod, b_mod)]
    csh1, csc1 = jnp.split(jax.nn.silu(c_ctx) @ w_mod[:, :2 * D] + b_mod[:2 * D], 2)
    h_l = modulate(rms_norm(x, norm1), sh1, sc1)
    h_c = modulate(rms_norm(ctx, norm1), csh1, csc1)
    x = x + gt1 * (gla_group(h_l, h_c, w_in, gate_w2, gate_b, o_norm) @ w_out)
    h = modulate(rms_norm(x, norm2), sh2, sc2)
    return x + gt2 * moe_swiglu(h, router, exp_wg, exp_wu, exp_wd)


def setup_inputs(seed: int = 0) -> dict:
    key = jax.random.key(seed)
    ks = iter(jax.random.split(key, 64))
    D = D_MODEL

    def nrm(shape, scale):
        return scale * jax.random.normal(next(ks), shape, jnp.float32)

    def gain(n):
        return 1.0 + nrm((n,), 0.02)

    inputs = {
        'x': nrm((BATCH, SEQ, D), 1.0),
        'c': nrm((BATCH, D), 1.0),
        'ctx': nrm((BATCH, CTX_LEN, D), 1.0),
        'c_ctx': nrm((D,), 1.0),
        'l0_w_mod': nrm((D, 6 * D), 0.5 * D ** -0.5),
        'l0_b_mod': nrm((6 * D,), 0.02),
        'l0_norm1': gain(D),
        'l0_norm2': gain(D),
        'l0_w_in': nrm((D, L0_IN_COLS), D ** -0.5),
        'l0_mu_shift': jax.random.uniform(next(ks), (RWKV_COLS,), jnp.float32, 0.1, 0.9),
        'l0_decay_w0': nrm((2, RWKV_WIDTH), 0.5),
        'l0_decay_w2': nrm((2, DECAY_LORA, RWKV_WIDTH), 0.5 * DECAY_LORA ** -0.5),
        'l0_iclr_a0': nrm((2, RWKV_WIDTH), 0.1),
        'l0_iclr_a2': nrm((2, ICLR_LORA, RWKV_WIDTH), ICLR_LORA ** -0.5),
        'l0_gate_g2': nrm((GATE_LORA, RWKV_WIDTH), GATE_LORA ** -0.5),
        'l0_k_k': 0.85 + nrm((RWKV_WIDTH,), 0.02),
        'l0_k_a': gain(RWKV_WIDTH),
        'l0_r_k': nrm((RWKV_HEADS, RWKV_HEAD_DIM), 0.1),
        'l0_lnx_g': gain(RWKV_WIDTH),
        'l0_lnx_b': nrm((RWKV_WIDTH,), 0.02),
        'l0_q_norm': gain(NA_HEAD_DIM),
        'l0_k_norm': gain(NA_HEAD_DIM),
        'l0_rpb': nrm((NA_HEADS, 2 * NA_KH_MAX - 1, 2 * NA_KW - 1), 0.1),
        'l0_w_out': nrm((RWKV_WIDTH + NA_WIDTH, D), (RWKV_WIDTH + NA_WIDTH) ** -0.5),
        'l0_ffn_wg': nrm((D, FFN_DIM), D ** -0.5),
        'l0_ffn_wu': nrm((D, FFN_DIM), D ** -0.5),
        'l0_ffn_wd': nrm((FFN_DIM, D), FFN_DIM ** -0.5),
        'l1_w_mod': nrm((D, 6 * D), 0.5 * D ** -0.5),
        'l1_b_mod': nrm((6 * D,), 0.02),
        'l1_norm1': gain(D),
        'l1_norm2': gain(D),
        'l1_w_in': nrm((D, L1_IN_COLS), D ** -0.5),
        'l1_gate_w2': nrm((2, GLA_GATE_RANK, GLA_KEY_WIDTH), GLA_GATE_RANK ** -0.5),
        'l1_gate_b': nrm((2, GLA_KEY_WIDTH), 0.1),
        'l1_o_norm': gain(GLA_DV),
        'l1_w_out': nrm((GLA_VAL_WIDTH, D), GLA_VAL_WIDTH ** -0.5),
        'l1_router': nrm((D, N_EXPERTS), D ** -0.5),
        'l1_exp_wg': nrm((N_EXPERTS, D, EXPERT_DIM), D ** -0.5),
        'l1_exp_wu': nrm((N_EXPERTS, D, EXPERT_DIM), D ** -0.5),
        'l1_exp_wd': nrm((N_EXPERTS, EXPERT_DIM, D), EXPERT_DIM ** -0.5),
    }
    return inputs


def reference(x, c, ctx, c_ctx,
              l0_w_mod, l0_b_mod, l0_norm1, l0_norm2, l0_w_in, l0_mu_shift,
              l0_decay_w0, l0_decay_w2, l0_iclr_a0, l0_iclr_a2, l0_gate_g2,
              l0_k_k, l0_k_a, l0_r_k, l0_lnx_g, l0_lnx_b,
              l0_q_norm, l0_k_norm, l0_rpb, l0_w_out,
              l0_ffn_wg, l0_ffn_wu, l0_ffn_wd,
              l1_w_mod, l1_b_mod, l1_norm1, l1_norm2, l1_w_in,
              l1_gate_w2, l1_gate_b, l1_o_norm, l1_w_out,
              l1_router, l1_exp_wg, l1_exp_wu, l1_exp_wd):
    layer_params = (
        (l0_w_mod, l0_b_mod, l0_norm1, l0_norm2, l0_w_in, l0_mu_shift,
         l0_decay_w0, l0_decay_w2, l0_iclr_a0, l0_iclr_a2, l0_gate_g2,
         l0_k_k, l0_k_a, l0_r_k, l0_lnx_g, l0_lnx_b,
         l0_q_norm, l0_k_norm, l0_rpb, l0_w_out, l0_ffn_wg, l0_ffn_wu, l0_ffn_wd),
        (l1_w_mod, l1_b_mod, l1_norm1, l1_norm2, l1_w_in,
         l1_gate_w2, l1_gate_b, l1_o_norm, l1_w_out,
         l1_router, l1_exp_wg, l1_exp_wu, l1_exp_wd),
    )
    for layer in range(DEPTH):
        if layer % 2 == 0:
            x, ctx = even_layer(x, ctx, c, c_ctx, *layer_params[layer])
        else:
            x = odd_layer(x, ctx, c, c_ctx, *layer_params[layer])
    return x
```

```cpp
#include <hip/hip_runtime.h>
#include <stdint.h>
#include <string.h>

#define DM 2048
#define NL 8192
#define NC 512
#define NT 8704
#define TL 4096
#define TC 256
#define MODW 12288
#define L0C 6528
#define L1C 6176
#define L0LD 6656
#define L1LD 6400
#define RWC 3456
#define FFN 5632
#define EXD 7168
#define NEXP 8
#define NTHR 512
#define MAXSLOT 18432
#define LDS_BYTES (131072 + 64 + 256)

typedef unsigned short bf16_t;
__device__ __forceinline__ int ptid() { int t = threadIdx.x; asm volatile("" : "+v"(t)); return t; }
#define XB_TMO      128
#define XB_XCNT(j)  (256  + 64 * (j))
#define XB_XSUB(j)  (1280 + 64 * (j))
#define XB_XGEN(j)  (2304 + 64 * (j))
#define XB_TOP      3328
#define XB_TOPGEN   3392
#define XCD_BAR_WORDS 3456
#define XB_SPIN_CAP (1u << 22)
#define LAS __attribute__((address_space(3)))
__device__ __forceinline__ unsigned xb_ld(unsigned* p)              { return __hip_atomic_load(p, __ATOMIC_RELAXED, __HIP_MEMORY_SCOPE_AGENT); }
__device__ __forceinline__ unsigned xb_add(unsigned* p, unsigned v) { return __hip_atomic_fetch_add(p, v, __ATOMIC_RELAXED, __HIP_MEMORY_SCOPE_AGENT); }
__device__ __forceinline__ unsigned xb_xcc_id() { return (unsigned)__builtin_amdgcn_s_getreg((3 << 11) | 20) & 0xFu; }
#define XB_SPIN(cond, bar) do { unsigned _sp = 0; while (cond) { __builtin_amdgcn_s_sleep(1); \
    if ((++_sp & 255u) == 0u) { if (xb_ld(&(bar)[XB_TMO])) break; if (_sp > XB_SPIN_CAP) { atomicAdd(&(bar)[XB_TMO], 1u); break; } } } } while (0)
struct XcdBarrier { unsigned* bar; unsigned x; volatile LAS unsigned* st; };
__device__ __forceinline__ XcdBarrier xcd_barrier_post(unsigned* bar, volatile LAS unsigned* st) {
    XcdBarrier b; b.bar = bar; b.x = xb_xcc_id(); b.st = st;
    if (threadIdx.x == 0) (void)xb_add(&bar[XB_XCNT(b.x)], 1u);
    return b;
}
__device__ __forceinline__ void xcd_barrier_complete(unsigned* bar, unsigned x, unsigned& nloc, unsigned& nx) {
    const unsigned G = gridDim.x * gridDim.y * gridDim.z;
    unsigned sum, cnt, mine, sp = 0u;
    for (;;) {
        sum = 0u; cnt = 0u; mine = 0u;
#pragma unroll
        for (unsigned j = 0; j < 16; ++j) { const unsigned c = xb_ld(&bar[XB_XCNT(j)]); sum += c; cnt += (c > 0u) ? 1u : 0u; mine = (j == x) ? c : mine; }
        if (sum == G) break;
        __builtin_amdgcn_s_sleep(1);
        if ((++sp & 255u) == 0u) { if (xb_ld(&bar[XB_TMO])) break; if (sp > XB_SPIN_CAP) { atomicAdd(&bar[XB_TMO], 1u); break; } }
    }
    nloc = mine > 0u ? mine : 1u; nx = cnt > 0u ? cnt : 1u;
}
__device__ __forceinline__ void xcd_barrier(const XcdBarrier& b) {
    asm volatile("s_waitcnt vmcnt(0)" ::: "memory");
    __syncthreads();
    if (threadIdx.x == 0) {
        unsigned* bar = b.bar;
        __builtin_amdgcn_s_waitcnt(0);
        unsigned nloc = b.st[0], nx = b.st[1];
        if (nloc == 0u) { xcd_barrier_complete(bar, b.x, nloc, nx); b.st[0] = nloc; b.st[1] = nx; }
        const unsigned old = xb_add(&bar[XB_XSUB(b.x)], 1u);
        const unsigned gen = old / nloc;
        if (old + 1u == (gen + 1u) * nloc) {
            __builtin_amdgcn_fence(__ATOMIC_RELEASE, "agent");
            asm volatile("s_waitcnt vmcnt(0)" ::: "memory");
            const unsigned og = xb_add(&bar[XB_TOP], 1u);
            const unsigned tg = og / nx;
            if (og + 1u == (tg + 1u) * nx) xb_add(&bar[XB_TOPGEN], 1u);
            else XB_SPIN(xb_ld(&bar[XB_TOPGEN]) == tg, bar);
            __builtin_amdgcn_fence(__ATOMIC_ACQUIRE, "agent");
            xb_add(&bar[XB_XGEN(b.x)], 1u);
            asm volatile("s_waitcnt vmcnt(0)" ::: "memory");
        } else {
            XB_SPIN(xb_ld(&bar[XB_XGEN(b.x)]) == gen, bar);
            __builtin_amdgcn_fence(__ATOMIC_ACQUIRE, "agent");
            asm volatile("s_waitcnt vmcnt(0)" ::: "memory");
        }
    }
    __syncthreads();
}


namespace pg8 {
#define PG8_LAS __attribute__((address_space(3)))
typedef short bf16x8 __attribute__((ext_vector_type(8)));
typedef float f32x4 __attribute__((ext_vector_type(4)));
typedef unsigned u32x4 __attribute__((ext_vector_type(4)));
constexpr int BM = 256, BK = 64, HALF = 128, HTB = HALF * BK * 2, STAGE_BYTES = 8 * HTB, NXCD = 8, WGM = 8;
__host__ __device__ __forceinline__ int lds_byte(int r, int c) { const int st = (r >> 4) * 2 + (c >> 5), rr = r & 15, cc = c & 31, ob = rr * 64 + cc * 2; return st * 1024 + (ob ^ (((ob >> 9) & 1) << 5)); }
__host__ __device__ __forceinline__ void stage_rc(int b, int& R, int& C) { const int st = b / 1024, sb = b % 1024, swz = sb ^ (((sb >> 9) & 1) << 5); R = (st >> 1) * 16 + swz / 64; C = (st & 1) * 32 + (swz % 64) / 2; }
__host__ __device__ __forceinline__ int perm32(int rho) { const int n = rho >> 4, i = rho & 15; return 8 * (i >> 2) + 4 * n + (i & 3); }
struct Unit { int pm, pn, k0; };
struct Gemm { const bf16_t* A; const bf16_t* Bt; int K; int ld; };
struct StaticOrder {
    int nM, nN, nwg, G, c;
    __device__ void init(int M, int N, int G_, int c_) { nM = M / BM; nN = N / BM; nwg = nM * nN; G = G_; c = c_; }
    __device__ bool next(int i, Unit& u) const {
        const long L = (long)i * G + c; if (L >= nwg) return false;
        int wgid = (int)L; { const int q = nwg / NXCD, r = nwg % NXCD, xcd = wgid % NXCD, off = wgid / NXCD; wgid = (xcd < r ? xcd * (q + 1) : r * (q + 1) + (xcd - r) * q) + off; }
        const int nig = WGM * nN, gid = wgid / nig, fm = gid * WGM, gsz = (nM - fm) < WGM ? (nM - fm) : WGM;
        u.pm = fm + ((wgid % nig) % gsz); u.pn = (wgid % nig) / gsz; u.k0 = 0; return true;
    }
    __device__ __forceinline__ void a_ready(const Unit&) const {}
    __device__ __forceinline__ void done(const Unit&) const {}
};
struct CtxSplitOrder {
    int nN, KS, ksub, G, c;
    __device__ bool next(int i, Unit& u) const {
        const long L = (long)i * G + c; if (L >= (long)2 * nN * KS) return false;
        const int l = (int)L; u.pm = 32 + (l & 1); u.pn = (l >> 1) % nN; u.k0 = ((l >> 1) / nN) * ksub; return true;
    }
    __device__ __forceinline__ void a_ready(const Unit&) const {}
    __device__ __forceinline__ void done(const Unit&) const {}
};
struct GroupedRange {
    int ntm, nN, lo, hi, G, c; const int* tile_e;
    __device__ bool next(int i, Unit& u) const {
        const long L0 = (long)i * G + c; const int n = hi - lo; if (L0 >= n) return false;
        int e = (int)L0; { const int q = n / NXCD, r = n % NXCD, xcd = e % NXCD, off = e / NXCD; e = (xcd < r ? xcd * (q + 1) : r * (q + 1) + (xcd - r) * q) + off; }
        const int L = lo + e; const int pm = L % ntm, pn = L / ntm;
        u.pm = pm; u.pn = tile_e[pm] * nN + pn; u.k0 = 0; return true;
    }
    __device__ __forceinline__ void a_ready(const Unit&) const {}
    __device__ __forceinline__ void done(const Unit&) const {}
};
struct GroupedTail {
    int ntm, nN, lo, ntail, KS, ksub, G, c; const int* tile_e;
    __device__ bool next(int i, Unit& u) const {
        const long J = (long)i * G + c; if (J >= (long)ntail * KS) return false;
        const int t = (int)(J % ntail), ks = (int)(J / ntail); const int L = lo + t;
        const int pm = L % ntm, pn = L / ntm;
        u.pm = pm; u.pn = tile_e[pm] * nN + pn; u.k0 = ks * ksub; return true;
    }
    __device__ __forceinline__ void a_ready(const Unit&) const {}
    __device__ __forceinline__ void done(const Unit&) const {}
};
struct GroupedOrder {
    int ntm, nN, G, c; const int* tile_e;
    __device__ bool next(int i, Unit& u) const {
        const int nwg = ntm * nN; const long L = (long)i * G + c; if (L >= nwg) return false;
        int wgid = (int)L; { const int q = nwg / NXCD, r = nwg % NXCD, xcd = wgid % NXCD, off = wgid / NXCD; wgid = (xcd < r ? xcd * (q + 1) : r * (q + 1) + (xcd - r) * q) + off; }
        const int nig = WGM * nN, gid = wgid / nig, fm = gid * WGM, gsz = (ntm - fm) < WGM ? (ntm - fm) : WGM;
        const int pm = fm + ((wgid % nig) % gsz), pn = (wgid % nig) / gsz;
        u.pm = pm; u.pn = tile_e[pm] * nN + pn; u.k0 = 0; return true;
    }
    __device__ __forceinline__ void a_ready(const Unit&) const {}
    __device__ __forceinline__ void done(const Unit&) const {}
};
template <class Epi, class Sched, bool ALIGN_EPI = false, bool SP2 = false>
__device__ __forceinline__ void gemm_phase(PG8_LAS unsigned char* lds, const Gemm g, const Sched& S, const Epi& E) {
    const int tid = ptid(), wid = __builtin_amdgcn_readfirstlane(tid >> 6), lane = tid & 63, wr = wid >> 2, wc = wid & 3, fr = lane & 15, fq = lane >> 4;
    const int K = g.K, nt = K / BK, LD = g.ld;
    unsigned voffA[2], voffB[2];
#pragma unroll
    for (int i = 0; i < 2; ++i) { int R, C; stage_rc(tid * 16 + i * 8192, R, C); const int Rb = Epi::PERM ? ((R & ~31) + perm32(R & 31)) : R;
        voffA[i] = (unsigned)(R * LD + C) * 2u; voffB[i] = (unsigned)(Rb * LD + C) * 2u; }
    const size_t kstep = (size_t)(BK * 2);
    const size_t hstep = (size_t)HALF * LD * 2;
    const size_t tstep = 2 * hstep;
    const unsigned ldsw = (unsigned)wid * 1024u;
    const int aoff = lds_byte(wr * 64 + fr, fq * 8), boff = lds_byte(wc * 32 + fr, fq * 8);
#define PG8_SA(b, h) (((b) * 2 + (h)) * HTB)
#define PG8_SB(b, h) ((4 + (b) * 2 + (h)) * HTB)
#define PG8_STAGE(bufoff, gbase, voff) do { _Pragma("unroll") for (int _i = 0; _i < 2; ++_i) \
        __builtin_amdgcn_global_load_lds((const unsigned*)((const char*)(gbase) + (voff)[_i]), (PG8_LAS unsigned*)(lds + (bufoff) + ldsw + _i * 8192), 16, 0, 0); } while (0)
#define PG8_LDA(dst, b, h) do { _Pragma("unroll") for (int m = 0; m < 4; ++m) _Pragma("unroll") for (int k = 0; k < 2; ++k) dst[m][k] = *(const PG8_LAS bf16x8*)(lds + PG8_SA(b, h) + aoff + m * 2048 + k * 1024); } while (0)
#define PG8_LDB(dst, b, h) do { _Pragma("unroll") for (int n = 0; n < 2; ++n) _Pragma("unroll") for (int k = 0; k < 2; ++k) dst[n][k] = *(const PG8_LAS bf16x8*)(lds + PG8_SB(b, h) + boff + n * 2048 + k * 1024); } while (0)
#define PG8_MMA(ai, bj, At, Bt) do { __builtin_amdgcn_s_setprio(1); _Pragma("unroll") for (int m = 0; m < 4; ++m) _Pragma("unroll") for (int n = 0; n < 2; ++n) _Pragma("unroll") for (int k = 0; k < 2; ++k) \
        acc[ai][bj][m][n] = __builtin_amdgcn_mfma_f32_16x16x32_bf16(Bt[n][k], At[m][k], acc[ai][bj][m][n], 0, 0, 0); __builtin_amdgcn_s_setprio(0); } while (0)
#define PG8_WAIT_V(n) asm volatile("s_waitcnt vmcnt(" #n ")" ::: "memory")
#define PG8_WAIT_L(n) asm volatile("s_waitcnt lgkmcnt(" #n ")" ::: "memory")
#define PG8_BAR __builtin_amdgcn_s_barrier()
#define PG8_SCHED __builtin_amdgcn_sched_barrier(0)
    Unit cur, nxt; int ui = 0;
    if (!S.next(0, cur)) return;
    f32x4 acc[2][2][4][2];
#pragma unroll
    for (int a = 0; a < 2; ++a)
#pragma unroll
        for (int b = 0; b < 2; ++b)
#pragma unroll
            for (int m = 0; m < 4; ++m)
#pragma unroll
                for (int n = 0; n < 2; ++n) acc[a][b][m][n] = (f32x4){0.f, 0.f, 0.f, 0.f};
    bf16x8 At[4][2], B0[2][2], B1[2][2];
    const char* cA = (const char*)g.A + (size_t)cur.pm * tstep + (size_t)cur.k0 * 2; const char* cB = (const char*)g.Bt + (size_t)cur.pn * tstep + (size_t)cur.k0 * 2;
    S.a_ready(cur);
    if constexpr (SP2) {
        PG8_STAGE(PG8_SB(0, 0), cB, voffB); PG8_STAGE(PG8_SB(0, 1), cB + hstep, voffB); PG8_STAGE(PG8_SA(0, 0), cA, voffA); PG8_STAGE(PG8_SA(0, 1), cA + hstep, voffA);
        if (wr == 1) PG8_BAR;
        PG8_WAIT_V(2); PG8_BAR;
        PG8_STAGE(PG8_SB(1, 0), cB + kstep, voffB); PG8_STAGE(PG8_SA(1, 0), cA + kstep, voffA); PG8_STAGE(PG8_SB(1, 1), cB + hstep + kstep, voffB);
        PG8_WAIT_V(6); PG8_BAR;
    } else {
        PG8_STAGE(PG8_SB(0, 0), cB, voffB); PG8_STAGE(PG8_SA(0, 0), cA, voffA); PG8_STAGE(PG8_SB(0, 1), cB + hstep, voffB); PG8_STAGE(PG8_SA(0, 1), cA + hstep, voffA);
        if (wr == 1) PG8_BAR;
        PG8_WAIT_V(4); PG8_BAR;
        PG8_STAGE(PG8_SB(1, 0), cB + kstep, voffB); PG8_STAGE(PG8_SA(1, 0), cA + kstep, voffA); PG8_STAGE(PG8_SB(1, 1), cB + hstep + kstep, voffB);
        PG8_WAIT_V(6); PG8_BAR;
    }
    for (;;) {
        const bool has_next = S.next(ui + 1, nxt);
        const char* nA = has_next ? (const char*)g.A + (size_t)nxt.pm * tstep + (size_t)nxt.k0 * 2 : cA; const char* nB = has_next ? (const char*)g.Bt + (size_t)nxt.pn * tstep + (size_t)nxt.k0 * 2 : cB;
        for (int t = 0; t < nt; t += 2) {
            const bool last = (t == nt - 2);
            const char* a1 = cA + (size_t)(t + 1) * kstep;
            const char* a2 = last ? nA : cA + (size_t)(t + 2) * kstep; const char* b2 = last ? nB : cB + (size_t)(t + 2) * kstep;
            const char* a3 = a2 + kstep; const char* b3 = b2 + kstep;
            if (last && has_next) S.a_ready(nxt);
            if constexpr (SP2) {
            PG8_LDB(B0, 0, 0); PG8_LDB(B1, 0, 1); PG8_SCHED; PG8_LDA(At, 0, 0); PG8_STAGE(PG8_SA(1, 1), a1 + hstep, voffA);
            PG8_WAIT_V(8); PG8_WAIT_L(0); PG8_BAR; PG8_MMA(0, 0, At, B0); PG8_MMA(0, 1, At, B1); PG8_BAR; PG8_SCHED;
            PG8_LDA(At, 0, 1); PG8_STAGE(PG8_SB(0, 0), b2, voffB); PG8_STAGE(PG8_SB(0, 1), b2 + hstep, voffB); PG8_STAGE(PG8_SA(0, 0), a2, voffA);
            PG8_WAIT_V(8); PG8_WAIT_L(0); PG8_BAR; PG8_MMA(1, 0, At, B0); PG8_MMA(1, 1, At, B1); PG8_BAR; PG8_SCHED;
            PG8_LDB(B0, 1, 0); PG8_LDB(B1, 1, 1); PG8_SCHED; PG8_LDA(At, 1, 0); PG8_STAGE(PG8_SA(0, 1), a2 + hstep, voffA);
            PG8_WAIT_V(8); PG8_WAIT_L(0); PG8_BAR; PG8_MMA(0, 0, At, B0); PG8_MMA(0, 1, At, B1); PG8_BAR; PG8_SCHED;
            PG8_LDA(At, 1, 1); PG8_STAGE(PG8_SB(1, 0), b3, voffB); PG8_STAGE(PG8_SB(1, 1), b3 + hstep, voffB); PG8_STAGE(PG8_SA(1, 0), a3, voffA);
            PG8_WAIT_V(8); PG8_WAIT_L(0); PG8_BAR; PG8_MMA(1, 0, At, B0); PG8_MMA(1, 1, At, B1); PG8_BAR; PG8_SCHED;
            } else {
            PG8_LDB(B0, 0, 0); PG8_SCHED; PG8_LDA(At, 0, 0); PG8_STAGE(PG8_SA(1, 1), a1 + hstep, voffA);
            PG8_WAIT_L(8); PG8_BAR; PG8_WAIT_L(0); PG8_MMA(0, 0, At, B0); PG8_BAR; PG8_SCHED;
            PG8_LDB(B1, 0, 1); PG8_STAGE(PG8_SB(0, 0), b2, voffB);
            PG8_BAR; PG8_WAIT_L(0); PG8_MMA(0, 1, At, B1); PG8_BAR;
            PG8_LDA(At, 0, 1); PG8_STAGE(PG8_SA(0, 0), a2, voffA);
            PG8_BAR; PG8_WAIT_L(0); PG8_MMA(1, 0, At, B0); PG8_BAR; PG8_SCHED;
            PG8_STAGE(PG8_SB(0, 1), b2 + hstep, voffB);
            PG8_WAIT_V(6); PG8_BAR; PG8_MMA(1, 1, At, B1); PG8_BAR;
            PG8_LDB(B0, 1, 0); PG8_SCHED; PG8_LDA(At, 1, 0); PG8_STAGE(PG8_SA(0, 1), a2 + hstep, voffA);
            PG8_WAIT_L(8); PG8_BAR; PG8_WAIT_L(0); PG8_MMA(0, 0, At, B0); PG8_BAR; PG8_SCHED;
            PG8_LDB(B1, 1, 1); PG8_STAGE(PG8_SB(1, 0), b3, voffB);
            PG8_BAR; PG8_WAIT_L(0); PG8_MMA(0, 1, At, B1); PG8_BAR;
            PG8_LDA(At, 1, 1); PG8_STAGE(PG8_SA(1, 0), a3, voffA);
            PG8_BAR; PG8_WAIT_L(0); PG8_MMA(1, 0, At, B0); PG8_BAR; PG8_SCHED;
            PG8_STAGE(PG8_SB(1, 1), b3 + hstep, voffB);
            PG8_WAIT_V(6); PG8_BAR; PG8_MMA(1, 1, At, B1); PG8_BAR;
            }
        }
        if constexpr (ALIGN_EPI) { if (wr == 0) PG8_BAR; }
        if constexpr (!Epi::AFTER_DRAIN) { E(acc, cur, wr, wc, fr, fq); S.done(cur); }
        if (!has_next) break;
#pragma unroll
        for (int a = 0; a < 2; ++a)
#pragma unroll
            for (int b = 0; b < 2; ++b)
#pragma unroll
                for (int m = 0; m < 4; ++m)
#pragma unroll
                    for (int n = 0; n < 2; ++n) acc[a][b][m][n] = (f32x4){0.f, 0.f, 0.f, 0.f};
        cur = nxt; cA = nA; cB = nB; ++ui;
        if constexpr (ALIGN_EPI) { if (wr == 1) PG8_BAR; }
    }
    PG8_WAIT_V(0);
    if constexpr (!ALIGN_EPI) { if (wr == 0) PG8_BAR; }
    PG8_BAR;
    if constexpr (Epi::AFTER_DRAIN) { E.fused(acc, cur, wr, wc, fr, fq, lds, wid, lane); S.done(cur); }
#undef PG8_SA
#undef PG8_SB
#undef PG8_STAGE
#undef PG8_LDA
#undef PG8_LDB
#undef PG8_MMA
#undef PG8_WAIT_V
#undef PG8_WAIT_L
#undef PG8_BAR
#undef PG8_SCHED
}

}

struct Params {
    const float* in[40];
    float* out;
    unsigned* bar;
    float* mod0; float* mod1;
    bf16_t* Hb; bf16_t* MIXb; bf16_t* H1b; bf16_t* Xp; bf16_t* H1Eb;
    bf16_t* Wt_in0; bf16_t* Wt_out0; bf16_t* Wt_ffnup; bf16_t* Wt_ffndn; bf16_t* Wt_in1; bf16_t* Wt_out1; bf16_t* Wt_expup; bf16_t* Wt_expdn;
    bf16_t* P; float* LRs;
    bf16_t* R; float* V; bf16_t* KK; float* G; float* W[2]; bf16_t* KD[2]; bf16_t* NB[2];
    float* Y[2];
    bf16_t* Qb; bf16_t* Kb; bf16_t* VTl; bf16_t* VTc; float* QM; float* XA; float* XB;
    float* O[2]; bf16_t* QT; bf16_t* KHT; bf16_t* AM; bf16_t* VT; float* DEC;
    int* tok_e; float* tok_w; int* meta; int* slot_token; int* tok_slot; int* tile_e;
    bf16_t* YE; float* YEP; float* PC; bf16_t* WTd; bf16_t* WTi; bf16_t* WTg;
};

__device__ __forceinline__ void lds_barrier() { asm volatile("s_waitcnt lgkmcnt(0)" ::: "memory"); __builtin_amdgcn_s_barrier(); asm volatile("" ::: "memory"); }
__device__ __forceinline__ float bf2f(bf16_t b) { return __uint_as_float(((unsigned)b) << 16); }
typedef float f32x2_t __attribute__((ext_vector_type(2)));
typedef __bf16 bf16x2_t __attribute__((ext_vector_type(2)));
__device__ __forceinline__ unsigned cvt_pk_bf16(float lo, float hi) { const f32x2_t v = {lo, hi}; return __builtin_bit_cast(unsigned, __builtin_convertvector(v, bf16x2_t)); }
__device__ __forceinline__ bf16_t f2bf(float f) { return (bf16_t)(cvt_pk_bf16(f, 0.f) & 0xffffu); }
__device__ __forceinline__ float sigm(float x) { return __builtin_amdgcn_rcpf(1.f + __expf(-x)); }
__device__ __forceinline__ float siluf(float x) { return x * __builtin_amdgcn_rcpf(1.f + __expf(-x)); }
__device__ __forceinline__ float silu_fast(float x) { return x * __builtin_amdgcn_rcpf(1.f + __expf(-x)); }
__device__ __forceinline__ float softplusf(float x) { return x > 20.f ? x : __logf(1.f + __expf(x)); }
__device__ __forceinline__ int rowgrp(int row) { return row < NL ? row / TL : 2; }
__device__ __forceinline__ float dpp_add16(float x) {
    x += __builtin_bit_cast(float, __builtin_amdgcn_update_dpp(0, __builtin_bit_cast(int, x), 0xB1, 0xF, 0xF, true));
    x += __builtin_bit_cast(float, __builtin_amdgcn_update_dpp(0, __builtin_bit_cast(int, x), 0x4E, 0xF, 0xF, true));
    x += __builtin_bit_cast(float, __builtin_amdgcn_update_dpp(0, __builtin_bit_cast(int, x), 0x141, 0xF, 0xF, true));
    x += __builtin_bit_cast(float, __builtin_amdgcn_update_dpp(0, __builtin_bit_cast(int, x), 0x140, 0xF, 0xF, true));
    return x;
}
__device__ __forceinline__ float wave_sum(float v) {
    v = dpp_add16(v);
    v += __shfl_xor(v, 16); v += __shfl_xor(v, 32);
    return v;
}
__device__ __forceinline__ float wave_max(float v) {
#pragma unroll
    for (int o = 32; o >= 1; o >>= 1) v = fmaxf(v, __shfl_xor(v, o));
    return v;
}
__device__ __forceinline__ float block_sum(float v, float* red) {
    v = wave_sum(v);
    __syncthreads();
    const int bt_ = ptid();
    if ((bt_ & 63) == 0) red[bt_ >> 6] = v;
    __syncthreads();
    float s = 0.f;
#pragma unroll
    for (int i = 0; i < 8; ++i) s += red[i];
    return s;
}

__device__ __forceinline__ void conv_T(const float* W0, const float* W1, int K, int N, int Nt, int mode, bf16_t* Bt, float* ldsf, int wg, int nwg) {
    bf16_t (*T)[66] = (bf16_t (*)[66])ldsf;
    const int tid = ptid();
    const int tn = Nt / 64, tk = K / 64;
    for (int tile = wg; tile < tn * tk; tile += nwg) {
        const int n0 = (tile % tn) * 64, k0 = (tile / tn) * 64;
        const float* src = W0; int col0 = n0;
        if (mode == 1) { const int t = n0 >> 8, h = (n0 >> 7) & 1, j0 = n0 & 127; src = h ? W1 : W0; col0 = t * 128 + j0; }
        const int kk = tid >> 4, c4 = (tid & 15) * 4;
#pragma unroll
        for (int r = 0; r < 2; ++r) {
            const int k = kk + 32 * r;
            float4 v = make_float4(0.f, 0.f, 0.f, 0.f);
            if (col0 + c4 < N) v = *(const float4*)(src + (size_t)(k0 + k) * N + col0 + c4);
            T[c4 + 0][k] = f2bf(v.x); T[c4 + 1][k] = f2bf(v.y); T[c4 + 2][k] = f2bf(v.z); T[c4 + 3][k] = f2bf(v.w);
        }
        __syncthreads();
        {
            const int n = tid >> 3, k8 = (tid & 7) * 8;
            const unsigned* tp = (const unsigned*)&T[n][k8];
            uint4 o; o.x = tp[0]; o.y = tp[1]; o.z = tp[2]; o.w = tp[3];
            *(uint4*)(Bt + (size_t)(n0 + n) * K + k0 + k8) = o;
        }
        __syncthreads();
    }
}
#define CT_L0A 6656
#define CT_L0B (CT_L0A + 2048)
#define CT_L0C (CT_L0B + 11264)
#define CT_L0 (CT_L0C + 5632)
#define CT_A (CT_L0 + 6400)
#define CT_B (CT_A + 2048)
#define CT_C (CT_B + 8 * 14336)
#define CT_TOTAL (CT_C + 8 * 7168)
#define CT_LDS_BYTES 5120
struct ConvTile { const float* src; bf16_t* dst; int N; int K; int nvalid; };
#define CTTAB_OFF (131072 + 64)
__device__ __forceinline__ void ct_table_init(const Params& p, unsigned long long* tab) {
    tab[0] = (unsigned long long)p.in[8]; tab[1] = (unsigned long long)p.in[23]; tab[2] = (unsigned long long)p.in[24]; tab[3] = (unsigned long long)p.in[25]; tab[4] = (unsigned long long)p.in[26];
    tab[5] = (unsigned long long)p.in[31]; tab[6] = (unsigned long long)p.in[35]; tab[7] = (unsigned long long)p.in[37]; tab[8] = (unsigned long long)p.in[38]; tab[9] = (unsigned long long)p.in[39];
    tab[10] = (unsigned long long)p.Wt_in0; tab[11] = (unsigned long long)p.Wt_out0; tab[12] = (unsigned long long)p.Wt_ffnup; tab[13] = (unsigned long long)p.Wt_ffndn;
    tab[14] = (unsigned long long)p.Wt_in1; tab[15] = (unsigned long long)p.Wt_out1; tab[16] = (unsigned long long)p.Wt_expup; tab[17] = (unsigned long long)p.Wt_expdn;
}
__device__ __forceinline__ ConvTile conv_tile_desc(const unsigned long long* tab, int t) {
    int si, di, N, K, nb, kb, e = 0, mode = 0, npad = 0;
    if (t < CT_L0A) { si = 0; di = 10; N = L0C; K = DM; nb = t % 104; kb = t / 104; npad = 1; }
    else if (t < CT_L0B) { const int u = t - CT_L0A; si = 1; di = 11; N = DM; K = DM; nb = u & 31; kb = u >> 5; }
    else if (t < CT_L0C) { const int u = t - CT_L0B; si = 2; di = 12; N = FFN; K = DM; nb = u % 176; kb = u / 176; mode = 1; }
    else if (t < CT_L0) { const int u = t - CT_L0C; si = 4; di = 13; N = DM; K = FFN; nb = u & 31; kb = u >> 5; }
    else if (t < CT_A) { const int u = t - CT_L0; si = 5; di = 14; N = L1C; K = DM; nb = u % 100; kb = u / 100; npad = 1; }
    else if (t < CT_B) { const int u = t - CT_A; si = 6; di = 15; N = DM; K = DM; nb = u & 31; kb = u >> 5; }
    else if (t < CT_C) { const int u = t - CT_B; e = u / 14336; const int v = u % 14336; si = 7; di = 16; N = EXD; K = DM; nb = v % 224; kb = v / 224; mode = 1; }
    else { const int u = (t < CT_TOTAL ? t : CT_TOTAL - 1) - CT_C; e = u / 7168; const int v = u % 7168; si = 9; di = 17; N = DM; K = EXD; nb = v & 31; kb = v >> 5; }
    const int n0 = nb * 64;
    int col0 = n0, nvalid = 64;
    if (mode) { col0 = (n0 >> 8) * 128 + (n0 & 127); si += (n0 >> 7) & 1; }
    if (npad) { nvalid = N - n0; if (nvalid <= 0) col0 = 0; }
    ConvTile c;
    const size_t KN = (size_t)K * N;
    c.src = (const float*)tab[si] + (size_t)e * KN + (size_t)(kb * 32) * N + col0;
    c.dst = (bf16_t*)tab[di] + (size_t)e * (mode ? 2 * KN : KN) + (size_t)n0 * K + kb * 32;
    c.N = N; c.K = K; c.nvalid = nvalid;
    return c;
}
#define CT_FORQ(X) X(0) X(1) X(2) X(3) X(4) X(5) X(6) X(7)
#define CT_LOAD1(q) cv##q = *(const float4*)(ct_.src + (size_t)(ckq_ * 8 + (q)) * ct_.N + ccol_);
#define CT_LOAD(T_) do { const int tt_ = (T_) < CT_TOTAL ? (T_) : CT_TOTAL - 1; const ConvTile ct_ = conv_tile_desc(cttab, tt_); const int ckq_ = lane >> 4, ccol_ = ((lane & 15) * 4 < ct_.nvalid) ? (lane & 15) * 4 : 0; CT_FORQ(CT_LOAD1) } while (0)
#define CT_ATOM(e, C) { uint4 a_; a_.x = cvt_pk_bf16(cv0.C, cv1.C); a_.y = cvt_pk_bf16(cv2.C, cv3.C); a_.z = cvt_pk_bf16(cv4.C, cv5.C); a_.w = cvt_pk_bf16(cv6.C, cv7.C); \
    if (!cok_) a_ = make_uint4(0u, 0u, 0u, 0u); *(uint4*)(cdst_ + (size_t)(e) * ct_.K) = a_; }
#define CT_STORE(T_, LDSW_) do { const int tt_ = (T_) < CT_TOTAL ? (T_) : CT_TOTAL - 1; const ConvTile ct_ = conv_tile_desc(cttab, tt_); const bool cok_ = (lane & 15) * 4 < ct_.nvalid; \
    bf16_t* cdst_ = ct_.dst + (size_t)((lane & 15) * 4) * ct_.K + (lane >> 4) * 8; CT_ATOM(0, x) CT_ATOM(1, y) CT_ATOM(2, z) CT_ATOM(3, w) } while (0)
__device__ __forceinline__ void ph_convert(const Params& p, float* lds, int wg, int nwg, int ct_end) {
    const int tid = ptid(), wave = __builtin_amdgcn_readfirstlane(tid >> 6), lane = tid & 63;
    const unsigned long long* cttab = (const unsigned long long*)((const char*)lds + CTTAB_OFF);
    float4 cv0, cv1, cv2, cv3, cv4, cv5, cv6, cv7;
    for (int t = wg * 8 + wave; t < ct_end; t += nwg * 8) { CT_LOAD(t); CT_STORE(t, 0); }
}

__device__ __forceinline__ void ph_mod(const Params& p, float* lds, int wg, int nwg) {
    float* cs = lds;
    float* red = lds + 3 * DM;
    const int tid = ptid(), wave = tid >> 6, lane = tid & 63;
    if (wg >= 4 * (MODW / 256)) return;
    for (int i = tid; i < 3 * DM; i += NTHR) {
        const int r = i / DM, k = i % DM;
        const float c = r < 2 ? p.in[1][r * DM + k] : p.in[3][k];
        cs[i] = siluf(c);
    }
    __syncthreads();
    for (int item = wg; item < 4 * (MODW / 256); item += nwg) {
        const int kh = item & 1, it2 = item >> 1, layer = it2 / (MODW / 256), cb = (it2 % (MODW / 256)) * 256;
        const float* w = (layer ? p.in[27] : p.in[4]) + cb + lane * 4;
        const float* b = layer ? p.in[28] : p.in[5];
        float* out = layer ? p.mod1 : p.mod0;
        float a0[4] = {0.f, 0.f, 0.f, 0.f}, a1[4] = {0.f, 0.f, 0.f, 0.f}, a2[4] = {0.f, 0.f, 0.f, 0.f};
        const int kbeg = kh * 1024 + wave * 128;
#pragma unroll 8
        for (int k = kbeg; k < kbeg + 128; ++k) {
            const float4 wv = *(const float4*)(w + (size_t)k * MODW);
            const float c0 = cs[k], c1 = cs[DM + k], c2 = cs[2 * DM + k];
            a0[0] += c0 * wv.x; a0[1] += c0 * wv.y; a0[2] += c0 * wv.z; a0[3] += c0 * wv.w;
            a1[0] += c1 * wv.x; a1[1] += c1 * wv.y; a1[2] += c1 * wv.z; a1[3] += c1 * wv.w;
            a2[0] += c2 * wv.x; a2[1] += c2 * wv.y; a2[2] += c2 * wv.z; a2[3] += c2 * wv.w;
        }
        *(float4*)(red + (wave * 3 + 0) * 256 + lane * 4) = make_float4(a0[0], a0[1], a0[2], a0[3]);
        *(float4*)(red + (wave * 3 + 1) * 256 + lane * 4) = make_float4(a1[0], a1[1], a1[2], a1[3]);
        *(float4*)(red + (wave * 3 + 2) * 256 + lane * 4) = make_float4(a2[0], a2[1], a2[2], a2[3]);
        __syncthreads();
        for (int q = tid; q < 768; q += NTHR) {
            const int r = q >> 8, c = q & 255;
            float sum = kh ? 0.f : b[cb + c];
#pragma unroll
            for (int w8 = 0; w8 < 8; ++w8) sum += red[(w8 * 3 + r) * 256 + c];
            unsafeAtomicAdd(out + r * MODW + cb + c, sum);
        }
        __syncthreads();
    }
}

__device__ __forceinline__ void ph_norm(const float* src_lat, const float* src_ctx, const float* gain, const float* mod, int shift_idx, int scale_idx,
                        bf16_t* out, int nrows, float* lds, int wg, int nwg,
                        const float* part = nullptr, int nparts = 0, const float* pgate = nullptr, float* wb = nullptr) {
    (void)lds;
    const int tid = ptid(), wave = tid >> 6, lane = tid & 63;
    for (int row = wg * 8 + wave; row < nrows; row += nwg * 8) {
        const float4* x = (const float4*)(row < NL ? src_lat + (size_t)row * DM : src_ctx + (size_t)(row - NL) * DM);
        float4 v[8];
#pragma unroll
        for (int q = 0; q < 8; ++q) v[q] = x[lane + 64 * q];
        if (part != nullptr && row >= NL) {
#pragma unroll
            for (int q = 0; q < 8; ++q) {
                float4 a = make_float4(0.f, 0.f, 0.f, 0.f);
                for (int sidx = 0; sidx < nparts; ++sidx) { const float4 t = ((const float4*)(part + ((size_t)sidx * NC + (row - NL)) * DM))[lane + 64 * q]; a.x += t.x; a.y += t.y; a.z += t.z; a.w += t.w; }
                const float4 g4 = ((const float4*)pgate)[lane + 64 * q];
                v[q].x += g4.x * a.x; v[q].y += g4.y * a.y; v[q].z += g4.z * a.z; v[q].w += g4.w * a.w;
                if (wb) ((float4*)(wb + (size_t)row * DM))[lane + 64 * q] = v[q];
            }
        }
        float ss = 0.f;
#pragma unroll
        for (int q = 0; q < 8; ++q) ss += v[q].x * v[q].x + v[q].y * v[q].y + v[q].z * v[q].z + v[q].w * v[q].w;
        ss = wave_sum(ss);
        const float rs = rsqrtf(ss * (1.f / DM) + 1e-6f);
        const int g = rowgrp(row);
#pragma unroll
        for (int q = 0; q < 8; ++q) {
            const float4 gn = ((const float4*)gain)[lane + 64 * q];
            const float4 sh = ((const float4*)(mod + g * MODW + shift_idx * DM))[lane + 64 * q];
            const float4 sc = ((const float4*)(mod + g * MODW + scale_idx * DM))[lane + 64 * q];
            uint2 o;
            o.x = cvt_pk_bf16(v[q].x * rs * gn.x * (1.f + sc.x) + sh.x, v[q].y * rs * gn.y * (1.f + sc.y) + sh.y);
            o.y = cvt_pk_bf16(v[q].z * rs * gn.z * (1.f + sc.z) + sh.z, v[q].w * rs * gn.w * (1.f + sc.w) + sh.w);
            ((uint2*)(out + (size_t)row * DM))[lane + 64 * q] = o;
        }
    }
}

struct EpiF32Store {
    static constexpr bool PERM = false, AFTER_DRAIN = false;
    float* C; int ldc; int nn;
    __device__ __forceinline__ void operator()(const pg8::f32x4 (&acc)[2][2][4][2], const pg8::Unit& u, int wr, int wc, int fr, int fq) const {
        const int row0 = u.pm * 256 + wr * 64 + fr, pnl = nn ? u.pn % nn : u.pn, col0 = pnl * 256 + wc * 32 + 4 * fq;
#pragma unroll
        for (int ai = 0; ai < 2; ++ai)
#pragma unroll
            for (int m = 0; m < 4; ++m) { float* rowp = C + (size_t)(row0 + ai * 128 + m * 16) * ldc + col0;
#pragma unroll
                for (int bj = 0; bj < 2; ++bj)
#pragma unroll
                    for (int n = 0; n < 2; ++n) *(pg8::f32x4*)(rowp + bj * 128 + n * 16) = acc[ai][bj][m][n]; }
    }
};
struct EpiResGate {
    static constexpr bool PERM = false, AFTER_DRAIN = false;
    const float* res_lat; const float* res_ctx; const float* gate; float* C;
    __device__ __forceinline__ void operator()(const pg8::f32x4 (&acc)[2][2][4][2], const pg8::Unit& u, int wr, int wc, int fr, int fq) const {
        const int row0 = u.pm * 256 + wr * 64 + fr, col0 = u.pn * 256 + wc * 32 + 4 * fq;
#pragma unroll
        for (int ai = 0; ai < 2; ++ai)
#pragma unroll
            for (int m = 0; m < 4; ++m) { const int row = row0 + ai * 128 + m * 16;
                const float* rp = (row < NL ? res_lat + (size_t)row * DM : res_ctx + (size_t)(row - NL) * DM) + col0;
                const float* gp = gate + rowgrp(row) * MODW + col0;
                float* cp = C + (size_t)row * DM + col0;
#pragma unroll
                for (int bj = 0; bj < 2; ++bj)
#pragma unroll
                    for (int n = 0; n < 2; ++n) { const pg8::f32x4 r = *(const pg8::f32x4*)(rp + bj * 128 + n * 16), g = *(const pg8::f32x4*)(gp + bj * 128 + n * 16);
                        *(pg8::f32x4*)(cp + bj * 128 + n * 16) = r + g * acc[ai][bj][m][n]; } }
    }
};
struct EpiCtxPartial {
    static constexpr bool PERM = false, AFTER_DRAIN = false;
    float* P; int ksub;
    __device__ __forceinline__ void operator()(const pg8::f32x4 (&acc)[2][2][4][2], const pg8::Unit& u, int wr, int wc, int fr, int fq) const {
        const int row0 = (u.pm - 32) * 256 + wr * 64 + fr, col0 = u.pn * 256 + wc * 32 + 4 * fq; float* base = P + (size_t)(u.k0 / ksub) * NC * DM;
#pragma unroll
        for (int ai = 0; ai < 2; ++ai)
#pragma unroll
            for (int m = 0; m < 4; ++m) { float* rowp = base + (size_t)(row0 + ai * 128 + m * 16) * DM + col0;
#pragma unroll
                for (int bj = 0; bj < 2; ++bj)
#pragma unroll
                    for (int n = 0; n < 2; ++n) *(pg8::f32x4*)(rowp + bj * 128 + n * 16) = acc[ai][bj][m][n]; }
    }
};
struct EpiTailPartial {
    static constexpr bool PERM = false, AFTER_DRAIN = false;
    float* P; int ntm, nN, lo, ntail, ksub;
    __device__ __forceinline__ void operator()(const pg8::f32x4 (&acc)[2][2][4][2], const pg8::Unit& u, int wr, int wc, int fr, int fq) const {
        const int pnl = u.pn % nN, t = pnl * ntm + u.pm - lo, ks = u.k0 / ksub;
        float* base = P + (size_t)(ks * ntail + t) * 65536 + (wr * 64 + fr) * 256 + wc * 32 + 4 * fq;
#pragma unroll
        for (int ai = 0; ai < 2; ++ai)
#pragma unroll
            for (int m = 0; m < 4; ++m) { float* rowp = base + (ai * 128 + m * 16) * 256;
#pragma unroll
                for (int bj = 0; bj < 2; ++bj)
#pragma unroll
                    for (int n = 0; n < 2; ++n) *(pg8::f32x4*)(rowp + bj * 128 + n * 16) = acc[ai][bj][m][n]; }
    }
};
struct EpiBf16Store {
    static constexpr bool PERM = true, AFTER_DRAIN = false;
    bf16_t* O; int ldc; float* side; int side_pn; int nn;
    __device__ __forceinline__ void operator()(const pg8::f32x4 (&acc)[2][2][4][2], const pg8::Unit& u, int wr, int wc, int fr, int fq) const {
        const int row0 = u.pm * 256 + wr * 64 + fr, col0 = (nn ? u.pn % nn : u.pn) * 256 + wc * 32 + 8 * fq;
#pragma unroll
        for (int ai = 0; ai < 2; ++ai)
#pragma unroll
            for (int m = 0; m < 4; ++m) { const int row = row0 + ai * 128 + m * 16; bf16_t* rowp = O + (size_t)row * ldc + col0;
#pragma unroll
                for (int bj = 0; bj < 2; ++bj) { const pg8::f32x4 v0 = acc[ai][bj][m][0], v1 = acc[ai][bj][m][1];
                    pg8::u32x4 w; w.x = cvt_pk_bf16(v0[0], v0[1]); w.y = cvt_pk_bf16(v0[2], v0[3]); w.z = cvt_pk_bf16(v1[0], v1[1]); w.w = cvt_pk_bf16(v1[2], v1[3]);
                    *(pg8::u32x4*)(rowp + bj * 128) = w;
                    if (side != nullptr && u.pn == side_pn) { float* sp = side + (size_t)row * 256 + bj * 128 + wc * 32 + 8 * fq; *(pg8::f32x4*)sp = v0; *(pg8::f32x4*)(sp + 4) = v1; } } }
    }
};
struct EpiSwiglu {
    static constexpr bool PERM = true, AFTER_DRAIN = false;
    bf16_t* O; int ldc; int nn;
    __device__ __forceinline__ void operator()(const pg8::f32x4 (&acc)[2][2][4][2], const pg8::Unit& u, int wr, int wc, int fr, int fq) const {
        const int row0 = u.pm * 256 + wr * 64 + fr, pnl = nn ? u.pn % nn : u.pn, col0 = pnl * 128 + wc * 32 + 8 * fq;
#pragma unroll
        for (int ai = 0; ai < 2; ++ai)
#pragma unroll
            for (int m = 0; m < 4; ++m) { bf16_t* rowp = O + (size_t)(row0 + ai * 128 + m * 16) * ldc + col0;
                const pg8::f32x4 g0 = acc[ai][0][m][0], g1 = acc[ai][0][m][1], u0 = acc[ai][1][m][0], u1 = acc[ai][1][m][1];
                pg8::u32x4 w;
                w.x = cvt_pk_bf16(silu_fast(g0[0]) * u0[0], silu_fast(g0[1]) * u0[1]); w.y = cvt_pk_bf16(silu_fast(g0[2]) * u0[2], silu_fast(g0[3]) * u0[3]);
                w.z = cvt_pk_bf16(silu_fast(g1[0]) * u1[0], silu_fast(g1[1]) * u1[1]); w.w = cvt_pk_bf16(silu_fast(g1[2]) * u1[2], silu_fast(g1[3]) * u1[3]);
                *(pg8::u32x4*)rowp = w; }
    }
};

__device__ __forceinline__ float rp_shift(const bf16_t* P, int row, int col, float mu) {
    int t, T;
    if (row < NL) { t = row % TL; T = TL; } else { t = (row - NL) % TC; T = TC; }
    const bf16_t* pc = P + (size_t)row * L0LD + col;
    const float c = bf2f(pc[0]), pv = t > 0 ? bf2f(pc[-L0LD]) : 0.f, nx = t < T - 1 ? bf2f(pc[L0LD]) : 0.f;
    return c + mu * (0.5f * (pv + nx) - c);
}
__device__ __forceinline__ void ph_lora_wt(const Params& p, int wg, int nwg) {
    const int tid = ptid();
    for (int idx = wg * NTHR + tid; idx < 384 * 1024; idx += nwg * NTHR) {
        const int ch = idx & 1023, j = idx >> 10;
        if (j < 128) p.WTd[((size_t)(j >> 6) * 1024 + ch) * 64 + (j & 63)] = f2bf(p.in[11][(size_t)j * 1024 + ch]);
        else if (j < 256) { const int q = j - 128; p.WTi[((size_t)(q >> 6) * 1024 + ch) * 64 + (q & 63)] = f2bf(p.in[13][(size_t)q * 1024 + ch]); }
        else { const int q = j - 256; p.WTg[(size_t)ch * 128 + q] = f2bf(p.in[14][(size_t)q * 1024 + ch]); }
    }
}
#define RPM_LD 392
__device__ __forceinline__ void ph_rwprep(const Params& p, float* lds, int wg, int nwg) {
    bf16_t* X = (bf16_t*)lds;
    const int tid = ptid(), wave = __builtin_amdgcn_readfirstlane(tid >> 6), lane = tid & 63, r16 = lane & 15, g = lane >> 4;
    for (int item = wg; item < NT / 34; item += nwg) {
        const int rowI = item * 34;
        for (int z = tid; z < 14 * RPM_LD / 2; z += NTHR) ((unsigned*)(X + 34 * RPM_LD))[z] = 0u;
#pragma unroll 2
        for (int q12 = 0; q12 < 26; ++q12) {
            const int idx = tid + q12 * NTHR; if (idx >= 34 * 384) break; const int rr = idx / 384, j = idx % 384; const int row0 = rowI;
            float v = rp_shift(p.P, row0 + rr, 3072 + j, p.in[9][3072 + j]);
            v = j < 128 ? (1.f - 2.f * __builtin_amdgcn_rcpf(1.f + __expf(2.f * v))) : (j < 256 ? v : sigm(v));
            X[rr * RPM_LD + j] = f2bf(v);
        }
        __syncthreads();
#pragma unroll 1
        for (int rt = 0; rt < 3; ++rt) {
        const int row0 = rowI + rt * 16, rowEnd = rowI + 34;
        pg8::bf16x8 af[12];
#pragma unroll
        for (int ks = 0; ks < 12; ++ks) af[ks] = *(const pg8::bf16x8*)(X + (rt * 16 + r16) * RPM_LD + ks * 32 + 8 * g);
#pragma unroll 1
        for (int hh = 0; hh < 2; ++hh) {
            const int h = wave * 2 + hh;
            pg8::f32x4 dA0[4], dA1[4], iA0[4], iA1[4], gG[4];
#pragma unroll
            for (int cb = 0; cb < 4; ++cb) {
                const int chb = h * 64 + cb * 16 + r16;
                pg8::f32x4 z = {0.f, 0.f, 0.f, 0.f};
                dA0[cb] = z; dA1[cb] = z; iA0[cb] = z; iA1[cb] = z; gG[cb] = z;
#pragma unroll
                for (int kk = 0; kk < 2; ++kk) {
                    dA0[cb] = __builtin_amdgcn_mfma_f32_16x16x32_bf16(af[kk], *(const pg8::bf16x8*)(p.WTd + ((size_t)chb) * 64 + kk * 32 + 8 * g), dA0[cb], 0, 0, 0);
                    dA1[cb] = __builtin_amdgcn_mfma_f32_16x16x32_bf16(af[2 + kk], *(const pg8::bf16x8*)(p.WTd + ((size_t)1024 + chb) * 64 + kk * 32 + 8 * g), dA1[cb], 0, 0, 0);
                    iA0[cb] = __builtin_amdgcn_mfma_f32_16x16x32_bf16(af[4 + kk], *(const pg8::bf16x8*)(p.WTi + ((size_t)chb) * 64 + kk * 32 + 8 * g), iA0[cb], 0, 0, 0);
                    iA1[cb] = __builtin_amdgcn_mfma_f32_16x16x32_bf16(af[6 + kk], *(const pg8::bf16x8*)(p.WTi + ((size_t)1024 + chb) * 64 + kk * 32 + 8 * g), iA1[cb], 0, 0, 0);
                }
#pragma unroll
                for (int kk = 0; kk < 4; ++kk)
                    gG[cb] = __builtin_amdgcn_mfma_f32_16x16x32_bf16(af[8 + kk], *(const pg8::bf16x8*)(p.WTg + (size_t)chb * 128 + kk * 32 + 8 * g), gG[cb], 0, 0, 0);
            }
            float* T = lds + 9472 + wave * 2560;
#pragma unroll 1
            for (int half = 0; half < 2; ++half) {
                if (row0 + half * 8 >= rowEnd) break;
                if ((g >> 1) == half) {
#pragma unroll
                    for (int cb = 0; cb < 4; ++cb)
#pragma unroll
                        for (int reg = 0; reg < 4; ++reg) { const int o = (((4 * g + reg) & 7) * 64) + cb * 16 + r16;
                            T[o] = dA0[cb][reg]; T[512 + o] = dA1[cb][reg]; T[1024 + o] = iA0[cb][reg]; T[1536 + o] = iA1[cb][reg]; T[2048 + o] = gG[cb][reg]; }
                }
                const int ch = h * 64 + lane;
                const float mur = p.in[9][ch], muk = p.in[9][1024 + ch], muv = p.in[9][2048 + ch], kkc = p.in[15][ch], ka = p.in[16][ch];
                const float w00 = p.in[10][ch], w01 = p.in[10][1024 + ch], a00 = p.in[12][ch], a01 = p.in[12][1024 + ch];
#pragma unroll 1
                for (int sub = 0; sub < 2; ++sub) {
                if (row0 + half * 8 + sub * 4 >= rowEnd) break;
                float pr_[6], pk_[6], pv_[6];
#pragma unroll
                for (int q = 0; q < 6; ++q) { int rq = row0 + half * 8 + sub * 4 - 1 + q; rq = rq < 0 ? 0 : (rq > NT - 1 ? NT - 1 : rq);
                    const bf16_t* pp = p.P + (size_t)rq * L0LD + ch; pr_[q] = bf2f(pp[0]); pk_[q] = bf2f(pp[1024]); pv_[q] = bf2f(pp[2048]); }
#pragma unroll
                for (int r4 = 0; r4 < 4; ++r4) {
                    const int rr = sub * 4 + r4;
                    const int row = row0 + half * 8 + rr; const size_t o = (size_t)row * 1024 + ch;
                    if (row >= rowEnd) break;
                    const float d0 = T[rr * 64 + lane], d1 = T[512 + rr * 64 + lane], i0 = T[1024 + rr * 64 + lane], i1 = T[1536 + rr * 64 + lane], gv = T[2048 + rr * 64 + lane];
                    int tt, TT; if (row < NL) { tt = row % TL; TT = TL; } else { tt = (row - NL) % TC; TT = TC; }
                    const bool hp = tt > 0, hn = tt < TT - 1;
                    const float rv = pr_[r4 + 1] + mur * (0.5f * ((hp ? pr_[r4] : 0.f) + (hn ? pr_[r4 + 2] : 0.f)) - pr_[r4 + 1]);
                    const float k = pk_[r4 + 1] + muk * (0.5f * ((hp ? pk_[r4] : 0.f) + (hn ? pk_[r4 + 2] : 0.f)) - pk_[r4 + 1]);
                    const float v = pv_[r4 + 1] + muv * (0.5f * ((hp ? pv_[r4] : 0.f) + (hn ? pv_[r4 + 2] : 0.f)) - pv_[r4 + 1]);
                    const float kq = k * kkc; const float ssum = wave_sum(kq * kq); const float kkn = kq * rsqrtf(ssum + 1e-12f);
                    p.R[o] = f2bf(rv); p.V[o] = v; p.G[o] = gv; p.KK[o] = f2bf(kkn);
                    {   const float wlog = -softplusf(-(w00 + d0)) - 0.5f; const float a = sigm(a00 + i0);
                        p.W[0][o] = __expf(-__expf(wlog)); p.NB[0][o] = f2bf(-kkn * a); p.KD[0][o] = f2bf(k * (1.f + (a - 1.f) * ka)); }
                    {   const float wlog = -softplusf(-(w01 + d1)) - 0.5f; const float a = sigm(a01 + i1);
                        p.W[1][o] = __expf(-__expf(wlog)); p.NB[1][o] = f2bf(-kkn * a); p.KD[1][o] = f2bf(k * (1.f + (a - 1.f) * ka)); }
                }
                }
            }
        }
        }
        __syncthreads();
    }
}

typedef float f2v __attribute__((ext_vector_type(2)));
#define RW_TB 32
#define RW_STEPF 336
#define RW_NBLK ((TC + TL) / RW_TB)
#define RW_LJ 11
__device__ __forceinline__ void ph_rwscan(const Params& p, float* lds, int wg, int nwg, int ct_begin) {
    const int tid = ptid(), wave = __builtin_amdgcn_readfirstlane(tid >> 6), lane = tid & 63;
    const bool loader = wave >= 4;
    for (int unit = wg; unit < 256; unit += nwg) {
        const int b = unit >> 7, h = (unit >> 3) & 15, dir = (unit >> 2) & 1, rg = unit & 3;
        const int lt = tid & 255;
        const float* const aW = dir ? p.W[1] : p.W[0]; const bf16_t* const aN = dir ? p.NB[1] : p.NB[0]; const bf16_t* const aD = dir ? p.KD[1] : p.KD[0];
        const int st0 = lt >> 4, st1 = 16 + (lt >> 4), c4l = lt & 15, sth = lt >> 3, c8l = lt & 7, qv = lt < 128 ? lt : 127, stv = qv >> 2, cvl = qv & 3;
        float4 rAW0, rAW1, rAV, rBW0, rBW1, rBV; uint4 rAK, rAN, rAD, rAR, rBK, rBN, rBD, rBR;
#define RW_LOAD_BLOCK(BLK, S) do { const int blk_ = (BLK) < RW_NBLK ? (BLK) : RW_NBLK - 1; const int T_ = blk_ < TC / RW_TB ? TC : TL, base_ = blk_ < TC / RW_TB ? NL + b * TC : b * TL, i0_ = blk_ < TC / RW_TB ? blk_ * RW_TB : (blk_ - TC / RW_TB) * RW_TB; \
        const int ta_ = dir ? T_ - 1 - (i0_ + st0) : i0_ + st0, tb_ = dir ? T_ - 1 - (i0_ + st1) : i0_ + st1, th_ = dir ? T_ - 1 - (i0_ + sth) : i0_ + sth, tv_ = dir ? T_ - 1 - (i0_ + stv) : i0_ + stv; \
        const size_t oa_ = (size_t)(base_ + ta_) * 1024 + h * 64 + c4l * 4, ob_ = (size_t)(base_ + tb_) * 1024 + h * 64 + c4l * 4, oh_ = (size_t)(base_ + th_) * 1024 + h * 64 + c8l * 8, ov_ = (size_t)(base_ + tv_) * 1024 + h * 64 + rg * 16 + cvl * 4; \
        r##S##W0 = *(const float4*)(aW + oa_); r##S##W1 = *(const float4*)(aW + ob_); r##S##K = *(const uint4*)(p.KK + oh_); r##S##N = *(const uint4*)(aN + oh_); \
        r##S##D = *(const uint4*)(aD + oh_); r##S##R = *(const uint4*)(p.R + oh_); r##S##V = *(const float4*)(p.V + ov_); } while (0)
#define RW_BF4LO(U) make_float4(__uint_as_float((U).x << 16), __uint_as_float((U).x & 0xffff0000u), __uint_as_float((U).y << 16), __uint_as_float((U).y & 0xffff0000u))
#define RW_BF4HI(U) make_float4(__uint_as_float((U).z << 16), __uint_as_float((U).z & 0xffff0000u), __uint_as_float((U).w << 16), __uint_as_float((U).w & 0xffff0000u))
#define RW_WRITE_BLOCK(BUF, S) do { float4* wq_ = (float4*)(BUF); wq_[st0 * 84 + c4l * 5] = r##S##W0; wq_[st1 * 84 + c4l * 5] = r##S##W1; \
        float4* wh_ = wq_ + sth * 84 + (2 * c8l) * 5 + 1; \
        wh_[0] = RW_BF4LO(r##S##K); wh_[5] = RW_BF4HI(r##S##K); wh_[1] = RW_BF4LO(r##S##N); wh_[6] = RW_BF4HI(r##S##N); \
        wh_[2] = RW_BF4LO(r##S##D); wh_[7] = RW_BF4HI(r##S##D); wh_[3] = RW_BF4LO(r##S##R); wh_[8] = RW_BF4HI(r##S##R); \
        wq_[stv * 84 + 80 + cvl] = r##S##V; } while (0)
        float* buf0 = lds; float* buf1 = lds + RW_TB * RW_STEPF;
        float4 cv0, cv1, cv2, cv3, cv4, cv5, cv6, cv7;
        const unsigned long long* cttab = (const unsigned long long*)((const char*)lds + CTTAB_OFF);
        const int cgw = wg * 4 + (wave - 4), cnw = nwg * 4;
        char* const ctlds = (char*)lds + 2 * RW_TB * RW_STEPF * 4 + (wave - 4) * CT_LDS_BYTES;
        if (loader) { RW_LOAD_BLOCK(0, A); RW_WRITE_BLOCK(buf0, A); RW_LOAD_BLOCK(1, A); RW_LOAD_BLOCK(2, B); CT_LOAD(ct_begin + cgw); }
        __syncthreads();
        f2v Sa = {0.f, 0.f}, Sb = {0.f, 0.f};
        float* const Yd = dir ? p.Y[1] : p.Y[0];
        const int seg = lane & 15, vrl = wave * 4 + (lane >> 4);
#define RW_LOADER_STEP(BLK, NXT, S) do { __builtin_amdgcn_s_setprio(0); RW_WRITE_BLOCK(NXT, S); RW_LOAD_BLOCK((BLK) + 3, S); \
        { const int tcur = ct_begin + (BLK) * cnw + cgw; CT_STORE(tcur, ctlds); CT_LOAD(tcur + cnw); } } while (0)
#define RW_CONSUME(BLK, CUR) do { __builtin_amdgcn_s_setprio(3); \
        float ylo = 0.f, yhi = 0.f; \
        const float* sp0 = (CUR) + seg * 20; const float* vp0 = (CUR) + 320 + vrl; \
        float4 w4 = *(const float4*)(sp0), k4 = *(const float4*)(sp0 + 4), n4 = *(const float4*)(sp0 + 8), d4 = *(const float4*)(sp0 + 12), r4 = *(const float4*)(sp0 + 16); \
        float v = vp0[0]; \
        _Pragma("unroll") for (int s = 0; s < RW_TB; ++s) { \
            float4 w4n = w4, k4n = k4, n4n = n4, d4n = d4, r4n = r4; float vn = v; \
            if (s + 1 < RW_TB) { const float* sp = sp0 + (s + 1) * RW_STEPF; \
                w4n = *(const float4*)(sp); k4n = *(const float4*)(sp + 4); n4n = *(const float4*)(sp + 8); d4n = *(const float4*)(sp + 12); r4n = *(const float4*)(sp + 16); \
                vn = vp0[(s + 1) * RW_STEPF]; } \
            __builtin_amdgcn_sched_barrier(0); \
            const f2v wA = {w4.x, w4.y}, wB = {w4.z, w4.w}, kA = {k4.x, k4.y}, kB = {k4.z, k4.w}, nA = {n4.x, n4.y}, nB = {n4.z, n4.w}; \
            const f2v dA = {d4.x, d4.y}, dB = {d4.z, d4.w}, rA = {r4.x, r4.y}, rB = {r4.z, r4.w}; \
            f2v t = Sa * kA; t = __builtin_elementwise_fma(Sb, kB, t); \
            const float sa = dpp_add16(t.x + t.y); \
            const f2v sav = {sa, sa}, vv = {v, v}; \
            const f2v tA = __builtin_elementwise_fma(sav, nA, vv * dA), tB = __builtin_elementwise_fma(sav, nB, vv * dB); \
            Sa = __builtin_elementwise_fma(Sa, wA, tA); Sb = __builtin_elementwise_fma(Sb, wB, tB); \
            f2v yy = Sa * rA; yy = __builtin_elementwise_fma(Sb, rB, yy); \
            const float y = dpp_add16(yy.x + yy.y); \
            if (s < 16) ylo = (seg == s) ? y : ylo; else yhi = (seg == (s - 16)) ? y : yhi; \
            w4 = w4n; k4 = k4n; n4 = n4n; d4 = d4n; r4 = r4n; v = vn; } \
        const int blk_ = (BLK); const int T = blk_ < TC / RW_TB ? TC : TL, base = blk_ < TC / RW_TB ? NL + b * TC : b * TL, i0 = blk_ < TC / RW_TB ? blk_ * RW_TB : (blk_ - TC / RW_TB) * RW_TB; \
        const int ia = i0 + seg, ib = i0 + 16 + seg; \
        const int ta = dir ? T - 1 - ia : ia, tb = dir ? T - 1 - ib : ib; \
        Yd[(size_t)(base + ta) * 1024 + h * 64 + rg * 16 + vrl] = ylo; \
        Yd[(size_t)(base + tb) * 1024 + h * 64 + rg * 16 + vrl] = yhi; \
        __builtin_amdgcn_s_setprio(0); } while (0)
        for (int blk = 0; blk < RW_NBLK; blk += 2) {
            if (loader) RW_LOADER_STEP(blk, buf1, A); else RW_CONSUME(blk, buf0);
            lds_barrier();
            if (loader) RW_LOADER_STEP(blk + 1, buf0, B); else RW_CONSUME(blk + 1, buf1);
            lds_barrier();
        }
        __syncthreads();
    }
}

__device__ __forceinline__ void ph_rwout(const Params& p, int wg, int nwg) {
    const int tid_ = ptid(); const int wave = tid_ >> 6, lane = tid_ & 63;
    for (int row = wg; row < NT; row += nwg) {
#pragma unroll
        for (int hh = 0; hh < 2; ++hh) {
            const int h = wave * 2 + hh;
            const size_t o = (size_t)row * 1024 + h * 64 + lane;
            const float y = p.Y[0][o] + p.Y[1][o];
            const float mu = wave_sum(y) * (1.f / 64.f);
            const float dlt = y - mu;
            const float var = wave_sum(dlt * dlt) * (1.f / 64.f);
            const float yn = dlt * rsqrtf(var + 64e-5f) * p.in[18][h * 64 + lane] + p.in[19][h * 64 + lane];
            const float r = bf2f(p.R[o]), kb = 0.5f * (bf2f(p.KD[0][o]) + bf2f(p.KD[1][o]));
            const float bs = wave_sum(r * kb * p.in[17][h * 64 + lane]);
            p.MIXb[(size_t)row * DM + h * 64 + lane] = f2bf((yn + bs * p.V[o]) * p.G[o]);
        }
    }
}

__device__ __forceinline__ void ph_naprep(const Params& p, float* lds, int wg, int nwg) {
    const int tid = ptid(), wave = tid >> 6, lane = tid & 63;
    {
        const float kb = 8.f * wave_max(fabsf(p.in[21][lane]));
        float bmax[2];
#pragma unroll
        for (int hh = 0; hh < 2; ++hh) { float m = 0.f; for (int i = lane; i < 465; i += 64) m = fmaxf(m, fabsf(p.in[22][(wave * 2 + hh) * 465 + i])); bmax[hh] = wave_max(m); }
        for (int row = wg; row < NT; row += nwg) {
#pragma unroll
            for (int hh = 0; hh < 2; ++hh) {
                const int h = wave * 2 + hh;
                const float q = bf2f(p.P[(size_t)row * L0LD + RWC + h * 64 + lane]);
                const float k = bf2f(p.P[(size_t)row * L0LD + RWC + 1024 + h * 64 + lane]);
                const float qs = wave_sum(q * q) * (1.f / 64.f), ks = wave_sum(k * k) * (1.f / 64.f);
                const float qn = q * rsqrtf(qs + 1e-6f) * p.in[20][lane] * 0.125f, kn = k * rsqrtf(ks + 1e-6f) * p.in[21][lane];
                p.Qb[(size_t)row * 1024 + h * 64 + lane] = f2bf(qn);
                { const int kb_ = row < NL ? row / TL : (row - NL) / TC, tp_ = row < NL ? row % TL : TL + (row - NL) % TC;
                  p.Kb[((((size_t)(kb_ * 16 + h) * 136 + (tp_ >> 5)) * 4 + (lane >> 4)) * 64 + ((lane >> 3) & 1) * 32 + (tp_ & 31)) * 8 + (lane & 7)] = f2bf(kn); }
                const float qq = wave_sum(qn * qn);
                if (lane == 0) p.QM[row * 16 + h] = (sqrtf(qq) * kb * 1.01f + bmax[hh]) * 1.44269504f;
            }
        }
    }
    {
        bf16_t* T = (bf16_t*)lds;
        for (int item = wg; item < 136 * 8; item += nwg) {
            const int tb = item >> 3, hg = item & 7;
            const int row0 = tb < 128 ? tb * 64 : NL + (tb - 128) * 64;
            {
                const int tok = tid >> 3, c16 = (tid & 7) * 16;
                const bf16_t* src = p.P + (size_t)(row0 + tok) * L0LD + RWC + 2048 + hg * 128 + c16;
                const uint4 va4 = *(const uint4*)src, vb4 = *(const uint4*)(src + 8);
                const unsigned wv[8] = {va4.x, va4.y, va4.z, va4.w, vb4.x, vb4.y, vb4.z, vb4.w};
#pragma unroll
                for (int q = 0; q < 8; ++q) { T[(c16 + 2 * q) * 72 + tok] = (bf16_t)(wv[q] & 0xffffu); T[(c16 + 2 * q + 1) * 72 + tok] = (bf16_t)(wv[q] >> 16); }
            }
            __syncthreads();
            {
                const int b = tb < 128 ? tb >> 6 : (tb - 128) >> 2, tile0 = tb < 128 ? (tb & 63) * 2 : 128 + ((tb - 128) & 3) * 2;
#pragma unroll
                for (int q = 0; q < 2; ++q) {
                    const int idx = tid + NTHR * q, ln = idx & 63, sq = (idx >> 6) & 1, nt = (idx >> 7) & 1, tl = (idx >> 8) & 1, hl = idx >> 9;
                    const int rr = ln & 31, hh2 = ln >> 5, ch = hl * 64 + 32 * nt + rr, tk0 = tl * 32 + 16 * sq + 4 * hh2;
                    const uint2 lo = *(const uint2*)(T + ch * 72 + tk0), hi = *(const uint2*)(T + ch * 72 + tk0 + 8);
                    *(uint4*)(p.VTl + ((((size_t)(b * 16 + 2 * hg + hl) * 136 + tile0 + tl) * 2 + nt) * 2 + sq) * 512 + ln * 8) = make_uint4(lo.x, lo.y, hi.x, hi.y);
                }
            }
            __syncthreads();
        }
    }
}

typedef float f32x16 __attribute__((ext_vector_type(16)));
template <bool BAND>
__device__ __forceinline__ void na_tile(const Params& p, const float* tab, const pg8::bf16x8 (&qf)[4], int keyrow0, const bf16_t* vtp, int vstride, int h, int r, int hh,
                                        int kc0, int q, int c0, int browoff, float mq, f32x16& o0, f32x16& o1, float& l) {
    pg8::bf16x8 kf[4];
#pragma unroll
    for (int ks = 0; ks < 4; ++ks) kf[ks] = *(const pg8::bf16x8*)(p.Kb + ((size_t)keyrow0 * 4 + ks) * 512 + (hh * 32 + r) * 8);
    pg8::bf16x8 vf[2][2];
#pragma unroll
    for (int nt = 0; nt < 2; ++nt)
#pragma unroll
        for (int s = 0; s < 2; ++s) vf[nt][s] = *(const pg8::bf16x8*)(vtp + ((nt * 2 + s) * 64 + hh * 32 + r) * 8);
    f32x16 sacc;
#pragma unroll
    for (int i = 0; i < 16; ++i) sacc[i] = 0.f;
#pragma unroll
    for (int ks = 0; ks < 4; ++ks) sacc = __builtin_amdgcn_mfma_f32_32x32x16_bf16(kf[ks], qf[ks], sacc, 0, 0, 0);
    float pv[16];
#pragma unroll
    for (int reg = 0; reg < 16; ++reg) {
        float sc = sacc[reg];
        if (BAND) {
            const int kc = kc0 + (reg & 3) + 8 * (reg >> 2) + 4 * hh;
            const bool valid = (unsigned)(kc - c0) < 16u;
            const int bi = valid ? browoff + kc - q + 15 : 0;
            sc += tab[bi];
            pv[reg] = valid ? __builtin_amdgcn_exp2f(sc * 1.44269504f - mq) : 0.f;
        } else pv[reg] = __builtin_amdgcn_exp2f(sc * 1.44269504f - mq);
        l += pv[reg];
    }
    pg8::bf16x8 pf[2];
#pragma unroll
    for (int s = 0; s < 2; ++s) { const pg8::u32x4 w = {cvt_pk_bf16(pv[8 * s], pv[8 * s + 1]), cvt_pk_bf16(pv[8 * s + 2], pv[8 * s + 3]), cvt_pk_bf16(pv[8 * s + 4], pv[8 * s + 5]), cvt_pk_bf16(pv[8 * s + 6], pv[8 * s + 7])};
        pf[s] = __builtin_bit_cast(pg8::bf16x8, w); }
#pragma unroll
    for (int s = 0; s < 2; ++s) { o0 = __builtin_amdgcn_mfma_f32_32x32x16_bf16(vf[0][s], pf[s], o0, 0, 0, 0); o1 = __builtin_amdgcn_mfma_f32_32x32x16_bf16(vf[1][s], pf[s], o1, 0, 0, 0); }
}
__device__ __forceinline__ void ph_naattn(const Params& p, float* lds, int wg, int nwg) {
    const int tid = ptid(), wave = __builtin_amdgcn_readfirstlane(tid >> 6), lane = tid & 63, r = lane & 31, hh = lane >> 5;
    float* tab = lds + wave * 512;
    for (int u = wg * 8 + wave; u < 4096 + 256; u += nwg * 8) {
        int b, h, qrow0, nband = 0, gr = 0, r0 = 0, q0 = 0;
        if (u < 4096) { h = u & 15; int x = u >> 4; q0 = (x & 1) * 32; x >>= 1; gr = x & 63; b = x >> 6; qrow0 = b * TL + gr * 64 + q0; r0 = gr - 4; r0 = r0 < 0 ? 0 : (r0 > 56 ? 56 : r0); nband = 8; }
        else { int x = u - 4096; h = x & 15; x >>= 4; b = x >> 3; qrow0 = NL + b * TC + (x & 7) * 32; }
        if (nband) for (int i = lane; i < 465; i += 64) tab[i] = p.in[22][h * 465 + i];
        pg8::bf16x8 qf[4];
#pragma unroll
        for (int ks = 0; ks < 4; ++ks) qf[ks] = *(const pg8::bf16x8*)(p.Qb + (size_t)(qrow0 + r) * 1024 + h * 64 + 16 * ks + 8 * hh);
        const float mq = p.QM[(qrow0 + r) * 16 + h];
        f32x16 o0, o1;
#pragma unroll
        for (int i = 0; i < 16; ++i) { o0[i] = 0.f; o1[i] = 0.f; }
        float l = 0.f;
        const int q = q0 + r; int c0 = q - 8; c0 = c0 < 0 ? 0 : (c0 > 48 ? 48 : c0);
        for (int tl = 0; tl < nband * 2; ++tl) {
            const int i = tl >> 1, kt = tl & 1;
            { const int tid_ = (b * 16 + h) * 136 + (r0 + i) * 2 + kt; na_tile<true>(p, tab, qf, tid_, p.VTl + (size_t)tid_ * 2048, TL, h, r, hh, 32 * kt, q, c0, (r0 + i - gr + 7) * 31, mq, o0, o1, l); }
        }
        for (int kt = 0; kt < 8; ++kt)
            { const int tid_ = (b * 16 + h) * 136 + 128 + kt; na_tile<false>(p, tab, qf, tid_, p.VTl + (size_t)tid_ * 2048, TC, h, r, hh, 0, 0, 0, 0, mq, o0, o1, l); }
        l += __shfl_xor(l, 32);
        const float inv = 1.f / l;
        bf16_t* dst = p.MIXb + (size_t)(qrow0 + r) * DM + 1024 + h * 64 + 4 * hh;
#pragma unroll
        for (int g4 = 0; g4 < 4; ++g4) {
            uint2 w0, w1;
            w0.x = cvt_pk_bf16(o0[4 * g4] * inv, o0[4 * g4 + 1] * inv); w0.y = cvt_pk_bf16(o0[4 * g4 + 2] * inv, o0[4 * g4 + 3] * inv);
            w1.x = cvt_pk_bf16(o1[4 * g4] * inv, o1[4 * g4 + 1] * inv); w1.y = cvt_pk_bf16(o1[4 * g4 + 2] * inv, o1[4 * g4 + 3] * inv);
            *(uint2*)(dst + 8 * g4) = w0; *(uint2*)(dst + 32 + 8 * g4) = w1;
        }
    }
}

#define GLA_NCH 68
#define GLA_LDP 264
__device__ __forceinline__ void ph_glaprep(const Params& p, float* lds, int wg, int nwg) {
    bf16_t* Qs = (bf16_t*)lds;
    bf16_t* Ks = Qs + 64 * GLA_LDP;
    float* lrs = (float*)(Ks + 64 * GLA_LDP);
    float* hsum = lrs + 64 * 16;
    const int tid = ptid(), wave = __builtin_amdgcn_readfirstlane(tid >> 6), lane = tid & 63;
    for (int unit = wg; unit < 16 * GLA_NCH; unit += nwg) {
        const int bhd = unit / GLA_NCH, c = unit % GLA_NCH;
        const int b = bhd >> 3, h = (bhd >> 1) & 3, dir = bhd & 1;
        const bool isctx = c < 4;
        const int T = isctx ? TC : TL, base = isctx ? NL + b * TC : b * TL, cc = isctx ? c : c - 4;
        for (int q = tid; q < 64 * 16; q += NTHR) { const int i = q >> 4, j = q & 15, idx = cc * 64 + i, t = dir ? T - 1 - idx : idx;
            lrs[q] = p.LRs[(size_t)(base + t) * 256 + 16 * dir + j]; }
#pragma unroll
        for (int q4 = 0; q4 < 4; ++q4) { const int e = tid + q4 * NTHR, i = e >> 5, c8 = e & 31, idx = cc * 64 + i, t = dir ? T - 1 - idx : idx;
            const bf16_t* pr = p.P + (size_t)(base + t) * L1LD + h * 256 + c8 * 8;
            *(uint4*)(Ks + i * GLA_LDP + c8 * 8) = *(const uint4*)pr;
            if (!isctx) *(uint4*)(Qs + i * GLA_LDP + c8 * 8) = *(const uint4*)(pr + 3104); }
        __syncthreads();
        {
            const int d = tid & 255, hf = tid >> 8, ch = h * 256 + d;
            float w2[16];
#pragma unroll
            for (int j = 0; j < 16; ++j) w2[j] = p.in[32][(size_t)(dir * 16 + j) * 1024 + ch];
            const float bias = p.in[33][dir * 1024 + ch];
            float lg[32]; float ls = 0.f;
#pragma unroll
            for (int i = 0; i < 32; ++i) { float x = bias;
#pragma unroll
                for (int j = 0; j < 16; ++j) x += lrs[(32 * hf + i) * 16 + j] * w2[j];
                lg[i] = -softplusf(-x) * (1.f / 16.f); ls += lg[i]; }
            hsum[hf * 256 + d] = ls;
            __syncthreads();
            const float bend = hsum[d] + hsum[256 + d];
            float bb = hf ? hsum[d] : 0.f, prev = 0.f; unsigned khp[16];
#pragma unroll
            for (int i = 0; i < 32; ++i) {
                const int ii = 32 * hf + i, idx = cc * 64 + ii, t = dir ? T - 1 - idx : idx;
                bb += lg[i]; (void)t;
                const float k = bf2f(Ks[ii * GLA_LDP + d]);
                const float kh = k * __expf(bend - bb);
                if (!isctx) { const float qt = bf2f(Qs[ii * GLA_LDP + d]) * __expf(bb) * 0.0625f, kt = k * __expf(-bb);
                    const bf16_t qb = f2bf(qt); Qs[ii * GLA_LDP + d] = qb; Ks[ii * GLA_LDP + d] = f2bf(kt); p.QT[(size_t)unit * 16384 + ((((ii >> 4) * 8 + (d >> 5)) * 64 + ((d >> 3) & 3) * 16 + (ii & 15)) * 8) + (d & 7)] = qb; }
                if (i & 1) khp[i >> 1] = cvt_pk_bf16(prev, kh); else prev = kh;
            }
            bf16_t* kd = p.KHT + (size_t)unit * 16384 + ((size_t)(((d >> 4) * 2 + hf) * 64 + (d & 15))) * 8;
#pragma unroll
            for (int q = 0; q < 4; ++q) *(uint4*)(kd + q * 128) = make_uint4(khp[4 * q], khp[4 * q + 1], khp[4 * q + 2], khp[4 * q + 3]);
            if (hf == 0) p.DEC[unit * 256 + d] = __expf(bend);
        }
        {
            const int v0 = tid;
            unsigned va[32];
#pragma unroll
            for (int i = 0; i < 64; i += 2) {
                const int idx0 = cc * 64 + i, t0 = dir ? T - 1 - idx0 : idx0, t1 = dir ? t0 - 1 : t0 + 1;
                const unsigned x0 = p.P[(size_t)(base + t0) * L1LD + 1024 + h * 512 + v0];
                const unsigned x1 = p.P[(size_t)(base + t1) * L1LD + 1024 + h * 512 + v0];
                va[i >> 1] = x0 | (x1 << 16);
            }
            bf16_t* d0 = p.VT + (size_t)unit * 32768 + ((size_t)((v0 >> 4) * 2 * 64 + (v0 & 15))) * 8;
#pragma unroll
            for (int q = 0; q < 8; ++q) *(uint4*)(d0 + ((q >> 2) * 64 + (q & 3) * 16) * 8) = make_uint4(va[4 * q], va[4 * q + 1], va[4 * q + 2], va[4 * q + 3]);
        }
        __syncthreads();
        if (!isctx) {
            const int r = lane & 15, g = lane >> 4, ti = wave >> 1;
#pragma unroll
            for (int q = 0; q < 2; ++q) {
                const int tj = (wave & 1) * 2 + q;
                pg8::f32x4 acc = {0.f, 0.f, 0.f, 0.f};
                if (tj <= ti) {
#pragma unroll
                    for (int ks = 0; ks < 8; ++ks) {
                        const pg8::bf16x8 a = *(const pg8::bf16x8*)(Ks + (tj * 16 + r) * GLA_LDP + ks * 32 + 8 * g);
                        const pg8::bf16x8 bq = *(const pg8::bf16x8*)(Qs + (ti * 16 + r) * GLA_LDP + ks * 32 + 8 * g);
                        acc = __builtin_amdgcn_mfma_f32_16x16x32_bf16(a, bq, acc, 0, 0, 0);
                    }
                }
                const int i = ti * 16 + r, j0 = tj * 16 + 4 * g;
                uint2 o;
                o.x = cvt_pk_bf16(j0 + 0 <= i ? acc[0] : 0.f, j0 + 1 <= i ? acc[1] : 0.f);
                o.y = cvt_pk_bf16(j0 + 2 <= i ? acc[2] : 0.f, j0 + 3 <= i ? acc[3] : 0.f);
                *(uint2*)(p.AM + (size_t)unit * 4096 + ((((i >> 4) * 2 + (j0 >> 5)) * 64 + ((j0 >> 3) & 3) * 16 + (i & 15)) * 8) + (j0 & 7)) = o;
            }
        }
        __syncthreads();
    }
}

#define GLA_LOAD_O(QT_, AM_, C_) do { const int c_ = (C_) < GLA_NCH ? (C_) : GLA_NCH - 1; const size_t u = (size_t)(bhd * GLA_NCH + c_); \
        _Pragma("unroll") for (int ks = 0; ks < 8; ++ks) QT_[ks] = *(const pg8::bf16x8*)(p.QT + u * 16384 + ((it * 8 + ks) * 64 + lane) * 8); \
        _Pragma("unroll") for (int ks = 0; ks < 2; ++ks) AM_[ks] = *(const pg8::bf16x8*)(p.AM + u * 4096 + ((it * 2 + ks) * 64 + lane) * 8); } while (0)
#define GLA_LOAD_S(KH_, VT_, DEC_, C_) do { const int c_ = (C_) < GLA_NCH ? (C_) : GLA_NCH - 1; const size_t u = (size_t)(bhd * GLA_NCH + c_); \
    _Pragma("unroll") for (int dt = 0; dt < 2; ++dt) { \
        _Pragma("unroll") for (int ks = 0; ks < 2; ++ks) { \
            KH_[dt][ks] = *(const pg8::bf16x8*)(p.KHT + u * 16384 + (((2 * w + dt) * 2 + ks) * 64 + lane) * 8); \
            VT_[dt][ks] = *(const pg8::bf16x8*)(p.VT + u * 32768 + (((vs * 2 + dt) * 2 + ks) * 64 + lane) * 8); } \
        DEC_[dt] = *(const pg8::f32x4*)(p.DEC + u * 256 + (2 * w + dt) * 16 + 4 * g); } } while (0)
#define GLA_LOAD_OVT(OVT_, C_) do { const size_t u = (size_t)(bhd * GLA_NCH + (C_)); _Pragma("unroll") for (int ks = 0; ks < 2; ++ks) OVT_[ks] = *(const pg8::bf16x8*)(p.VT + (u * 512 + vs * 32 + vt * 16 + r) * 64 + ks * 32 + 8 * g); } while (0)
__device__ __forceinline__ void ph_glascan(const Params& p, float* lds, int wg, int nwg, int gct_begin) {
    const unsigned long long* cttab = (const unsigned long long*)((const char*)lds + CTTAB_OFF);
    bf16_t* ST0 = (bf16_t*)lds; bf16_t* ST1 = ST0 + 32 * GLA_LDP;
    const int tid = ptid(), w = __builtin_amdgcn_readfirstlane(tid >> 6), lane = tid & 63, r = lane & 15, g = lane >> 4;
    const int it = w >> 1, vt = w & 1;
    for (int unit = wg; unit < 256; unit += nwg) {
        const int bhd = (unit & 7) * 2 + ((unit >> 3) & 1), vs = unit >> 4;
        const int b = bhd >> 3, h = (bhd >> 1) & 3, dir = bhd & 1;
        float* const Od = dir ? p.O[1] : p.O[0];
        for (int q = tid; q < 32 * GLA_LDP / 2; q += NTHR) ((unsigned*)ST0)[q] = 0u;
        pg8::f32x4 acc[2][2];
#pragma unroll
        for (int a = 0; a < 2; ++a)
#pragma unroll
            for (int c2 = 0; c2 < 2; ++c2) acc[a][c2] = (pg8::f32x4){0.f, 0.f, 0.f, 0.f};
        __syncthreads();
        pg8::bf16x8 cqt[8], cam[2], ckh[2][2], cvt[2][2], nkh[2][2], nvt[2][2]; pg8::f32x4 cdec[2], ndec[2];
        const pg8::bf16x8 zz = {0, 0, 0, 0, 0, 0, 0, 0};
#pragma unroll
        for (int ks = 0; ks < 8; ++ks) cqt[ks] = zz;
#pragma unroll
        for (int ks = 0; ks < 2; ++ks) cam[ks] = zz;
        GLA_LOAD_S(ckh, cvt, cdec, 0);
        float4 cv0, cv1, cv2, cv3, cv4, cv5, cv6, cv7; CT_LOAD(gct_begin + wg * 8 + w);
        const int gct_nch = (CT_TOTAL - gct_begin + nwg * 8 - 1) / (nwg * 8);
        for (int c = 0; c < GLA_NCH; ++c) {
            GLA_LOAD_S(nkh, nvt, ndec, c + 1);
            bf16_t* STc = (c & 1) ? ST1 : ST0; bf16_t* STn = (c & 1) ? ST0 : ST1;
#pragma unroll
            for (int dt = 0; dt < 2; ++dt)
#pragma unroll
                for (int v2 = 0; v2 < 2; ++v2) {
                    pg8::f32x4 a = acc[dt][v2] * cdec[dt];
#pragma unroll
                    for (int ks = 0; ks < 2; ++ks) a = __builtin_amdgcn_mfma_f32_16x16x32_bf16(ckh[dt][ks], cvt[v2][ks], a, 0, 0, 0);
                    acc[dt][v2] = a;
                    uint2 sv; sv.x = cvt_pk_bf16(a[0], a[1]); sv.y = cvt_pk_bf16(a[2], a[3]);
                    *(uint2*)(STn + (v2 * 16 + r) * GLA_LDP + (2 * w + dt) * 16 + 4 * g) = sv;
                }
            if (c >= 4) {
                pg8::f32x4 o = {0.f, 0.f, 0.f, 0.f};
#pragma unroll
                for (int ks = 0; ks < 8; ++ks) { const pg8::bf16x8 sa = *(const pg8::bf16x8*)(STc + (vt * 16 + r) * GLA_LDP + ks * 32 + 8 * g);
                    o = __builtin_amdgcn_mfma_f32_16x16x32_bf16(sa, cqt[ks], o, 0, 0, 0); }
                if (vt == 0) {
#pragma unroll
                    for (int ks = 0; ks < 2; ++ks) o = __builtin_amdgcn_mfma_f32_16x16x32_bf16(cvt[0][ks], cam[ks], o, 0, 0, 0);
                } else {
#pragma unroll
                    for (int ks = 0; ks < 2; ++ks) o = __builtin_amdgcn_mfma_f32_16x16x32_bf16(cvt[1][ks], cam[ks], o, 0, 0, 0);
                }
                const int idx = (c - 4) * 64 + it * 16 + r, t = dir ? TL - 1 - idx : idx;
                *(pg8::f32x4*)(Od + (size_t)(b * TL + t) * DM + h * 512 + vs * 32 + vt * 16 + 4 * g) = o;
            }
            if (c >= 3) GLA_LOAD_O(cqt, cam, c + 1);
#pragma unroll
            for (int ks = 0; ks < 2; ++ks) { cdec[ks] = ndec[ks];
#pragma unroll
                for (int q = 0; q < 2; ++q) { ckh[ks][q] = nkh[ks][q]; cvt[ks][q] = nvt[ks][q]; } }
            {
                const int tconv = gct_begin + c * (nwg * 8) + wg * 8 + w;
                if (c < gct_nch) { CT_STORE(tconv, 0); if (c + 1 < gct_nch) CT_LOAD(tconv + nwg * 8); }
            }
            lds_barrier();
        }
    }
}

__device__ __forceinline__ void ph_glaout(const Params& p, float* lds, int wg, int nwg) {
    (void)lds;
    const int tid = ptid(), wave = tid >> 6, lane = tid & 63;
    for (int row = wg * 8 + wave; row < NL; row += nwg * 8) {
        float4 o[8]; float hs[4] = {0.f, 0.f, 0.f, 0.f};
#pragma unroll
        for (int q = 0; q < 8; ++q) { const float4 a = ((const float4*)(p.O[0] + (size_t)row * DM))[lane + 64 * q], c = ((const float4*)(p.O[1] + (size_t)row * DM))[lane + 64 * q];
            o[q] = make_float4(a.x + c.x, a.y + c.y, a.z + c.z, a.w + c.w); hs[q >> 1] += o[q].x * o[q].x + o[q].y * o[q].y + o[q].z * o[q].z + o[q].w * o[q].w; }
#pragma unroll
        for (int hd = 0; hd < 4; ++hd) hs[hd] = rsqrtf(wave_sum(hs[hd]) * (1.f / 512.f) + 1e-6f);
#pragma unroll
        for (int q = 0; q < 8; ++q) {
            const float rs = hs[q >> 1];
            const float4 gn = ((const float4*)p.in[34])[lane + 64 * (q & 1)];
            const uint2 ogr = ((const uint2*)(p.P + (size_t)row * L1LD + 4128))[lane + 64 * q];
            const float4 og = make_float4(__uint_as_float(ogr.x << 16), __uint_as_float(ogr.x & 0xffff0000u), __uint_as_float(ogr.y << 16), __uint_as_float(ogr.y & 0xffff0000u));
            uint2 r;
            r.x = cvt_pk_bf16(o[q].x * rs * gn.x * siluf(og.x), o[q].y * rs * gn.y * siluf(og.y));
            r.y = cvt_pk_bf16(o[q].z * rs * gn.z * siluf(og.z), o[q].w * rs * gn.w * siluf(og.w));
            ((uint2*)(p.MIXb + (size_t)row * DM))[lane + 64 * q] = r;
        }
    }
}

__device__ __forceinline__ void ph_route(const Params& p, float* lds, int wg, int nwg) {
    float* rt = lds;
    const int tid = ptid(), wave = tid >> 6, lane = tid & 63;
    for (int i = tid; i < DM * 2; i += NTHR) { const float4 r = ((const float4*)p.in[36])[i]; const int k = i >> 1, e0 = (i & 1) * 4;
        rt[(e0 + 0) * DM + k] = r.x; rt[(e0 + 1) * DM + k] = r.y; rt[(e0 + 2) * DM + k] = r.z; rt[(e0 + 3) * DM + k] = r.w; }
    __syncthreads();
    for (int row = wg * 8 + wave; row < NL; row += nwg * 8) {
        float ss = 0.f;
#pragma unroll
        for (int q = 0; q < 8; ++q) { const float4 t = ((const float4*)(p.XA + (size_t)row * DM))[lane + 64 * q]; ss += t.x * t.x + t.y * t.y + t.z * t.z + t.w * t.w; }
        ss = wave_sum(ss);
        const float rs = rsqrtf(ss * (1.f / DM) + 1e-6f);
        const int g = row / TL;
        float l[8];
#pragma unroll
        for (int e = 0; e < 8; ++e) l[e] = 0.f;
#pragma unroll 2
        for (int q = 0; q < 8; ++q) {
            const int idx = lane + 64 * q;
            const float4 vq = ((const float4*)(p.XA + (size_t)row * DM))[idx];
            const float4 gn = ((const float4*)p.in[30])[idx];
            const float4 sh = ((const float4*)(p.mod1 + g * MODW + 3 * DM))[idx];
            const float4 sc = ((const float4*)(p.mod1 + g * MODW + 4 * DM))[idx];
            float4 hv;
            hv.x = vq.x * rs * gn.x * (1.f + sc.x) + sh.x; hv.y = vq.y * rs * gn.y * (1.f + sc.y) + sh.y;
            hv.z = vq.z * rs * gn.z * (1.f + sc.z) + sh.z; hv.w = vq.w * rs * gn.w * (1.f + sc.w) + sh.w;
            uint2 hb; hb.x = cvt_pk_bf16(hv.x, hv.y); hb.y = cvt_pk_bf16(hv.z, hv.w);
            ((uint2*)(p.Hb + (size_t)row * DM))[idx] = hb;
#pragma unroll
            for (int e = 0; e < 8; ++e) { const float4 r = ((const float4*)(rt + e * DM))[idx]; l[e] += hv.x * r.x + hv.y * r.y + hv.z * r.z + hv.w * r.w; }
        }
#pragma unroll
        for (int e = 0; e < 8; ++e) l[e] = wave_sum(l[e]);
        if (lane == 0) {
            int e0 = 0; float v0 = l[0];
#pragma unroll
            for (int e = 1; e < 8; ++e) if (l[e] > v0) { v0 = l[e]; e0 = e; }
            int e1 = -1; float v1 = -3.0e38f;
#pragma unroll
            for (int e = 0; e < 8; ++e) if (e != e0 && l[e] > v1) { v1 = l[e]; e1 = e; }
            const float w1 = 1.f / (1.f + expf(v0 - v1)), w0 = 1.f - w1;
            p.tok_e[row * 2] = e0; p.tok_e[row * 2 + 1] = e1; p.tok_w[row * 2] = w0; p.tok_w[row * 2 + 1] = w1;
        }
    }
    __syncthreads();
}

__device__ __forceinline__ void ph_dispatch_permute(const Params& p, float* lds, int wg, int nwg) {
    int* wtot = (int*)lds;
    int* pairs = wtot + 64;
    const int tid = ptid(), wave = tid >> 6, lane = tid & 63;
    int c[8];
#pragma unroll
    for (int e = 0; e < 8; ++e) c[e] = 0;
    for (int i = 0; i < 16; ++i) { const int tok = tid * 16 + i; const int ea = p.tok_e[tok * 2], eb = p.tok_e[tok * 2 + 1];
#pragma unroll
        for (int e = 0; e < 8; ++e) c[e] += (e == ea) + (e == eb); }
    int inc[8];
#pragma unroll
    for (int e = 0; e < 8; ++e) { int v = c[e];
#pragma unroll
        for (int o = 1; o < 64; o <<= 1) { const int t = __shfl_up(v, o); if (lane >= o) v += t; }
        inc[e] = v; }
    if (lane == 63) {
#pragma unroll
        for (int e = 0; e < 8; ++e) wtot[wave * 8 + e] = inc[e]; }
    __syncthreads();
    int pos[8], off[8], tot[8]; int total = 0;
#pragma unroll
    for (int e = 0; e < 8; ++e) { int base = 0, t = 0;
#pragma unroll
        for (int w8 = 0; w8 < 8; ++w8) { const int x = wtot[w8 * 8 + e]; base += (w8 < wave) ? x : 0; t += x; }
        tot[e] = t; off[e] = total; pos[e] = total + base + inc[e] - c[e]; total += ((t + 255) >> 8) << 8; }
    if (wg == 0 && tid == 0) {
#pragma unroll
        for (int e = 0; e < 8; ++e) { p.meta[e * 2] = tot[e]; p.meta[e * 2 + 1] = off[e]; const int nt = (tot[e] + 255) >> 8; for (int t = 0; t < nt; ++t) p.tile_e[(off[e] >> 8) + t] = e; }
        p.meta[16] = total;
    }
    int sl[32];
#pragma unroll
    for (int i = 0; i < 16; ++i) {
        const int tok = tid * 16 + i;
#pragma unroll
        for (int k = 0; k < 2; ++k) { const int e = p.tok_e[tok * 2 + k]; int sv = 0;
#pragma unroll
            for (int q = 0; q < 8; ++q) if (q == e) { sv = pos[q]; pos[q]++; }
            sl[i * 2 + k] = sv; }
    }
    for (int g = wg; g < NL / 32; g += nwg) {
        __syncthreads();
        if ((tid >> 1) == g) {
#pragma unroll
            for (int i = 0; i < 16; ++i)
#pragma unroll
                for (int k = 0; k < 2; ++k) { const int tok = tid * 16 + i, idx = (tid & 1) * 32 + i * 2 + k; pairs[idx * 2] = tok; pairs[idx * 2 + 1] = sl[i * 2 + k]; p.tok_slot[tok * 2 + k] = sl[i * 2 + k]; }
        }
        __syncthreads();
        const int half = tid >> 8, t4 = tid & 255;
        for (int q = half; q < 64; q += 8) {
            const int tk0 = pairs[q * 2], sv0 = pairs[q * 2 + 1], tk1 = pairs[q * 2 + 4], sv1 = pairs[q * 2 + 5], tk2 = pairs[q * 2 + 8], sv2 = pairs[q * 2 + 9], tk3 = pairs[q * 2 + 12], sv3 = pairs[q * 2 + 13];
            const uint4 r0 = ((const uint4*)(p.Hb + (size_t)tk0 * DM))[t4], r1 = ((const uint4*)(p.Hb + (size_t)tk1 * DM))[t4], r2 = ((const uint4*)(p.Hb + (size_t)tk2 * DM))[t4], r3 = ((const uint4*)(p.Hb + (size_t)tk3 * DM))[t4];
            ((uint4*)(p.Xp + (size_t)sv0 * DM))[t4] = r0; ((uint4*)(p.Xp + (size_t)sv1 * DM))[t4] = r1; ((uint4*)(p.Xp + (size_t)sv2 * DM))[t4] = r2; ((uint4*)(p.Xp + (size_t)sv3 * DM))[t4] = r3;
        }
    }
    {
        const int half = tid >> 8, t4 = tid & 255; int idx = 0;
#pragma unroll
        for (int e = 0; e < 8; ++e) { const int s0 = off[e] + tot[e], s1 = off[e] + (((tot[e] + 255) >> 8) << 8);
            for (int sv = s0 + half; sv < s1; sv += 2) { if (((idx + sv - s0) >> 1) % nwg == wg) ((uint4*)(p.Xp + (size_t)sv * DM))[t4] = make_uint4(0u, 0u, 0u, 0u); }
            idx += s1 - s0; }
    }
}

__device__ __forceinline__ void moe_tail_split(int ntm, int G, int& nfull, int& ntail, int& KS) {
    const int T = ntm * (DM / 256); nfull = (T / G) * G; ntail = T - nfull; KS = ntail == 0 ? 1 : (ntail * 4 <= G ? 4 : (ntail * 2 <= G ? 2 : 1));
    if (KS == 1) { nfull = T; ntail = 0; }
}
__device__ __forceinline__ float4 moe_fetch(const Params& p, int slot, int tid, int ntm, int nfull, int ntail, int KS) {
    const int pm = slot >> 8, pn = tid >> 6, L = pn * ntm + pm;
    if (L < nfull) { const uint2 r = ((const uint2*)(p.YE + (size_t)slot * DM))[tid]; return make_float4(__uint_as_float(r.x << 16), __uint_as_float(r.x & 0xffff0000u), __uint_as_float(r.y << 16), __uint_as_float(r.y & 0xffff0000u)); }
    const int t = L - nfull; float4 a = make_float4(0.f, 0.f, 0.f, 0.f);
    for (int ks = 0; ks < KS; ++ks) { const float4 q = *(const float4*)(p.YEP + (size_t)(ks * ntail + t) * 65536 + (slot & 255) * 256 + (tid & 63) * 4); a.x += q.x; a.y += q.y; a.z += q.z; a.w += q.w; }
    return a;
}
__device__ __forceinline__ void ph_combine(const Params& p, int wg, int nwg) {
    const int tid = ptid(), wave = tid >> 6, lane = tid & 63;
    const int ntm = p.meta[16] >> 8; int nfull, ntail, KS; moe_tail_split(ntm, nwg, nfull, ntail, KS);
    for (int row = wg * 8 + wave; row < NL; row += nwg * 8) {
        const int s0 = p.tok_slot[row * 2], s1 = p.tok_slot[row * 2 + 1];
        const float w0 = p.tok_w[row * 2], w1 = p.tok_w[row * 2 + 1];
#pragma unroll 4
        for (int q = 0; q < 8; ++q) {
            const int idx = lane + 64 * q;
            const float4 x = ((const float4*)(p.XA + (size_t)row * DM))[idx];
            const float4 g = ((const float4*)(p.mod1 + (row / TL) * MODW + 5 * DM))[idx];
            const float4 a = moe_fetch(p, s0, idx, ntm, nfull, ntail, KS), c = moe_fetch(p, s1, idx, ntm, nfull, ntail, KS);
            float4 o;
            o.x = x.x + g.x * (w0 * a.x + w1 * c.x); o.y = x.y + g.y * (w0 * a.y + w1 * c.y);
            o.z = x.z + g.z * (w0 * a.z + w1 * c.z); o.w = x.w + g.w * (w0 * a.w + w1 * c.w);
            ((float4*)(p.out + (size_t)row * DM))[idx] = o;
        }
    }
}

#define GEMM_STATIC(Aptr, Bptr, Mrows, Ncols, Kdim, EPI) do { pg8::Gemm g_{Aptr, Bptr, Kdim, Kdim}; pg8::StaticOrder S_; S_.init(Mrows, Ncols, nwg, wg); \
    pg8::gemm_phase<decltype(EPI), pg8::StaticOrder, true, true>(ldsb, g_, S_, EPI); } while (0)

__global__ void __launch_bounds__(NTHR, 2) k_all(Params p) {
    extern __shared__ __attribute__((aligned(16))) unsigned char dyn_lds[];
    float* lds = (float*)dyn_lds;
    PG8_LAS unsigned char* ldsb = (PG8_LAS unsigned char*)dyn_lds;
    volatile LAS unsigned* xbw = (volatile LAS unsigned*)(dyn_lds + 131072);
    if (threadIdx.x < 4) xbw[threadIdx.x] = 0u;
    if (threadIdx.x == 64) ct_table_init(p, (unsigned long long*)(dyn_lds + CTTAB_OFF));
    __syncthreads();
    XcdBarrier bar = xcd_barrier_post(p.bar, xbw);
    const int wg = blockIdx.x, nwg = gridDim.x;
#ifndef PROBE
#define PROBE 0
#endif
#define RUN(grp, ...) do { for (int rep_ = 0; rep_ < ((PROBE == (grp)) ? 2 : 1); ++rep_) { __VA_ARGS__ } } while (0)
    const int ct_rest = CT_TOTAL - CT_L0 - RW_NBLK * nwg * 4 - GLA_NCH * nwg * 8;
    const int ct_split = CT_L0 + (ct_rest > 0 ? ct_rest : 0);
    RUN(2, ph_mod(p, lds, wg, nwg); __syncthreads(); ph_lora_wt(p, wg, nwg); ph_convert(p, lds, wg, nwg, ct_split);); xcd_barrier(bar);
    RUN(5, ph_norm(p.in[0], p.in[2], p.in[6], p.mod0, 0, 1, p.Hb, NT, lds, wg, nwg);); xcd_barrier(bar);
    RUN(1, { EpiBf16Store E{p.P, L0LD, nullptr, 0, 0}; GEMM_STATIC(p.Hb, p.Wt_in0, NT, L0LD, DM, E); }); xcd_barrier(bar);
    RUN(3, ph_rwprep(p, lds, wg, nwg); ph_naprep(p, lds, wg, nwg);); xcd_barrier(bar);
    RUN(3, ph_rwscan(p, lds, wg, nwg, ct_split); ph_naattn(p, lds, wg, nwg);); xcd_barrier(bar);
    RUN(3, ph_rwout(p, wg, nwg);); xcd_barrier(bar);
    RUN(1, { EpiResGate E{p.in[0], p.in[2], p.mod0 + 2 * DM, p.XA}; GEMM_STATIC(p.MIXb, p.Wt_out0, NL, DM, DM, E); __syncthreads();
      pg8::Gemm g2{p.MIXb, p.Wt_out0, 256, DM}; pg8::CtxSplitOrder S2{DM / 256, 8, 256, nwg, wg}; EpiCtxPartial E2{p.PC, 256};
      pg8::gemm_phase<EpiCtxPartial, pg8::CtxSplitOrder, true, true>(ldsb, g2, S2, E2); }); xcd_barrier(bar);
    RUN(5, ph_norm(p.XA, p.in[2], p.in[7], p.mod0, 3, 4, p.Hb, NT, lds, wg, nwg, p.PC, 8, p.mod0 + 2 * MODW + 2 * DM, p.XA);); xcd_barrier(bar);
    RUN(1, { EpiSwiglu E{p.H1b, FFN, 0}; GEMM_STATIC(p.Hb, p.Wt_ffnup, NT, 2 * FFN, DM, E); }); xcd_barrier(bar);
    RUN(1, { EpiResGate E{p.XA, p.XA + (size_t)NL * DM, p.mod0 + 5 * DM, p.XB}; GEMM_STATIC(p.H1b, p.Wt_ffndn, NL, DM, FFN, E); __syncthreads();
      pg8::Gemm g2{p.H1b, p.Wt_ffndn, 512, FFN}; pg8::CtxSplitOrder S2{DM / 256, 11, 512, nwg, wg}; EpiCtxPartial E2{p.PC, 512};
      pg8::gemm_phase<EpiCtxPartial, pg8::CtxSplitOrder, true, true>(ldsb, g2, S2, E2); }); xcd_barrier(bar);
    RUN(5, ph_norm(p.XB, p.XA + (size_t)NL * DM, p.in[29], p.mod1, 0, 1, p.Hb, NT, lds, wg, nwg, p.PC, 11, p.mod0 + 2 * MODW + 5 * DM, nullptr);); xcd_barrier(bar);
    RUN(1, { EpiBf16Store E{p.P, L1LD, p.LRs, 12, 0}; GEMM_STATIC(p.Hb, p.Wt_in1, NT, L1LD, DM, E); }); xcd_barrier(bar);
    RUN(4, ph_glaprep(p, lds, wg, nwg);); xcd_barrier(bar);
    RUN(4, ph_glascan(p, lds, wg, nwg, ct_split + RW_NBLK * nwg * 4);); xcd_barrier(bar);
    RUN(4, ph_glaout(p, lds, wg, nwg);); xcd_barrier(bar);
    RUN(1, { EpiResGate E{p.XB, p.XB + (size_t)NL * DM, p.mod1 + 2 * DM, p.XA}; GEMM_STATIC(p.MIXb, p.Wt_out1, NL, DM, DM, E); }); xcd_barrier(bar);
    RUN(5, ph_route(p, lds, wg, nwg);); xcd_barrier(bar);
    RUN(5, ph_dispatch_permute(p, lds, wg, nwg);); xcd_barrier(bar);
    RUN(1, { pg8::Gemm g{p.Xp, p.Wt_expup, DM, DM}; pg8::GroupedOrder S{p.meta[16] >> 8, 2 * EXD / 256, nwg, wg, p.tile_e}; EpiSwiglu E{p.H1Eb, EXD, 2 * EXD / 256};
      pg8::gemm_phase<EpiSwiglu, pg8::GroupedOrder, true, true>(ldsb, g, S, E); }); xcd_barrier(bar);
    RUN(1, { const int ntm = p.meta[16] >> 8; int nfull, ntail, KS; moe_tail_split(ntm, nwg, nfull, ntail, KS);
      { pg8::Gemm g{p.H1Eb, p.Wt_expdn, EXD, EXD}; pg8::GroupedRange S{ntm, DM / 256, 0, nfull, nwg, wg, p.tile_e}; EpiBf16Store E{p.YE, DM, nullptr, 0, DM / 256};
        pg8::gemm_phase<EpiBf16Store, pg8::GroupedRange, true, true>(ldsb, g, S, E); }
      __syncthreads();
      { pg8::Gemm g{p.H1Eb, p.Wt_expdn, EXD / KS, EXD}; pg8::GroupedTail S{ntm, DM / 256, nfull, ntail, KS, EXD / KS, nwg, wg, p.tile_e}; EpiTailPartial E{p.YEP, ntm, DM / 256, nfull, ntail, EXD / KS};
        pg8::gemm_phase<EpiTailPartial, pg8::GroupedTail, true, true>(ldsb, g, S, E); } }); xcd_barrier(bar);
    RUN(5, ph_combine(p, wg, nwg););
}

extern "C" void kernel_launch(void* const* d_in, const int* in_sizes, int n_in, void* d_out, int out_size, void* d_ws, size_t ws_size, hipStream_t stream) {
    (void)in_sizes; (void)out_size;
    if (n_in != 40) return;
    Params p;
    memset(&p, 0, sizeof(p));
    for (int i = 0; i < 40; ++i) p.in[i] = (const float*)d_in[i];
    p.out = (float*)d_out;
    char* w = (char*)d_ws;
    size_t o = 0;
    auto take = [&](size_t bytes) { char* r = w + o; o += (bytes + 255) & ~(size_t)255; return (void*)r; };
    p.bar = (unsigned*)take(XCD_BAR_WORDS * 4);
    p.mod0 = (float*)take(3 * MODW * 4); p.mod1 = (float*)take(3 * MODW * 4);
    p.tok_e = (int*)take(NL * 2 * 4); p.tok_w = (float*)take(NL * 2 * 4); p.meta = (int*)take(256); p.slot_token = (int*)take(MAXSLOT * 4); p.tok_slot = (int*)take(NL * 2 * 4);
    p.LRs = (float*)take((size_t)NT * 256 * 4); p.tile_e = (int*)take(128 * 4); p.WTd = (bf16_t*)take(2 * 1024 * 64 * 2); p.WTi = (bf16_t*)take(2 * 1024 * 64 * 2); p.WTg = (bf16_t*)take(1024 * 128 * 2);
    p.Wt_in0 = (bf16_t*)take((size_t)L0LD * DM * 2); p.Wt_out0 = (bf16_t*)take((size_t)DM * DM * 2); p.Wt_ffnup = (bf16_t*)take((size_t)2 * FFN * DM * 2);
    p.Wt_ffndn = (bf16_t*)take((size_t)DM * FFN * 2); p.Wt_in1 = (bf16_t*)take((size_t)L1LD * DM * 2); p.Wt_out1 = (bf16_t*)take((size_t)DM * DM * 2);
    p.Wt_expup = (bf16_t*)take((size_t)NEXP * 2 * EXD * DM * 2); p.Wt_expdn = (bf16_t*)take((size_t)NEXP * DM * EXD * 2);
    p.Hb = (bf16_t*)take((size_t)NT * DM * 2); p.MIXb = (bf16_t*)take((size_t)NT * DM * 2);
    p.XA = (float*)take((size_t)NT * DM * 4); p.XB = (float*)take((size_t)NT * DM * 4);
    p.P = (bf16_t*)take((size_t)NT * L0LD * 4); p.H1b = (bf16_t*)take((size_t)NT * FFN * 2);
    p.H1Eb = (bf16_t*)p.P;
    const size_t mark = o;
    p.PC = (float*)(w + mark);
    p.R = (bf16_t*)take((size_t)NT * 2048); p.V = (float*)take((size_t)NT * 4096); p.KK = (bf16_t*)take((size_t)NT * 2048); p.G = (float*)take((size_t)NT * 4096);
    for (int d = 0; d < 2; ++d) { p.W[d] = (float*)take((size_t)NT * 4096); p.KD[d] = (bf16_t*)take((size_t)NT * 2048); p.NB[d] = (bf16_t*)take((size_t)NT * 2048); p.Y[d] = (float*)take((size_t)NT * 4096); }
    p.Qb = (bf16_t*)take((size_t)NT * 2048); p.Kb = (bf16_t*)take((size_t)32 * 136 * 2048 * 2); p.VTl = (bf16_t*)take((size_t)32 * 136 * 2048 * 2); p.VTc = p.VTl; p.QM = (float*)take((size_t)NT * 16 * 4);
    const size_t end0 = o;
    o = mark;
    p.O[0] = (float*)take((size_t)NL * DM * 4); p.O[1] = (float*)take((size_t)NL * DM * 4);
    p.QT = (bf16_t*)take((size_t)16 * GLA_NCH * 64 * 256 * 2); p.KHT = (bf16_t*)take((size_t)16 * GLA_NCH * 256 * 64 * 2); p.AM = (bf16_t*)take((size_t)16 * GLA_NCH * 64 * 64 * 2);
    p.VT = (bf16_t*)take((size_t)16 * GLA_NCH * 512 * 64 * 2); p.DEC = (float*)take((size_t)16 * GLA_NCH * 256 * 4);
    const size_t end1a = o;
    o = mark;
    p.YE = (bf16_t*)take((size_t)MAXSLOT * DM * 2);
    p.Xp = (bf16_t*)take((size_t)MAXSLOT * DM * 2);
    p.YEP = (float*)take((size_t)256 * 65536 * 4);
    if (o < end1a) o = end1a;
    const size_t end1 = o;
    const size_t need = end0 > end1 ? end0 : end1;
    static int grid = 0;
    if (!grid) {
        int dev = 0, cus = 0, per_cu = 0;
        grid = -1;
        if (need <= ws_size && hipGetDevice(&dev) == hipSuccess && hipDeviceGetAttribute(&cus, hipDeviceAttributeMultiprocessorCount, dev) == hipSuccess &&
            hipFuncSetAttribute((const void*)k_all, hipFuncAttributeMaxDynamicSharedMemorySize, LDS_BYTES) == hipSuccess &&
            hipOccupancyMaxActiveBlocksPerMultiprocessor(&per_cu, (const void*)k_all, NTHR, LDS_BYTES) == hipSuccess && per_cu >= 1) grid = cus < 256 ? cus : 256;
    }
    if (grid < 0) return;
    (void)hipMemsetAsync(p.bar, 0, (size_t)((char*)(p.mod1 + 3 * MODW) - (char*)p.bar), stream);
    hipLaunchKernelGGL(k_all, dim3(grid), dim3(NTHR), LDS_BYTES, stream, p);
}
```

```cpp
#include <hip/hip_runtime.h>
#include <stdint.h>
#include <string.h>

#define DM 2048
#define NL 8192
#define NC 512
#define NT 8704
#define TL 4096
#define TC 256
#define MODW 12288
#define L0C 6528
#define L1C 6176
#define L0LD 6656
#define L1LD 6400
#define RWC 3456
#define FFN 5632
#define EXD 7168
#define NEXP 8
#define NTHR 512
#define MAXSLOT 18432
#define LDS_BYTES (131072 + 64 + 256)

typedef unsigned short bf16_t;
__device__ __forceinline__ int ptid() { int t = threadIdx.x; asm volatile("" : "+v"(t)); return t; }
#define XB_TMO      128
#define XB_XCNT(j)  (256  + 64 * (j))
#define XB_XSUB(j)  (1280 + 64 * (j))
#define XB_XGEN(j)  (2304 + 64 * (j))
#define XB_TOP      3328
#define XB_TOPGEN   3392
#define XCD_BAR_WORDS 3456
#define XB_SPIN_CAP (1u << 22)
#define LAS __attribute__((address_space(3)))
__device__ __forceinline__ unsigned xb_ld(unsigned* p)              { return __hip_atomic_load(p, __ATOMIC_RELAXED, __HIP_MEMORY_SCOPE_AGENT); }
__device__ __forceinline__ unsigned xb_add(unsigned* p, unsigned v) { return __hip_atomic_fetch_add(p, v, __ATOMIC_RELAXED, __HIP_MEMORY_SCOPE_AGENT); }
__device__ __forceinline__ unsigned xb_xcc_id() { return (unsigned)__builtin_amdgcn_s_getreg((3 << 11) | 20) & 0xFu; }
#define XB_SPIN(cond, bar) do { unsigned _sp = 0; while (cond) { __builtin_amdgcn_s_sleep(1); \
    if ((++_sp & 255u) == 0u) { if (xb_ld(&(bar)[XB_TMO])) break; if (_sp > XB_SPIN_CAP) { atomicAdd(&(bar)[XB_TMO], 1u); break; } } } } while (0)
struct XcdBarrier { unsigned* bar; unsigned x; volatile LAS unsigned* st; };
__device__ __forceinline__ XcdBarrier xcd_barrier_post(unsigned* bar, volatile LAS unsigned* st) {
    XcdBarrier b; b.bar = bar; b.x = xb_xcc_id(); b.st = st;
    if (threadIdx.x == 0) (void)xb_add(&bar[XB_XCNT(b.x)], 1u);
    return b;
}
__device__ __forceinline__ void xcd_barrier_complete(unsigned* bar, unsigned x, unsigned& nloc, unsigned& nx) {
    const unsigned G = gridDim.x * gridDim.y * gridDim.z;
    unsigned sum, cnt, mine, sp = 0u;
    for (;;) {
        sum = 0u; cnt = 0u; mine = 0u;
#pragma unroll
        for (unsigned j = 0; j < 16; ++j) { const unsigned c = xb_ld(&bar[XB_XCNT(j)]); sum += c; cnt += (c > 0u) ? 1u : 0u; mine = (j == x) ? c : mine; }
        if (sum == G) break;
        __builtin_amdgcn_s_sleep(1);
        if ((++sp & 255u) == 0u) { if (xb_ld(&bar[XB_TMO])) break; if (sp > XB_SPIN_CAP) { atomicAdd(&bar[XB_TMO], 1u); break; } }
    }
    nloc = mine > 0u ? mine : 1u; nx = cnt > 0u ? cnt : 1u;
}
__device__ __forceinline__ void xcd_barrier(const XcdBarrier& b) {
    asm volatile("s_waitcnt vmcnt(0)" ::: "memory");
    __syncthreads();
    if (threadIdx.x == 0) {
        unsigned* bar = b.bar;
        __builtin_amdgcn_s_waitcnt(0);
        unsigned nloc = b.st[0], nx = b.st[1];
        if (nloc == 0u) { xcd_barrier_complete(bar, b.x, nloc, nx); b.st[0] = nloc; b.st[1] = nx; }
        const unsigned old = xb_add(&bar[XB_XSUB(b.x)], 1u);
        const unsigned gen = old / nloc;
        if (old + 1u == (gen + 1u) * nloc) {
            __builtin_amdgcn_fence(__ATOMIC_RELEASE, "agent");
            asm volatile("s_waitcnt vmcnt(0)" ::: "memory");
            const unsigned og = xb_add(&bar[XB_TOP], 1u);
            const unsigned tg = og / nx;
            if (og + 1u == (tg + 1u) * nx) xb_add(&bar[XB_TOPGEN], 1u);
            else XB_SPIN(xb_ld(&bar[XB_TOPGEN]) == tg, bar);
            __builtin_amdgcn_fence(__ATOMIC_ACQUIRE, "agent");
            xb_add(&bar[XB_XGEN(b.x)], 1u);
            asm volatile("s_waitcnt vmcnt(0)" ::: "memory");
        } else {
            XB_SPIN(xb_ld(&bar[XB_XGEN(b.x)]) == gen, bar);
            __builtin_amdgcn_fence(__ATOMIC_ACQUIRE, "agent");
            asm volatile("s_waitcnt vmcnt(0)" ::: "memory");
        }
    }
    __syncthreads();
}


namespace pg8 {
#define PG8_LAS __attribute__((address_space(3)))
typedef short bf16x8 __attribute__((ext_vector_type(8)));
typedef float f32x4 __attribute__((ext_vector_type(4)));
typedef unsigned u32x4 __attribute__((ext_vector_type(4)));
constexpr int BM = 256, BK = 64, HALF = 128, HTB = HALF * BK * 2, STAGE_BYTES = 8 * HTB, NXCD = 8, WGM = 8;
__host__ __device__ __forceinline__ int lds_byte(int r, int c) { const int st = (r >> 4) * 2 + (c >> 5), rr = r & 15, cc = c & 31, ob = rr * 64 + cc * 2; return st * 1024 + (ob ^ (((ob >> 9) & 1) << 5)); }
__host__ __device__ __forceinline__ void stage_rc(int b, int& R, int& C) { const int st = b / 1024, sb = b % 1024, swz = sb ^ (((sb >> 9) & 1) << 5); R = (st >> 1) * 16 + swz / 64; C = (st & 1) * 32 + (swz % 64) / 2; }
__host__ __device__ __forceinline__ int perm32(int rho) { const int n = rho >> 4, i = rho & 15; return 8 * (i >> 2) + 4 * n + (i & 3); }
struct Unit { int pm, pn, k0; };
struct Gemm { const bf16_t* A; const bf16_t* Bt; int K; int ld; };
struct StaticOrder {
    int nM, nN, nwg, G, c;
    __device__ void init(int M, int N, int G_, int c_) { nM = M / BM; nN = N / BM; nwg = nM * nN; G = G_; c = c_; }
    __device__ bool next(int i, Unit& u) const {
        const long L = (long)i * G + c; if (L >= nwg) return false;
        int wgid = (int)L; { const int q = nwg / NXCD, r = nwg % NXCD, xcd = wgid % NXCD, off = wgid / NXCD; wgid = (xcd < r ? xcd * (q + 1) : r * (q + 1) + (xcd - r) * q) + off; }
        const int nig = WGM * nN, gid = wgid / nig, fm = gid * WGM, gsz = (nM - fm) < WGM ? (nM - fm) : WGM;
        u.pm = fm + ((wgid % nig) % gsz); u.pn = (wgid % nig) / gsz; u.k0 = 0; return true;
    }
    __device__ __forceinline__ void a_ready(const Unit&) const {}
    __device__ __forceinline__ void done(const Unit&) const {}
};
struct CtxSplitOrder {
    int nN, KS, ksub, G, c;
    __device__ bool next(int i, Unit& u) const {
        const long L = (long)i * G + c; if (L >= (long)2 * nN * KS) return false;
        const int l = (int)L; u.pm = 32 + (l & 1); u.pn = (l >> 1) % nN; u.k0 = ((l >> 1) / nN) * ksub; return true;
    }
    __device__ __forceinline__ void a_ready(const Unit&) const {}
    __device__ __forceinline__ void done(const Unit&) const {}
};
struct GroupedRange {
    int ntm, nN, lo, hi, G, c; const int* tile_e;
    __device__ bool next(int i, Unit& u) const {
        const long L0 = (long)i * G + c; const int n = hi - lo; if (L0 >= n) return false;
        int e = (int)L0; { const int q = n / NXCD, r = n % NXCD, xcd = e % NXCD, off = e / NXCD; e = (xcd < r ? xcd * (q + 1) : r * (q + 1) + (xcd - r) * q) + off; }
        const int L = lo + e; const int pm = L % ntm, pn = L / ntm;
        u.pm = pm; u.pn = tile_e[pm] * nN + pn; u.k0 = 0; return true;
    }
    __device__ __forceinline__ void a_ready(const Unit&) const {}
    __device__ __forceinline__ void done(const Unit&) const {}
};
struct GroupedTail {
    int ntm, nN, lo, ntail, KS, ksub, G, c; const int* tile_e;
    __device__ bool next(int i, Unit& u) const {
        const long J = (long)i * G + c; if (J >= (long)ntail * KS) return false;
        const int t = (int)(J % ntail), ks = (int)(J / ntail); const int L = lo + t;
        const int pm = L % ntm, pn = L / ntm;
        u.pm = pm; u.pn = tile_e[pm] * nN + pn; u.k0 = ks * ksub; return true;
    }
    __device__ __forceinline__ void a_ready(const Unit&) const {}
    __device__ __forceinline__ void done(const Unit&) const {}
};
struct GroupedOrder {
    int ntm, nN, G, c; const int* tile_e;
    __device__ bool next(int i, Unit& u) const {
        const int nwg = ntm * nN; const long L = (long)i * G + c; if (L >= nwg) return false;
        int wgid = (int)L; { const int q = nwg / NXCD, r = nwg % NXCD, xcd = wgid % NXCD, off = wgid / NXCD; wgid = (xcd < r ? xcd * (q + 1) : r * (q + 1) + (xcd - r) * q) + off; }
        const int nig = WGM * nN, gid = wgid / nig, fm = gid * WGM, gsz = (ntm - fm) < WGM ? (ntm - fm) : WGM;
        const int pm = fm + ((wgid % nig) % gsz), pn = (wgid % nig) / gsz;
        u.pm = pm; u.pn = tile_e[pm] * nN + pn; u.k0 = 0; return true;
    }
    __device__ __forceinline__ void a_ready(const Unit&) const {}
    __device__ __forceinline__ void done(const Unit&) const {}
};
template <class Epi, class Sched, bool ALIGN_EPI = false, bool SP2 = false>
__device__ __forceinline__ void gemm_phase(PG8_LAS unsigned char* lds, const Gemm g, const Sched& S, const Epi& E) {
    const int tid = ptid(), wid = __builtin_amdgcn_readfirstlane(tid >> 6), lane = tid & 63, wr = wid >> 2, wc = wid & 3, fr = lane & 15, fq = lane >> 4;
    const int K = g.K, nt = K / BK, LD = g.ld;
    unsigned voffA[2], voffB[2];
#pragma unroll
    for (int i = 0; i < 2; ++i) { int R, C; stage_rc(tid * 16 + i * 8192, R, C); const int Rb = Epi::PERM ? ((R & ~31) + perm32(R & 31)) : R;
        voffA[i] = (unsigned)(R * LD + C) * 2u; voffB[i] = (unsigned)(Rb * LD + C) * 2u; }
    const size_t kstep = (size_t)(BK * 2);
    const size_t hstep = (size_t)HALF * LD * 2;
    const size_t tstep = 2 * hstep;
    const unsigned ldsw = (unsigned)wid * 1024u;
    const int aoff = lds_byte(wr * 64 + fr, fq * 8), boff = lds_byte(wc * 32 + fr, fq * 8);
#define PG8_SA(b, h) (((b) * 2 + (h)) * HTB)
#define PG8_SB(b, h) ((4 + (b) * 2 + (h)) * HTB)
#define PG8_STAGE(bufoff, gbase, voff) do { _Pragma("unroll") for (int _i = 0; _i < 2; ++_i) \
        __builtin_amdgcn_global_load_lds((const unsigned*)((const char*)(gbase) + (voff)[_i]), (PG8_LAS unsigned*)(lds + (bufoff) + ldsw + _i * 8192), 16, 0, 0); } while (0)
#define PG8_LDA(dst, b, h) do { _Pragma("unroll") for (int m = 0; m < 4; ++m) _Pragma("unroll") for (int k = 0; k < 2; ++k) dst[m][k] = *(const PG8_LAS bf16x8*)(lds + PG8_SA(b, h) + aoff + m * 2048 + k * 1024); } while (0)
#define PG8_LDB(dst, b, h) do { _Pragma("unroll") for (int n = 0; n < 2; ++n) _Pragma("unroll") for (int k = 0; k < 2; ++k) dst[n][k] = *(const PG8_LAS bf16x8*)(lds + PG8_SB(b, h) + boff + n * 2048 + k * 1024); } while (0)
#define PG8_MMA(ai, bj, At, Bt) do { __builtin_amdgcn_s_setprio(1); _Pragma("unroll") for (int m = 0; m < 4; ++m) _Pragma("unroll") for (int n = 0; n < 2; ++n) _Pragma("unroll") for (int k = 0; k < 2; ++k) \
        acc[ai][bj][m][n] = __builtin_amdgcn_mfma_f32_16x16x32_bf16(Bt[n][k], At[m][k], acc[ai][bj][m][n], 0, 0, 0); __builtin_amdgcn_s_setprio(0); } while (0)
#define PG8_WAIT_V(n) asm volatile("s_waitcnt vmcnt(" #n ")" ::: "memory")
#define PG8_WAIT_L(n) asm volatile("s_waitcnt lgkmcnt(" #n ")" ::: "memory")
#define PG8_BAR __builtin_amdgcn_s_barrier()
#define PG8_SCHED __builtin_amdgcn_sched_barrier(0)
    Unit cur, nxt; int ui = 0;
    if (!S.next(0, cur)) return;
    f32x4 acc[2][2][4][2];
#pragma unroll
    for (int a = 0; a < 2; ++a)
#pragma unroll
        for (int b = 0; b < 2; ++b)
#pragma unroll
            for (int m = 0; m < 4; ++m)
#pragma unroll
                for (int n = 0; n < 2; ++n) acc[a][b][m][n] = (f32x4){0.f, 0.f, 0.f, 0.f};
    bf16x8 At[4][2], B0[2][2], B1[2][2];
    const char* cA = (const char*)g.A + (size_t)cur.pm * tstep + (size_t)cur.k0 * 2; const char* cB = (const char*)g.Bt + (size_t)cur.pn * tstep + (size_t)cur.k0 * 2;
    S.a_ready(cur);
    if constexpr (SP2) {
        PG8_STAGE(PG8_SB(0, 0), cB, voffB); PG8_STAGE(PG8_SB(0, 1), cB + hstep, voffB); PG8_STAGE(PG8_SA(0, 0), cA, voffA); PG8_STAGE(PG8_SA(0, 1), cA + hstep, voffA);
        if (wr == 1) PG8_BAR;
        PG8_WAIT_V(2); PG8_BAR;
        PG8_STAGE(PG8_SB(1, 0), cB + kstep, voffB); PG8_STAGE(PG8_SA(1, 0), cA + kstep, voffA); PG8_STAGE(PG8_SB(1, 1), cB + hstep + kstep, voffB);
        PG8_WAIT_V(6); PG8_BAR;
    } else {
        PG8_STAGE(PG8_SB(0, 0), cB, voffB); PG8_STAGE(PG8_SA(0, 0), cA, voffA); PG8_STAGE(PG8_SB(0, 1), cB + hstep, voffB); PG8_STAGE(PG8_SA(0, 1), cA + hstep, voffA);
        if (wr == 1) PG8_BAR;
        PG8_WAIT_V(4); PG8_BAR;
        PG8_STAGE(PG8_SB(1, 0), cB + kstep, voffB); PG8_STAGE(PG8_SA(1, 0), cA + kstep, voffA); PG8_STAGE(PG8_SB(1, 1), cB + hstep + kstep, voffB);
        PG8_WAIT_V(6); PG8_BAR;
    }
    for (;;) {
        const bool has_next = S.next(ui + 1, nxt);
        const char* nA = has_next ? (const char*)g.A + (size_t)nxt.pm * tstep + (size_t)nxt.k0 * 2 : cA; const char* nB = has_next ? (const char*)g.Bt + (size_t)nxt.pn * tstep + (size_t)nxt.k0 * 2 : cB;
        for (int t = 0; t < nt; t += 2) {
            const bool last = (t == nt - 2);
            const char* a1 = cA + (size_t)(t + 1) * kstep;
            const char* a2 = last ? nA : cA + (size_t)(t + 2) * kstep; const char* b2 = last ? nB : cB + (size_t)(t + 2) * kstep;
            const char* a3 = a2 + kstep; const char* b3 = b2 + kstep;
            if (last && has_next) S.a_ready(nxt);
            if constexpr (SP2) {
            PG8_LDB(B0, 0, 0); PG8_LDB(B1, 0, 1); PG8_SCHED; PG8_LDA(At, 0, 0); PG8_STAGE(PG8_SA(1, 1), a1 + hstep, voffA);
            PG8_WAIT_V(8); PG8_WAIT_L(0); PG8_BAR; PG8_MMA(0, 0, At, B0); PG8_MMA(0, 1, At, B1); PG8_BAR; PG8_SCHED;
            PG8_LDA(At, 0, 1); PG8_STAGE(PG8_SB(0, 0), b2, voffB); PG8_STAGE(PG8_SB(0, 1), b2 + hstep, voffB); PG8_STAGE(PG8_SA(0, 0), a2, voffA);
            PG8_WAIT_V(8); PG8_WAIT_L(0); PG8_BAR; PG8_MMA(1, 0, At, B0); PG8_MMA(1, 1, At, B1); PG8_BAR; PG8_SCHED;
            PG8_LDB(B0, 1, 0); PG8_LDB(B1, 1, 1); PG8_SCHED; PG8_LDA(At, 1, 0); PG8_STAGE(PG8_SA(0, 1), a2 + hstep, voffA);
            PG8_WAIT_V(8); PG8_WAIT_L(0); PG8_BAR; PG8_MMA(0, 0, At, B0); PG8_MMA(0, 1, At, B1); PG8_BAR; PG8_SCHED;
            PG8_LDA(At, 1, 1); PG8_STAGE(PG8_SB(1, 0), b3, voffB); PG8_STAGE(PG8_SB(1, 1), b3 + hstep, voffB); PG8_STAGE(PG8_SA(1, 0), a3, voffA);
            PG8_WAIT_V(8); PG8_WAIT_L(0); PG8_BAR; PG8_MMA(1, 0, At, B0); PG8_MMA(1, 1, At, B1); PG8_BAR; PG8_SCHED;
            } else {
            PG8_LDB(B0, 0, 0); PG8_SCHED; PG8_LDA(At, 0, 0); PG8_STAGE(PG8_SA(1, 1), a1 + hstep, voffA);
            PG8_WAIT_L(8); PG8_BAR; PG8_WAIT_L(0); PG8_MMA(0, 0, At, B0); PG8_BAR; PG8_SCHED;
            PG8_LDB(B1, 0, 1); PG8_STAGE(PG8_SB(0, 0), b2, voffB);
            PG8_BAR; PG8_WAIT_L(0); PG8_MMA(0, 1, At, B1); PG8_BAR;
            PG8_LDA(At, 0, 1); PG8_STAGE(PG8_SA(0, 0), a2, voffA);
            PG8_BAR; PG8_WAIT_L(0); PG8_MMA(1, 0, At, B0); PG8_BAR; PG8_SCHED;
            PG8_STAGE(PG8_SB(0, 1), b2 + hstep, voffB);
            PG8_WAIT_V(6); PG8_BAR; PG8_MMA(1, 1, At, B1); PG8_BAR;
            PG8_LDB(B0, 1, 0); PG8_SCHED; PG8_LDA(At, 1, 0); PG8_STAGE(PG8_SA(0, 1), a2 + hstep, voffA);
            PG8_WAIT_L(8); PG8_BAR; PG8_WAIT_L(0); PG8_MMA(0, 0, At, B0); PG8_BAR; PG8_SCHED;
            PG8_LDB(B1, 1, 1); PG8_STAGE(PG8_SB(1, 0), b3, voffB);
            PG8_BAR; PG8_WAIT_L(0); PG8_MMA(0, 1, At, B1); PG8_BAR;
            PG8_LDA(At, 1, 1); PG8_STAGE(PG8_SA(1, 0), a3, voffA);
            PG8_BAR; PG8_WAIT_L(0); PG8_MMA(1, 0, At, B0); PG8_BAR; PG8_SCHED;
            PG8_STAGE(PG8_SB(1, 1), b3 + hstep, voffB);
            PG8_WAIT_V(6); PG8_BAR; PG8_MMA(1, 1, At, B1); PG8_BAR;
            }
        }
        if constexpr (ALIGN_EPI) { if (wr == 0) PG8_BAR; }
        if constexpr (!Epi::AFTER_DRAIN) { E(acc, cur, wr, wc, fr, fq); S.done(cur); }
        if (!has_next) break;
#pragma unroll
        for (int a = 0; a < 2; ++a)
#pragma unroll
            for (int b = 0; b < 2; ++b)
#pragma unroll
                for (int m = 0; m < 4; ++m)
#pragma unroll
                    for (int n = 0; n < 2; ++n) acc[a][b][m][n] = (f32x4){0.f, 0.f, 0.f, 0.f};
        cur = nxt; cA = nA; cB = nB; ++ui;
        if constexpr (ALIGN_EPI) { if (wr == 1) PG8_BAR; }
    }
    PG8_WAIT_V(0);
    if constexpr (!ALIGN_EPI) { if (wr == 0) PG8_BAR; }
    PG8_BAR;
    if constexpr (Epi::AFTER_DRAIN) { E.fused(acc, cur, wr, wc, fr, fq, lds, wid, lane); S.done(cur); }
#undef PG8_SA
#undef PG8_SB
#undef PG8_STAGE
#undef PG8_LDA
#undef PG8_LDB
#undef PG8_MMA
#undef PG8_WAIT_V
#undef PG8_WAIT_L
#undef PG8_BAR
#undef PG8_SCHED
}

}

struct Params {
    const float* in[40];
    float* out;
    unsigned* bar;
    float* mod0; float* mod1;
    bf16_t* Hb; bf16_t* MIXb; bf16_t* H1b; bf16_t* Xp; bf16_t* H1Eb;
    bf16_t* Wt_in0; bf16_t* Wt_out0; bf16_t* Wt_ffnup; bf16_t* Wt_ffndn; bf16_t* Wt_in1; bf16_t* Wt_out1; bf16_t* Wt_expup; bf16_t* Wt_expdn;
    bf16_t* P; float* LRs;
    bf16_t* R; float* V; bf16_t* KK; float* G; float* W[2]; bf16_t* KD[2]; bf16_t* NB[2];
    float* Y[2];
    bf16_t* Qb; bf16_t* Kb; bf16_t* VTl; bf16_t* VTc; float* QM; float* XA; float* XB;
    float* O[2]; bf16_t* QT; bf16_t* KHT; bf16_t* AM; bf16_t* VT; float* DEC;
    int* tok_e; float* tok_w; int* meta; int* slot_token; int* tok_slot; int* tile_e;
    bf16_t* YE; float* YEP; float* PC; bf16_t* WTd; bf16_t* WTi; bf16_t* WTg;
};

__device__ __forceinline__ void lds_barrier() { asm volatile("s_waitcnt lgkmcnt(0)" ::: "memory"); __builtin_amdgcn_s_barrier(); asm volatile("" ::: "memory"); }
__device__ __forceinline__ float bf2f(bf16_t b) { return __uint_as_float(((unsigned)b) << 16); }
typedef float f32x2_t __attribute__((ext_vector_type(2)));
typedef __bf16 bf16x2_t __attribute__((ext_vector_type(2)));
__device__ __forceinline__ unsigned cvt_pk_bf16(float lo, float hi) { const f32x2_t v = {lo, hi}; return __builtin_bit_cast(unsigned, __builtin_convertvector(v, bf16x2_t)); }
__device__ __forceinline__ bf16_t f2bf(float f) { return (bf16_t)(cvt_pk_bf16(f, 0.f) & 0xffffu); }
__device__ __forceinline__ float sigm(float x) { return __builtin_amdgcn_rcpf(1.f + __expf(-x)); }
__device__ __forceinline__ float siluf(float x) { return x * __builtin_amdgcn_rcpf(1.f + __expf(-x)); }
__device__ __forceinline__ float silu_fast(float x) { return x * __builtin_amdgcn_rcpf(1.f + __expf(-x)); }
__device__ __forceinline__ float softplusf(float x) { return x > 20.f ? x : __logf(1.f + __expf(x)); }
__device__ __forceinline__ int rowgrp(int row) { return row < NL ? row / TL : 2; }
__device__ __forceinline__ float dpp_add16(float x) {
    x += __builtin_bit_cast(float, __builtin_amdgcn_update_dpp(0, __builtin_bit_cast(int, x), 0xB1, 0xF, 0xF, true));
    x += __builtin_bit_cast(float, __builtin_amdgcn_update_dpp(0, __builtin_bit_cast(int, x), 0x4E, 0xF, 0xF, true));
    x += __builtin_bit_cast(float, __builtin_amdgcn_update_dpp(0, __builtin_bit_cast(int, x), 0x141, 0xF, 0xF, true));
    x += __builtin_bit_cast(float, __builtin_amdgcn_update_dpp(0, __builtin_bit_cast(int, x), 0x140, 0xF, 0xF, true));
    return x;
}
__device__ __forceinline__ float wave_sum(float v) {
    v = dpp_add16(v);
    v += __shfl_xor(v, 16); v += __shfl_xor(v, 32);
    return v;
}
__device__ __forceinline__ float wave_max(float v) {
#pragma unroll
    for (int o = 32; o >= 1; o >>= 1) v = fmaxf(v, __shfl_xor(v, o));
    return v;
}
__device__ __forceinline__ float block_sum(float v, float* red) {
    v = wave_sum(v);
    __syncthreads();
    const int bt_ = ptid();
    if ((bt_ & 63) == 0) red[bt_ >> 6] = v;
    __syncthreads();
    float s = 0.f;
#pragma unroll
    for (int i = 0; i < 8; ++i) s += red[i];
    return s;
}

__device__ __forceinline__ void conv_T(const float* W0, const float* W1, int K, int N, int Nt, int mode, bf16_t* Bt, float* ldsf, int wg, int nwg) {
    bf16_t (*T)[66] = (bf16_t (*)[66])ldsf;
    const int tid = ptid();
    const int tn = Nt / 64, tk = K / 64;
    for (int tile = wg; tile < tn * tk; tile += nwg) {
        const int n0 = (tile % tn) * 64, k0 = (tile / tn) * 64;
        const float* src = W0; int col0 = n0;
        if (mode == 1) { const int t = n0 >> 8, h = (n0 >> 7) & 1, j0 = n0 & 127; src = h ? W1 : W0; col0 = t * 128 + j0; }
        const int kk = tid >> 4, c4 = (tid & 15) * 4;
#pragma unroll
        for (int r = 0; r < 2; ++r) {
            const int k = kk + 32 * r;
            float4 v = make_float4(0.f, 0.f, 0.f, 0.f);
            if (col0 + c4 < N) v = *(const float4*)(src + (size_t)(k0 + k) * N + col0 + c4);
            T[c4 + 0][k] = f2bf(v.x); T[c4 + 1][k] = f2bf(v.y); T[c4 + 2][k] = f2bf(v.z); T[c4 + 3][k] = f2bf(v.w);
        }
        __syncthreads();
        {
            const int n = tid >> 3, k8 = (tid & 7) * 8;
            const unsigned* tp = (const unsigned*)&T[n][k8];
            uint4 o; o.x = tp[0]; o.y = tp[1]; o.z = tp[2]; o.w = tp[3];
            *(uint4*)(Bt + (size_t)(n0 + n) * K + k0 + k8) = o;
        }
        __syncthreads();
    }
}
#define CT_L0A 6656
#define CT_L0B (CT_L0A + 2048)
#define CT_L0C (CT_L0B + 11264)
#define CT_L0 (CT_L0C + 5632)
#define CT_A (CT_L0 + 6400)
#define CT_B (CT_A + 2048)
#define CT_C (CT_B + 8 * 14336)
#define CT_TOTAL (CT_C + 8 * 7168)
#define CT_LDS_BYTES 5120
struct ConvTile { const float* src; bf16_t* dst; int N; int K; int nvalid; };
#define CTTAB_OFF (131072 + 64)
__device__ __forceinline__ void ct_table_init(const Params& p, unsigned long long* tab) {
    tab[0] = (unsigned long long)p.in[8]; tab[1] = (unsigned long long)p.in[23]; tab[2] = (unsigned long long)p.in[24]; tab[3] = (unsigned long long)p.in[25]; tab[4] = (unsigned long long)p.in[26];
    tab[5] = (unsigned long long)p.in[31]; tab[6] = (unsigned long long)p.in[35]; tab[7] = (unsigned long long)p.in[37]; tab[8] = (unsigned long long)p.in[38]; tab[9] = (unsigned long long)p.in[39];
    tab[10] = (unsigned long long)p.Wt_in0; tab[11] = (unsigned long long)p.Wt_out0; tab[12] = (unsigned long long)p.Wt_ffnup; tab[13] = (unsigned long long)p.Wt_ffndn;
    tab[14] = (unsigned long long)p.Wt_in1; tab[15] = (unsigned long long)p.Wt_out1; tab[16] = (unsigned long long)p.Wt_expup; tab[17] = (unsigned long long)p.Wt_expdn;
}
__device__ __forceinline__ ConvTile conv_tile_desc(const unsigned long long* tab, int t) {
    int si, di, N, K, nb, kb, e = 0, mode = 0, npad = 0;
    if (t < CT_L0A) { si = 0; di = 10; N = L0C; K = DM; nb = t % 104; kb = t / 104; npad = 1; }
    else if (t < CT_L0B) { const int u = t - CT_L0A; si = 1; di = 11; N = DM; K = DM; nb = u & 31; kb = u >> 5; }
    else if (t < CT_L0C) { const int u = t - CT_L0B; si = 2; di = 12; N = FFN; K = DM; nb = u % 176; kb = u / 176; mode = 1; }
    else if (t < CT_L0) { const int u = t - CT_L0C; si = 4; di = 13; N = DM; K = FFN; nb = u & 31; kb = u >> 5; }
    else if (t < CT_A) { const int u = t - CT_L0; si = 5; di = 14; N = L1C; K = DM; nb = u % 100; kb = u / 100; npad = 1; }
    else if (t < CT_B) { const int u = t - CT_A; si = 6; di = 15; N = DM; K = DM; nb = u & 31; kb = u >> 5; }
    else if (t < CT_C) { const int u = t - CT_B; e = u / 14336; const int v = u % 14336; si = 7; di = 16; N = EXD; K = DM; nb = v % 224; kb = v / 224; mode = 1; }
    else { const int u = (t < CT_TOTAL ? t : CT_TOTAL - 1) - CT_C; e = u / 7168; const int v = u % 7168; si = 9; di = 17; N = DM; K = EXD; nb = v & 31; kb = v >> 5; }
    const int n0 = nb * 64;
    int col0 = n0, nvalid = 64;
    if (mode) { col0 = (n0 >> 8) * 128 + (n0 & 127); si += (n0 >> 7) & 1; }
    if (npad) { nvalid = N - n0; if (nvalid <= 0) col0 = 0; }
    ConvTile c;
    const size_t KN = (size_t)K * N;
    c.src = (const float*)tab[si] + (size_t)e * KN + (size_t)(kb * 32) * N + col0;
    c.dst = (bf16_t*)tab[di] + (size_t)e * (mode ? 2 * KN : KN) + (size_t)n0 * K + kb * 32;
    c.N = N; c.K = K; c.nvalid = nvalid;
    return c;
}
#define CT_FORQ(X) X(0) X(1) X(2) X(3) X(4) X(5) X(6) X(7)
#define CT_LOAD1(q) cv##q = *(const float4*)(ct_.src + (size_t)(ckq_ * 8 + (q)) * ct_.N + ccol_);
#define CT_LOAD(T_) do { const int tt_ = (T_) < CT_TOTAL ? (T_) : CT_TOTAL - 1; const ConvTile ct_ = conv_tile_desc(cttab, tt_); const int ckq_ = lane >> 4, ccol_ = ((lane & 15) * 4 < ct_.nvalid) ? (lane & 15) * 4 : 0; CT_FORQ(CT_LOAD1) } while (0)
#define CT_ATOM(e, C) { uint4 a_; a_.x = cvt_pk_bf16(cv0.C, cv1.C); a_.y = cvt_pk_bf16(cv2.C, cv3.C); a_.z = cvt_pk_bf16(cv4.C, cv5.C); a_.w = cvt_pk_bf16(cv6.C, cv7.C); \
    if (!cok_) a_ = make_uint4(0u, 0u, 0u, 0u); *(uint4*)(cdst_ + (size_t)(e) * ct_.K) = a_; }
#define CT_STORE(T_, LDSW_) do { const int tt_ = (T_) < CT_TOTAL ? (T_) : CT_TOTAL - 1; const ConvTile ct_ = conv_tile_desc(cttab, tt_); const bool cok_ = (lane & 15) * 4 < ct_.nvalid; \
    bf16_t* cdst_ = ct_.dst + (size_t)((lane & 15) * 4) * ct_.K + (lane >> 4) * 8; CT_ATOM(0, x) CT_ATOM(1, y) CT_ATOM(2, z) CT_ATOM(3, w) } while (0)
__device__ __forceinline__ void ph_convert(const Params& p, float* lds, int wg, int nwg, int ct_end) {
    const int tid = ptid(), wave = __builtin_amdgcn_readfirstlane(tid >> 6), lane = tid & 63;
    const unsigned long long* cttab = (const unsigned long long*)((const char*)lds + CTTAB_OFF);
    float4 cv0, cv1, cv2, cv3, cv4, cv5, cv6, cv7;
    for (int t = wg * 8 + wave; t < ct_end; t += nwg * 8) { CT_LOAD(t); CT_STORE(t, 0); }
}

__device__ __forceinline__ void ph_mod(const Params& p, float* lds, int wg, int nwg) {
    float* cs = lds;
    float* red = lds + 3 * DM;
    const int tid = ptid(), wave = tid >> 6, lane = tid & 63;
    if (wg >= 4 * (MODW / 256)) return;
    for (int i = tid; i < 3 * DM; i += NTHR) {
        const int r = i / DM, k = i % DM;
        const float c = r < 2 ? p.in[1][r * DM + k] : p.in[3][k];
        cs[i] = siluf(c);
    }
    __syncthreads();
    for (int item = wg; item < 4 * (MODW / 256); item += nwg) {
        const int kh = item & 1, it2 = item >> 1, layer = it2 / (MODW / 256), cb = (it2 % (MODW / 256)) * 256;
        const float* w = (layer ? p.in[27] : p.in[4]) + cb + lane * 4;
        const float* b = layer ? p.in[28] : p.in[5];
        float* out = layer ? p.mod1 : p.mod0;
        float a0[4] = {0.f, 0.f, 0.f, 0.f}, a1[4] = {0.f, 0.f, 0.f, 0.f}, a2[4] = {0.f, 0.f, 0.f, 0.f};
        const int kbeg = kh * 1024 + wave * 128;
#pragma unroll 8
        for (int k = kbeg; k < kbeg + 128; ++k) {
            const float4 wv = *(const float4*)(w + (size_t)k * MODW);
            const float c0 = cs[k], c1 = cs[DM + k], c2 = cs[2 * DM + k];
            a0[0] += c0 * wv.x; a0[1] += c0 * wv.y; a0[2] += c0 * wv.z; a0[3] += c0 * wv.w;
            a1[0] += c1 * wv.x; a1[1] += c1 * wv.y; a1[2] += c1 * wv.z; a1[3] += c1 * wv.w;
            a2[0] += c2 * wv.x; a2[1] += c2 * wv.y; a2[2] += c2 * wv.z; a2[3] += c2 * wv.w;
        }
        *(float4*)(red + (wave * 3 + 0) * 256 + lane * 4) = make_float4(a0[0], a0[1], a0[2], a0[3]);
        *(float4*)(red + (wave * 3 + 1) * 256 + lane * 4) = make_float4(a1[0], a1[1], a1[2], a1[3]);
        *(float4*)(red + (wave * 3 + 2) * 256 + lane * 4) = make_float4(a2[0], a2[1], a2[2], a2[3]);
        __syncthreads();
        for (int q = tid; q < 768; q += NTHR) {
            const int r = q >> 8, c = q & 255;
            float sum = kh ? 0.f : b[cb + c];
#pragma unroll
            for (int w8 = 0; w8 < 8; ++w8) sum += red[(w8 * 3 + r) * 256 + c];
            unsafeAtomicAdd(out + r * MODW + cb + c, sum);
        }
        __syncthreads();
    }
}

__device__ __forceinline__ void ph_norm(const float* src_lat, const float* src_ctx, const float* gain, const float* mod, int shift_idx, int scale_idx,
                        bf16_t* out, int nrows, float* lds, int wg, int nwg,
                        const float* part = nullptr, int nparts = 0, const float* pgate = nullptr, float* wb = nullptr) {
    (void)lds;
    const int tid = ptid(), wave = tid >> 6, lane = tid & 63;
    for (int row = wg * 8 + wave; row < nrows; row += nwg * 8) {
        const float4* x = (const float4*)(row < NL ? src_lat + (size_t)row * DM : src_ctx + (size_t)(row - NL) * DM);
        float4 v[8];
#pragma unroll
        for (int q = 0; q < 8; ++q) v[q] = x[lane + 64 * q];
        if (part != nullptr && row >= NL) {
#pragma unroll
            for (int q = 0; q < 8; ++q) {
                float4 a = make_float4(0.f, 0.f, 0.f, 0.f);
                for (int sidx = 0; sidx < nparts; ++sidx) { const float4 t = ((const float4*)(part + ((size_t)sidx * NC + (row - NL)) * DM))[lane + 64 * q]; a.x += t.x; a.y += t.y; a.z += t.z; a.w += t.w; }
                const float4 g4 = ((const float4*)pgate)[lane + 64 * q];
                v[q].x += g4.x * a.x; v[q].y += g4.y * a.y; v[q].z += g4.z * a.z; v[q].w += g4.w * a.w;
                if (wb) ((float4*)(wb + (size_t)row * DM))[lane + 64 * q] = v[q];
            }
        }
        float ss = 0.f;
#pragma unroll
        for (int q = 0; q < 8; ++q) ss += v[q].x * v[q].x + v[q].y * v[q].y + v[q].z * v[q].z + v[q].w * v[q].w;
        ss = wave_sum(ss);
        const float rs = rsqrtf(ss * (1.f / DM) + 1e-6f);
        const int g = rowgrp(row);
#pragma unroll
        for (int q = 0; q < 8; ++q) {
            const float4 gn = ((const float4*)gain)[lane + 64 * q];
            const float4 sh = ((const float4*)(mod + g * MODW + shift_idx * DM))[lane + 64 * q];
            const float4 sc = ((const float4*)(mod + g * MODW + scale_idx * DM))[lane + 64 * q];
            uint2 o;
            o.x = cvt_pk_bf16(v[q].x * rs * gn.x * (1.f + sc.x) + sh.x, v[q].y * rs * gn.y * (1.f + sc.y) + sh.y);
            o.y = cvt_pk_bf16(v[q].z * rs * gn.z * (1.f + sc.z) + sh.z, v[q].w * rs * gn.w * (1.f + sc.w) + sh.w);
            ((uint2*)(out + (size_t)row * DM))[lane + 64 * q] = o;
        }
    }
}

struct EpiF32Store {
    static constexpr bool PERM = false, AFTER_DRAIN = false;
    float* C; int ldc; int nn;
    __device__ __forceinline__ void operator()(const pg8::f32x4 (&acc)[2][2][4][2], const pg8::Unit& u, int wr, int wc, int fr, int fq) const {
        const int row0 = u.pm * 256 + wr * 64 + fr, pnl = nn ? u.pn % nn : u.pn, col0 = pnl * 256 + wc * 32 + 4 * fq;
#pragma unroll
        for (int ai = 0; ai < 2; ++ai)
#pragma unroll
            for (int m = 0; m < 4; ++m) { float* rowp = C + (size_t)(row0 + ai * 128 + m * 16) * ldc + col0;
#pragma unroll
                for (int bj = 0; bj < 2; ++bj)
#pragma unroll
                    for (int n = 0; n < 2; ++n) *(pg8::f32x4*)(rowp + bj * 128 + n * 16) = acc[ai][bj][m][n]; }
    }
};
struct EpiResGate {
    static constexpr bool PERM = false, AFTER_DRAIN = false;
    const float* res_lat; const float* res_ctx; const float* gate; float* C;
    __device__ __forceinline__ void operator()(const pg8::f32x4 (&acc)[2][2][4][2], const pg8::Unit& u, int wr, int wc, int fr, int fq) const {
        const int row0 = u.pm * 256 + wr * 64 + fr, col0 = u.pn * 256 + wc * 32 + 4 * fq;
#pragma unroll
        for (int ai = 0; ai < 2; ++ai)
#pragma unroll
            for (int m = 0; m < 4; ++m) { const int row = row0 + ai * 128 + m * 16;
                const float* rp = (row < NL ? res_lat + (size_t)row * DM : res_ctx + (size_t)(row - NL) * DM) + col0;
                const float* gp = gate + rowgrp(row) * MODW + col0;
                float* cp = C + (size_t)row * DM + col0;
#pragma unroll
                for (int bj = 0; bj < 2; ++bj)
#pragma unroll
                    for (int n = 0; n < 2; ++n) { const pg8::f32x4 r = *(const pg8::f32x4*)(rp + bj * 128 + n * 16), g = *(const pg8::f32x4*)(gp + bj * 128 + n * 16);
                        *(pg8::f32x4*)(cp + bj * 128 + n * 16) = r + g * acc[ai][bj][m][n]; } }
    }
};
struct EpiCtxPartial {
    static constexpr bool PERM = false, AFTER_DRAIN = false;
    float* P; int ksub;
    __device__ __forceinline__ void operator()(const pg8::f32x4 (&acc)[2][2][4][2], const pg8::Unit& u, int wr, int wc, int fr, int fq) const {
        const int row0 = (u.pm - 32) * 256 + wr * 64 + fr, col0 = u.pn * 256 + wc * 32 + 4 * fq; float* base = P + (size_t)(u.k0 / ksub) * NC * DM;
#pragma unroll
        for (int ai = 0; ai < 2; ++ai)
#pragma unroll
            for (int m = 0; m < 4; ++m) { float* rowp = base + (size_t)(row0 + ai * 128 + m * 16) * DM + col0;
#pragma unroll
                for (int bj = 0; bj < 2; ++bj)
#pragma unroll
                    for (int n = 0; n < 2; ++n) *(pg8::f32x4*)(rowp + bj * 128 + n * 16) = acc[ai][bj][m][n]; }
    }
};
struct EpiTailPartial {
    static constexpr bool PERM = false, AFTER_DRAIN = false;
    float* P; int ntm, nN, lo, ntail, ksub;
    __device__ __forceinline__ void operator()(const pg8::f32x4 (&acc)[2][2][4][2], const pg8::Unit& u, int wr, int wc, int fr, int fq) const {
        const int pnl = u.pn % nN, t = pnl * ntm + u.pm - lo, ks = u.k0 / ksub;
        float* base = P + (size_t)(ks * ntail + t) * 65536 + (wr * 64 + fr) * 256 + wc * 32 + 4 * fq;
#pragma unroll
        for (int ai = 0; ai < 2; ++ai)
#pragma unroll
            for (int m = 0; m < 4; ++m) { float* rowp = base + (ai * 128 + m * 16) * 256;
#pragma unroll
                for (int bj = 0; bj < 2; ++bj)
#pragma unroll
                    for (int n = 0; n < 2; ++n) *(pg8::f32x4*)(rowp + bj * 128 + n * 16) = acc[ai][bj][m][n]; }
    }
};
struct EpiBf16Store {
    static constexpr bool PERM = true, AFTER_DRAIN = false;
    bf16_t* O; int ldc; float* side; int side_pn; int nn;
    __device__ __forceinline__ void operator()(const pg8::f32x4 (&acc)[2][2][4][2], const pg8::Unit& u, int wr, int wc, int fr, int fq) const {
        const int row0 = u.pm * 256 + wr * 64 + fr, col0 = (nn ? u.pn % nn : u.pn) * 256 + wc * 32 + 8 * fq;
#pragma unroll
        for (int ai = 0; ai < 2; ++ai)
#pragma unroll
            for (int m = 0; m < 4; ++m) { const int row = row0 + ai * 128 + m * 16; bf16_t* rowp = O + (size_t)row * ldc + col0;
#pragma unroll
                for (int bj = 0; bj < 2; ++bj) { const pg8::f32x4 v0 = acc[ai][bj][m][0], v1 = acc[ai][bj][m][1];
                    pg8::u32x4 w; w.x = cvt_pk_bf16(v0[0], v0[1]); w.y = cvt_pk_bf16(v0[2], v0[3]); w.z = cvt_pk_bf16(v1[0], v1[1]); w.w = cvt_pk_bf16(v1[2], v1[3]);
                    *(pg8::u32x4*)(rowp + bj * 128) = w;
                    if (side != nullptr && u.pn == side_pn) { float* sp = side + (size_t)row * 256 + bj * 128 + wc * 32 + 8 * fq; *(pg8::f32x4*)sp = v0; *(pg8::f32x4*)(sp + 4) = v1; } } }
    }
};
struct EpiSwiglu {
    static constexpr bool PERM = true, AFTER_DRAIN = false;
    bf16_t* O; int ldc; int nn;
    __device__ __forceinline__ void operator()(const pg8::f32x4 (&acc)[2][2][4][2], const pg8::Unit& u, int wr, int wc, int fr, int fq) const {
        const int row0 = u.pm * 256 + wr * 64 + fr, pnl = nn ? u.pn % nn : u.pn, col0 = pnl * 128 + wc * 32 + 8 * fq;
#pragma unroll
        for (int ai = 0; ai < 2; ++ai)
#pragma unroll
            for (int m = 0; m < 4; ++m) { bf16_t* rowp = O + (size_t)(row0 + ai * 128 + m * 16) * ldc + col0;
                const pg8::f32x4 g0 = acc[ai][0][m][0], g1 = acc[ai][0][m][1], u0 = acc[ai][1][m][0], u1 = acc[ai][1][m][1];
                pg8::u32x4 w;
                w.x = cvt_pk_bf16(silu_fast(g0[0]) * u0[0], silu_fast(g0[1]) * u0[1]); w.y = cvt_pk_bf16(silu_fast(g0[2]) * u0[2], silu_fast(g0[3]) * u0[3]);
                w.z = cvt_pk_bf16(silu_fast(g1[0]) * u1[0], silu_fast(g1[1]) * u1[1]); w.w = cvt_pk_bf16(silu_fast(g1[2]) * u1[2], silu_fast(g1[3]) * u1[3]);
                *(pg8::u32x4*)rowp = w; }
    }
};

__device__ __forceinline__ float rp_shift(const bf16_t* P, int row, int col, float mu) {
    int t, T;
    if (row < NL) { t = row % TL; T = TL; } else { t = (row - NL) % TC; T = TC; }
    const bf16_t* pc = P + (size_t)row * L0LD + col;
    const float c = bf2f(pc[0]), pv = t > 0 ? bf2f(pc[-L0LD]) : 0.f, nx = t < T - 1 ? bf2f(pc[L0LD]) : 0.f;
    return c + mu * (0.5f * (pv + nx) - c);
}
__device__ __forceinline__ void ph_lora_wt(const Params& p, int wg, int nwg) {
    const int tid = ptid();
    for (int idx = wg * NTHR + tid; idx < 384 * 1024; idx += nwg * NTHR) {
        const int ch = idx & 1023, j = idx >> 10;
        if (j < 128) p.WTd[((size_t)(j >> 6) * 1024 + ch) * 64 + (j & 63)] = f2bf(p.in[11][(size_t)j * 1024 + ch]);
        else if (j < 256) { const int q = j - 128; p.WTi[((size_t)(q >> 6) * 1024 + ch) * 64 + (q & 63)] = f2bf(p.in[13][(size_t)q * 1024 + ch]); }
        else { const int q = j - 256; p.WTg[(size_t)ch * 128 + q] = f2bf(p.in[14][(size_t)q * 1024 + ch]); }
    }
}
#define RPM_LD 392
__device__ __forceinline__ void ph_rwprep(const Params& p, float* lds, int wg, int nwg) {
    bf16_t* X = (bf16_t*)lds;
    const int tid = ptid(), wave = __builtin_amdgcn_readfirstlane(tid >> 6), lane = tid & 63, r16 = lane & 15, g = lane >> 4;
    for (int item = wg; item < NT / 34; item += nwg) {
        const int rowI = item * 34;
        for (int z = tid; z < 14 * RPM_LD / 2; z += NTHR) ((unsigned*)(X + 34 * RPM_LD))[z] = 0u;
#pragma unroll
        for (int q12 = 0; q12 < 4; ++q12) {
            const int idx = tid + q12 * NTHR; if (idx >= 34 * 48) break; const int rr = idx / 48, j = (idx % 48) * 8; const int row = rowI + rr;
            int t, T; if (row < NL) { t = row % TL; T = TL; } else { t = (row - NL) % TC; T = TC; }
            const bf16_t* pc = p.P + (size_t)row * L0LD + 3072 + j;
            const uint4 zc = *(const uint4*)pc, z0 = {0u, 0u, 0u, 0u};
            const uint4 zp = t > 0 ? *(const uint4*)(pc - L0LD) : z0, zn = t < T - 1 ? *(const uint4*)(pc + L0LD) : z0;
            const float4 mA = *(const float4*)(p.in[9] + 3072 + j), mB = *(const float4*)(p.in[9] + 3072 + j + 4);
            const unsigned cu[4] = {zc.x, zc.y, zc.z, zc.w}, pu[4] = {zp.x, zp.y, zp.z, zp.w}, nu[4] = {zn.x, zn.y, zn.z, zn.w};
            const float mu[8] = {mA.x, mA.y, mA.z, mA.w, mB.x, mB.y, mB.z, mB.w};
            unsigned ou[4];
#pragma unroll
            for (int e = 0; e < 4; ++e) {
                float vv[2];
#pragma unroll
                for (int hf = 0; hf < 2; ++hf) {
                    const float c = hf ? __uint_as_float(cu[e] & 0xffff0000u) : __uint_as_float(cu[e] << 16);
                    const float pv = hf ? __uint_as_float(pu[e] & 0xffff0000u) : __uint_as_float(pu[e] << 16);
                    const float nx = hf ? __uint_as_float(nu[e] & 0xffff0000u) : __uint_as_float(nu[e] << 16);
                    float v = c + mu[2 * e + hf] * (0.5f * (pv + nx) - c);
                    v = j < 128 ? (1.f - 2.f * __builtin_amdgcn_rcpf(1.f + __expf(2.f * v))) : (j < 256 ? v : sigm(v));
                    vv[hf] = v;
                }
                ou[e] = cvt_pk_bf16(vv[0], vv[1]);
            }
            *(uint4*)(X + rr * RPM_LD + j) = make_uint4(ou[0], ou[1], ou[2], ou[3]);
        }
        __syncthreads();
#pragma unroll 1
        for (int rt = 0; rt < 3; ++rt) {
        const int row0 = rowI + rt * 16, rowEnd = rowI + 34;
        pg8::bf16x8 af[12];
#pragma unroll
        for (int ks = 0; ks < 12; ++ks) af[ks] = *(const pg8::bf16x8*)(X + (rt * 16 + r16) * RPM_LD + ks * 32 + 8 * g);
#pragma unroll 1
        for (int hh = 0; hh < 2; ++hh) {
            const int h = wave * 2 + hh;
            pg8::f32x4 dA0[4], dA1[4], iA0[4], iA1[4], gG[4];
#pragma unroll
            for (int cb = 0; cb < 4; ++cb) {
                const int chb = h * 64 + cb * 16 + r16;
                pg8::f32x4 z = {0.f, 0.f, 0.f, 0.f};
                dA0[cb] = z; dA1[cb] = z; iA0[cb] = z; iA1[cb] = z; gG[cb] = z;
#pragma unroll
                for (int kk = 0; kk < 2; ++kk) {
                    dA0[cb] = __builtin_amdgcn_mfma_f32_16x16x32_bf16(af[kk], *(const pg8::bf16x8*)(p.WTd + ((size_t)chb) * 64 + kk * 32 + 8 * g), dA0[cb], 0, 0, 0);
                    dA1[cb] = __builtin_amdgcn_mfma_f32_16x16x32_bf16(af[2 + kk], *(const pg8::bf16x8*)(p.WTd + ((size_t)1024 + chb) * 64 + kk * 32 + 8 * g), dA1[cb], 0, 0, 0);
                    iA0[cb] = __builtin_amdgcn_mfma_f32_16x16x32_bf16(af[4 + kk], *(const pg8::bf16x8*)(p.WTi + ((size_t)chb) * 64 + kk * 32 + 8 * g), iA0[cb], 0, 0, 0);
                    iA1[cb] = __builtin_amdgcn_mfma_f32_16x16x32_bf16(af[6 + kk], *(const pg8::bf16x8*)(p.WTi + ((size_t)1024 + chb) * 64 + kk * 32 + 8 * g), iA1[cb], 0, 0, 0);
                }
#pragma unroll
                for (int kk = 0; kk < 4; ++kk)
                    gG[cb] = __builtin_amdgcn_mfma_f32_16x16x32_bf16(af[8 + kk], *(const pg8::bf16x8*)(p.WTg + (size_t)chb * 128 + kk * 32 + 8 * g), gG[cb], 0, 0, 0);
            }
            float* T = lds + 9472 + wave * 2560;
            const int ch = h * 64 + lane;
            const float mur = p.in[9][ch], muk = p.in[9][1024 + ch], muv = p.in[9][2048 + ch], kkc = p.in[15][ch], ka = p.in[16][ch];
            const float w00 = p.in[10][ch], w01 = p.in[10][1024 + ch], a00 = p.in[12][ch], a01 = p.in[12][1024 + ch];
            float nr_[6], nk_[6], nv_[6];
#define RP_LOADP(Q4) do { _Pragma("unroll") for (int q = 0; q < 6; ++q) { int rq = row0 + (Q4) * 4 - 1 + q; rq = rq < 0 ? 0 : (rq > NT - 1 ? NT - 1 : rq); \
                const bf16_t* pp = p.P + (size_t)rq * L0LD + ch; nr_[q] = bf2f(pp[0]); nk_[q] = bf2f(pp[1024]); nv_[q] = bf2f(pp[2048]); } } while (0)
            RP_LOADP(0);
#pragma unroll 1
            for (int q4 = 0; q4 < 4; ++q4) {
                if (row0 + q4 * 4 >= rowEnd) break;
                if ((q4 & 1) == 0 && (g >> 1) == (q4 >> 1)) {
#pragma unroll
                    for (int cb = 0; cb < 4; ++cb)
#pragma unroll
                        for (int reg = 0; reg < 4; ++reg) { const int o = (((4 * g + reg) & 7) * 64) + cb * 16 + r16;
                            T[o] = dA0[cb][reg]; T[512 + o] = dA1[cb][reg]; T[1024 + o] = iA0[cb][reg]; T[1536 + o] = iA1[cb][reg]; T[2048 + o] = gG[cb][reg]; }
                }
                float pr_[6], pk_[6], pv_[6];
#pragma unroll
                for (int q = 0; q < 6; ++q) { pr_[q] = nr_[q]; pk_[q] = nk_[q]; pv_[q] = nv_[q]; }
                RP_LOADP(q4 + 1);
#pragma unroll
                for (int r4 = 0; r4 < 4; ++r4) {
                    const int rr = (q4 & 1) * 4 + r4;
                    const int row = row0 + q4 * 4 + r4; const size_t o = (size_t)row * 1024 + ch;
                    if (row >= rowEnd) break;
                    const float d0 = T[rr * 64 + lane], d1 = T[512 + rr * 64 + lane], i0 = T[1024 + rr * 64 + lane], i1 = T[1536 + rr * 64 + lane], gv = T[2048 + rr * 64 + lane];
                    int tt, TT; if (row < NL) { tt = row % TL; TT = TL; } else { tt = (row - NL) % TC; TT = TC; }
                    const bool hp = tt > 0, hn = tt < TT - 1;
                    const float rv = pr_[r4 + 1] + mur * (0.5f * ((hp ? pr_[r4] : 0.f) + (hn ? pr_[r4 + 2] : 0.f)) - pr_[r4 + 1]);
                    const float k = pk_[r4 + 1] + muk * (0.5f * ((hp ? pk_[r4] : 0.f) + (hn ? pk_[r4 + 2] : 0.f)) - pk_[r4 + 1]);
                    const float v = pv_[r4 + 1] + muv * (0.5f * ((hp ? pv_[r4] : 0.f) + (hn ? pv_[r4 + 2] : 0.f)) - pv_[r4 + 1]);
                    const float kq = k * kkc; const float ssum = wave_sum(kq * kq); const float kkn = kq * rsqrtf(ssum + 1e-12f);
                    p.R[o] = f2bf(rv); p.V[o] = v; p.G[o] = gv; p.KK[o] = f2bf(kkn);
                    {   const float wlog = -softplusf(-(w00 + d0)) - 0.5f; const float a = sigm(a00 + i0);
                        p.W[0][o] = __expf(-__expf(wlog)); p.NB[0][o] = f2bf(-kkn * a); p.KD[0][o] = f2bf(k * (1.f + (a - 1.f) * ka)); }
                    {   const float wlog = -softplusf(-(w01 + d1)) - 0.5f; const float a = sigm(a01 + i1);
                        p.W[1][o] = __expf(-__expf(wlog)); p.NB[1][o] = f2bf(-kkn * a); p.KD[1][o] = f2bf(k * (1.f + (a - 1.f) * ka)); }
                }
            }
        }
        }
        __syncthreads();
    }
}

typedef float f2v __attribute__((ext_vector_type(2)));
#define RW_TB 32
#define RW_STEPF 336
#define RW_NBLK ((TC + TL) / RW_TB)
#define RW_LJ 11
__device__ __forceinline__ void ph_rwscan(const Params& p, float* lds, int wg, int nwg, int ct_begin) {
    const int tid = ptid(), wave = __builtin_amdgcn_readfirstlane(tid >> 6), lane = tid & 63;
    const bool loader = wave >= 4;
    for (int unit = wg; unit < 256; unit += nwg) {
        const int b = unit >> 7, h = (unit >> 3) & 15, dir = (unit >> 2) & 1, rg = unit & 3;
        const int lt = tid & 255;
        const float* const aW = dir ? p.W[1] : p.W[0]; const bf16_t* const aN = dir ? p.NB[1] : p.NB[0]; const bf16_t* const aD = dir ? p.KD[1] : p.KD[0];
        const int st0 = lt >> 4, st1 = 16 + (lt >> 4), c4l = lt & 15, sth = lt >> 3, c8l = lt & 7, qv = lt < 128 ? lt : 127, stv = qv >> 2, cvl = qv & 3;
        float4 rAW0, rAW1, rAV, rBW0, rBW1, rBV; uint4 rAK, rAN, rAD, rAR, rBK, rBN, rBD, rBR;
#define RW_LOAD_BLOCK(BLK, S) do { const int blk_ = (BLK) < RW_NBLK ? (BLK) : RW_NBLK - 1; const int T_ = blk_ < TC / RW_TB ? TC : TL, base_ = blk_ < TC / RW_TB ? NL + b * TC : b * TL, i0_ = blk_ < TC / RW_TB ? blk_ * RW_TB : (blk_ - TC / RW_TB) * RW_TB; \
        const int ta_ = dir ? T_ - 1 - (i0_ + st0) : i0_ + st0, tb_ = dir ? T_ - 1 - (i0_ + st1) : i0_ + st1, th_ = dir ? T_ - 1 - (i0_ + sth) : i0_ + sth, tv_ = dir ? T_ - 1 - (i0_ + stv) : i0_ + stv; \
        const size_t oa_ = (size_t)(base_ + ta_) * 1024 + h * 64 + c4l * 4, ob_ = (size_t)(base_ + tb_) * 1024 + h * 64 + c4l * 4, oh_ = (size_t)(base_ + th_) * 1024 + h * 64 + c8l * 8, ov_ = (size_t)(base_ + tv_) * 1024 + h * 64 + rg * 16 + cvl * 4; \
        r##S##W0 = *(const float4*)(aW + oa_); r##S##W1 = *(const float4*)(aW + ob_); r##S##K = *(const uint4*)(p.KK + oh_); r##S##N = *(const uint4*)(aN + oh_); \
        r##S##D = *(const uint4*)(aD + oh_); r##S##R = *(const uint4*)(p.R + oh_); r##S##V = *(const float4*)(p.V + ov_); } while (0)
#define RW_BF4LO(U) make_float4(__uint_as_float((U).x << 16), __uint_as_float((U).x & 0xffff0000u), __uint_as_float((U).y << 16), __uint_as_float((U).y & 0xffff0000u))
#define RW_BF4HI(U) make_float4(__uint_as_float((U).z << 16), __uint_as_float((U).z & 0xffff0000u), __uint_as_float((U).w << 16), __uint_as_float((U).w & 0xffff0000u))
#define RW_WRITE_BLOCK(BUF, S) do { float4* wq_ = (float4*)(BUF); wq_[st0 * 84 + c4l * 5] = r##S##W0; wq_[st1 * 84 + c4l * 5] = r##S##W1; \
        float4* wh_ = wq_ + sth * 84 + (2 * c8l) * 5 + 1; \
        wh_[0] = RW_BF4LO(r##S##K); wh_[5] = RW_BF4HI(r##S##K); wh_[1] = RW_BF4LO(r##S##N); wh_[6] = RW_BF4HI(r##S##N); \
        wh_[2] = RW_BF4LO(r##S##D); wh_[7] = RW_BF4HI(r##S##D); wh_[3] = RW_BF4LO(r##S##R); wh_[8] = RW_BF4HI(r##S##R); \
        wq_[stv * 84 + 80 + cvl] = r##S##V; } while (0)
        float* buf0 = lds; float* buf1 = lds + RW_TB * RW_STEPF;
        float4 cv0, cv1, cv2, cv3, cv4, cv5, cv6, cv7;
        const unsigned long long* cttab = (const unsigned long long*)((const char*)lds + CTTAB_OFF);
        const int cgw = wg * 4 + (wave - 4), cnw = nwg * 4;
        char* const ctlds = (char*)lds + 2 * RW_TB * RW_STEPF * 4 + (wave - 4) * CT_LDS_BYTES;
        if (loader) { RW_LOAD_BLOCK(0, A); RW_WRITE_BLOCK(buf0, A); RW_LOAD_BLOCK(1, A); RW_LOAD_BLOCK(2, B); CT_LOAD(ct_begin + cgw); }
        __syncthreads();
        f2v Sa = {0.f, 0.f}, Sb = {0.f, 0.f};
        float* const Yd = dir ? p.Y[1] : p.Y[0];
        const int seg = lane & 15, vrl = wave * 4 + (lane >> 4);
#define RW_LOADER_STEP(BLK, NXT, S) do { __builtin_amdgcn_s_setprio(0); RW_WRITE_BLOCK(NXT, S); RW_LOAD_BLOCK((BLK) + 3, S); \
        { const int tcur = ct_begin + (BLK) * cnw + cgw; CT_STORE(tcur, ctlds); CT_LOAD(tcur + cnw); } } while (0)
#define RW_CONSUME(BLK, CUR) do { __builtin_amdgcn_s_setprio(3); \
        float ylo = 0.f, yhi = 0.f; \
        const float* sp0 = (CUR) + seg * 20; const float* vp0 = (CUR) + 320 + vrl; \
        float4 w4 = *(const float4*)(sp0), k4 = *(const float4*)(sp0 + 4), n4 = *(const float4*)(sp0 + 8), d4 = *(const float4*)(sp0 + 12), r4 = *(const float4*)(sp0 + 16); \
        float v = vp0[0]; \
        _Pragma("unroll") for (int s = 0; s < RW_TB; ++s) { \
            float4 w4n = w4, k4n = k4, n4n = n4, d4n = d4, r4n = r4; float vn = v; \
            if (s + 1 < RW_TB) { const float* sp = sp0 + (s + 1) * RW_STEPF; \
                w4n = *(const float4*)(sp); k4n = *(const float4*)(sp + 4); n4n = *(const float4*)(sp + 8); d4n = *(const float4*)(sp + 12); r4n = *(const float4*)(sp + 16); \
                vn = vp0[(s + 1) * RW_STEPF]; } \
            __builtin_amdgcn_sched_barrier(0); \
            const f2v wA = {w4.x, w4.y}, wB = {w4.z, w4.w}, kA = {k4.x, k4.y}, kB = {k4.z, k4.w}, nA = {n4.x, n4.y}, nB = {n4.z, n4.w}; \
            const f2v dA = {d4.x, d4.y}, dB = {d4.z, d4.w}, rA = {r4.x, r4.y}, rB = {r4.z, r4.w}; \
            f2v t = Sa * kA; t = __builtin_elementwise_fma(Sb, kB, t); \
            const float sa = dpp_add16(t.x + t.y); \
            const f2v sav = {sa, sa}, vv = {v, v}; \
            const f2v tA = __builtin_elementwise_fma(sav, nA, vv * dA), tB = __builtin_elementwise_fma(sav, nB, vv * dB); \
            Sa = __builtin_elementwise_fma(Sa, wA, tA); Sb = __builtin_elementwise_fma(Sb, wB, tB); \
            f2v yy = Sa * rA; yy = __builtin_elementwise_fma(Sb, rB, yy); \
            const float y = dpp_add16(yy.x + yy.y); \
            if (s < 16) ylo = (seg == s) ? y : ylo; else yhi = (seg == (s - 16)) ? y : yhi; \
            w4 = w4n; k4 = k4n; n4 = n4n; d4 = d4n; r4 = r4n; v = vn; } \
        const int blk_ = (BLK); const int T = blk_ < TC / RW_TB ? TC : TL, base = blk_ < TC / RW_TB ? NL + b * TC : b * TL, i0 = blk_ < TC / RW_TB ? blk_ * RW_TB : (blk_ - TC / RW_TB) * RW_TB; \
        const int ia = i0 + seg, ib = i0 + 16 + seg; \
        const int ta = dir ? T - 1 - ia : ia, tb = dir ? T - 1 - ib : ib; \
        Yd[(size_t)(base + ta) * 1024 + h * 64 + rg * 16 + vrl] = ylo; \
        Yd[(size_t)(base + tb) * 1024 + h * 64 + rg * 16 + vrl] = yhi; \
        __builtin_amdgcn_s_setprio(0); } while (0)
        for (int blk = 0; blk < RW_NBLK; blk += 2) {
            if (loader) RW_LOADER_STEP(blk, buf1, A); else RW_CONSUME(blk, buf0);
            lds_barrier();
            if (loader) RW_LOADER_STEP(blk + 1, buf0, B); else RW_CONSUME(blk + 1, buf1);
            lds_barrier();
        }
        __syncthreads();
    }
}

__device__ __forceinline__ void ph_rwout(const Params& p, int wg, int nwg) {
    const int tid_ = ptid(); const int wave = tid_ >> 6, lane = tid_ & 63;
    for (int row = wg; row < NT; row += nwg) {
#pragma unroll
        for (int hh = 0; hh < 2; ++hh) {
            const int h = wave * 2 + hh;
            const size_t o = (size_t)row * 1024 + h * 64 + lane;
            const float y = p.Y[0][o] + p.Y[1][o];
            const float mu = wave_sum(y) * (1.f / 64.f);
            const float dlt = y - mu;
            const float var = wave_sum(dlt * dlt) * (1.f / 64.f);
            const float yn = dlt * rsqrtf(var + 64e-5f) * p.in[18][h * 64 + lane] + p.in[19][h * 64 + lane];
            const float r = bf2f(p.R[o]), kb = 0.5f * (bf2f(p.KD[0][o]) + bf2f(p.KD[1][o]));
            const float bs = wave_sum(r * kb * p.in[17][h * 64 + lane]);
            p.MIXb[(size_t)row * DM + h * 64 + lane] = f2bf((yn + bs * p.V[o]) * p.G[o]);
        }
    }
}

__device__ __forceinline__ void ph_naprep(const Params& p, float* lds, int wg, int nwg) {
    const int tid = ptid(), wave = tid >> 6, lane = tid & 63;
    {
        const float kb = 8.f * wave_max(fabsf(p.in[21][lane]));
        float bmax[2];
#pragma unroll
        for (int hh = 0; hh < 2; ++hh) { float m = 0.f; for (int i = lane; i < 465; i += 64) m = fmaxf(m, fabsf(p.in[22][(wave * 2 + hh) * 465 + i])); bmax[hh] = wave_max(m); }
        for (int row = wg; row < NT; row += nwg) {
#pragma unroll
            for (int hh = 0; hh < 2; ++hh) {
                const int h = wave * 2 + hh;
                const float q = bf2f(p.P[(size_t)row * L0LD + RWC + h * 64 + lane]);
                const float k = bf2f(p.P[(size_t)row * L0LD + RWC + 1024 + h * 64 + lane]);
                const float qs = wave_sum(q * q) * (1.f / 64.f), ks = wave_sum(k * k) * (1.f / 64.f);
                const float qn = q * rsqrtf(qs + 1e-6f) * p.in[20][lane] * 0.125f, kn = k * rsqrtf(ks + 1e-6f) * p.in[21][lane];
                p.Qb[(size_t)row * 1024 + h * 64 + lane] = f2bf(qn);
                { const int kb_ = row < NL ? row / TL : (row - NL) / TC, tp_ = row < NL ? row % TL : TL + (row - NL) % TC;
                  p.Kb[((((size_t)(kb_ * 16 + h) * 136 + (tp_ >> 5)) * 4 + (lane >> 4)) * 64 + ((lane >> 3) & 1) * 32 + (tp_ & 31)) * 8 + (lane & 7)] = f2bf(kn); }
                const float qq = wave_sum(qn * qn);
                if (lane == 0) p.QM[row * 16 + h] = (sqrtf(qq) * kb * 1.01f + bmax[hh]) * 1.44269504f;
            }
        }
    }
    {
        bf16_t* T = (bf16_t*)lds;
        for (int item = wg; item < 136 * 8; item += nwg) {
            const int tb = item >> 3, hg = item & 7;
            const int row0 = tb < 128 ? tb * 64 : NL + (tb - 128) * 64;
            {
                const int tok = tid >> 3, c16 = (tid & 7) * 16;
                const bf16_t* src = p.P + (size_t)(row0 + tok) * L0LD + RWC + 2048 + hg * 128 + c16;
                const uint4 va4 = *(const uint4*)src, vb4 = *(const uint4*)(src + 8);
                const unsigned wv[8] = {va4.x, va4.y, va4.z, va4.w, vb4.x, vb4.y, vb4.z, vb4.w};
#pragma unroll
                for (int q = 0; q < 8; ++q) { T[(c16 + 2 * q) * 72 + tok] = (bf16_t)(wv[q] & 0xffffu); T[(c16 + 2 * q + 1) * 72 + tok] = (bf16_t)(wv[q] >> 16); }
            }
            __syncthreads();
            {
                const int b = tb < 128 ? tb >> 6 : (tb - 128) >> 2, tile0 = tb < 128 ? (tb & 63) * 2 : 128 + ((tb - 128) & 3) * 2;
#pragma unroll
                for (int q = 0; q < 2; ++q) {
                    const int idx = tid + NTHR * q, ln = idx & 63, sq = (idx >> 6) & 1, nt = (idx >> 7) & 1, tl = (idx >> 8) & 1, hl = idx >> 9;
                    const int rr = ln & 31, hh2 = ln >> 5, ch = hl * 64 + 32 * nt + rr, tk0 = tl * 32 + 16 * sq + 4 * hh2;
                    const uint2 lo = *(const uint2*)(T + ch * 72 + tk0), hi = *(const uint2*)(T + ch * 72 + tk0 + 8);
                    *(uint4*)(p.VTl + ((((size_t)(b * 16 + 2 * hg + hl) * 136 + tile0 + tl) * 2 + nt) * 2 + sq) * 512 + ln * 8) = make_uint4(lo.x, lo.y, hi.x, hi.y);
                }
            }
            __syncthreads();
        }
    }
}

typedef float f32x16 __attribute__((ext_vector_type(16)));
template <bool BAND>
__device__ __forceinline__ void na_tile(const Params& p, const float* tab, const pg8::bf16x8 (&qf)[4], int keyrow0, const bf16_t* vtp, int vstride, int h, int r, int hh,
                                        int kc0, int q, int c0, int browoff, float mq, f32x16& o0, f32x16& o1, float& l) {
    pg8::bf16x8 kf[4];
#pragma unroll
    for (int ks = 0; ks < 4; ++ks) kf[ks] = *(const pg8::bf16x8*)(p.Kb + ((size_t)keyrow0 * 4 + ks) * 512 + (hh * 32 + r) * 8);
    pg8::bf16x8 vf[2][2];
#pragma unroll
    for (int nt = 0; nt < 2; ++nt)
#pragma unroll
        for (int s = 0; s < 2; ++s) vf[nt][s] = *(const pg8::bf16x8*)(vtp + ((nt * 2 + s) * 64 + hh * 32 + r) * 8);
    f32x16 sacc;
#pragma unroll
    for (int i = 0; i < 16; ++i) sacc[i] = 0.f;
#pragma unroll
    for (int ks = 0; ks < 4; ++ks) sacc = __builtin_amdgcn_mfma_f32_32x32x16_bf16(kf[ks], qf[ks], sacc, 0, 0, 0);
    float pv[16];
#pragma unroll
    for (int reg = 0; reg < 16; ++reg) {
        float sc = sacc[reg];
        if (BAND) {
            const int kc = kc0 + (reg & 3) + 8 * (reg >> 2) + 4 * hh;
            const bool valid = (unsigned)(kc - c0) < 16u;
            const int bi = valid ? browoff + kc - q + 15 : 0;
            sc += tab[bi];
            pv[reg] = valid ? __builtin_amdgcn_exp2f(sc * 1.44269504f - mq) : 0.f;
        } else pv[reg] = __builtin_amdgcn_exp2f(sc * 1.44269504f - mq);
        l += pv[reg];
    }
    pg8::bf16x8 pf[2];
#pragma unroll
    for (int s = 0; s < 2; ++s) { const pg8::u32x4 w = {cvt_pk_bf16(pv[8 * s], pv[8 * s + 1]), cvt_pk_bf16(pv[8 * s + 2], pv[8 * s + 3]), cvt_pk_bf16(pv[8 * s + 4], pv[8 * s + 5]), cvt_pk_bf16(pv[8 * s + 6], pv[8 * s + 7])};
        pf[s] = __builtin_bit_cast(pg8::bf16x8, w); }
#pragma unroll
    for (int s = 0; s < 2; ++s) { o0 = __builtin_amdgcn_mfma_f32_32x32x16_bf16(vf[0][s], pf[s], o0, 0, 0, 0); o1 = __builtin_amdgcn_mfma_f32_32x32x16_bf16(vf[1][s], pf[s], o1, 0, 0, 0); }
}
__device__ __forceinline__ void ph_naattn(const Params& p, float* lds, int wg, int nwg) {
    const int tid = ptid(), wave = __builtin_amdgcn_readfirstlane(tid >> 6), lane = tid & 63, r = lane & 31, hh = lane >> 5;
    float* tab = lds + wave * 512;
    for (int u = wg * 8 + wave; u < 4096 + 256; u += nwg * 8) {
        int b, h, qrow0, nband = 0, gr = 0, r0 = 0, q0 = 0;
        if (u < 4096) { h = u & 15; int x = u >> 4; q0 = (x & 1) * 32; x >>= 1; gr = x & 63; b = x >> 6; qrow0 = b * TL + gr * 64 + q0; r0 = gr - 4; r0 = r0 < 0 ? 0 : (r0 > 56 ? 56 : r0); nband = 8; }
        else { int x = u - 4096; h = x & 15; x >>= 4; b = x >> 3; qrow0 = NL + b * TC + (x & 7) * 32; }
        if (nband) for (int i = lane; i < 465; i += 64) tab[i] = p.in[22][h * 465 + i];
        pg8::bf16x8 qf[4];
#pragma unroll
        for (int ks = 0; ks < 4; ++ks) qf[ks] = *(const pg8::bf16x8*)(p.Qb + (size_t)(qrow0 + r) * 1024 + h * 64 + 16 * ks + 8 * hh);
        const float mq = p.QM[(qrow0 + r) * 16 + h];
        f32x16 o0, o1;
#pragma unroll
        for (int i = 0; i < 16; ++i) { o0[i] = 0.f; o1[i] = 0.f; }
        float l = 0.f;
        const int q = q0 + r; int c0 = q - 8; c0 = c0 < 0 ? 0 : (c0 > 48 ? 48 : c0);
        for (int tl = 0; tl < nband * 2; ++tl) {
            const int i = tl >> 1, kt = tl & 1;
            { const int tid_ = (b * 16 + h) * 136 + (r0 + i) * 2 + kt; na_tile<true>(p, tab, qf, tid_, p.VTl + (size_t)tid_ * 2048, TL, h, r, hh, 32 * kt, q, c0, (r0 + i - gr + 7) * 31, mq, o0, o1, l); }
        }
        for (int kt = 0; kt < 8; ++kt)
            { const int tid_ = (b * 16 + h) * 136 + 128 + kt; na_tile<false>(p, tab, qf, tid_, p.VTl + (size_t)tid_ * 2048, TC, h, r, hh, 0, 0, 0, 0, mq, o0, o1, l); }
        l += __shfl_xor(l, 32);
        const float inv = 1.f / l;
        bf16_t* dst = p.MIXb + (size_t)(qrow0 + r) * DM + 1024 + h * 64 + 4 * hh;
#pragma unroll
        for (int g4 = 0; g4 < 4; ++g4) {
            uint2 w0, w1;
            w0.x = cvt_pk_bf16(o0[4 * g4] * inv, o0[4 * g4 + 1] * inv); w0.y = cvt_pk_bf16(o0[4 * g4 + 2] * inv, o0[4 * g4 + 3] * inv);
            w1.x = cvt_pk_bf16(o1[4 * g4] * inv, o1[4 * g4 + 1] * inv); w1.y = cvt_pk_bf16(o1[4 * g4 + 2] * inv, o1[4 * g4 + 3] * inv);
            *(uint2*)(dst + 8 * g4) = w0; *(uint2*)(dst + 32 + 8 * g4) = w1;
        }
    }
}

#define GLA_NCH 68
#define GLA_LDP 264
__device__ __forceinline__ void ph_glaprep(const Params& p, float* lds, int wg, int nwg) {
    bf16_t* Qs = (bf16_t*)lds;
    bf16_t* Ks = Qs + 64 * GLA_LDP;
    float* lrs = (float*)(Ks + 64 * GLA_LDP);
    float* hsum = lrs + 64 * 16;
    const int tid = ptid(), wave = __builtin_amdgcn_readfirstlane(tid >> 6), lane = tid & 63;
    for (int unit = wg; unit < 16 * GLA_NCH; unit += nwg) {
        const int bhd = unit / GLA_NCH, c = unit % GLA_NCH;
        const int b = bhd >> 3, h = (bhd >> 1) & 3, dir = bhd & 1;
        const bool isctx = c < 4;
        const int T = isctx ? TC : TL, base = isctx ? NL + b * TC : b * TL, cc = isctx ? c : c - 4;
        for (int q = tid; q < 64 * 16; q += NTHR) { const int i = q >> 4, j = q & 15, idx = cc * 64 + i, t = dir ? T - 1 - idx : idx;
            lrs[q] = p.LRs[(size_t)(base + t) * 256 + 16 * dir + j]; }
#pragma unroll
        for (int q4 = 0; q4 < 4; ++q4) { const int e = tid + q4 * NTHR, i = e >> 5, c8 = e & 31, idx = cc * 64 + i, t = dir ? T - 1 - idx : idx;
            const bf16_t* pr = p.P + (size_t)(base + t) * L1LD + h * 256 + c8 * 8;
            *(uint4*)(Ks + i * GLA_LDP + c8 * 8) = *(const uint4*)pr;
            if (!isctx) *(uint4*)(Qs + i * GLA_LDP + c8 * 8) = *(const uint4*)(pr + 3104); }
        __syncthreads();
        {
            const int d = tid & 255, hf = tid >> 8, ch = h * 256 + d;
            float w2[16];
#pragma unroll
            for (int j = 0; j < 16; ++j) w2[j] = p.in[32][(size_t)(dir * 16 + j) * 1024 + ch];
            const float bias = p.in[33][dir * 1024 + ch];
            float lg[32]; float ls = 0.f;
#pragma unroll
            for (int i = 0; i < 32; ++i) { float x = bias;
#pragma unroll
                for (int j = 0; j < 16; ++j) x += lrs[(32 * hf + i) * 16 + j] * w2[j];
                lg[i] = -softplusf(-x) * (1.f / 16.f); ls += lg[i]; }
            hsum[hf * 256 + d] = ls;
            __syncthreads();
            const float bend = hsum[d] + hsum[256 + d];
            float bb = hf ? hsum[d] : 0.f, prev = 0.f; unsigned khp[16];
#pragma unroll
            for (int i = 0; i < 32; ++i) {
                const int ii = 32 * hf + i, idx = cc * 64 + ii, t = dir ? T - 1 - idx : idx;
                bb += lg[i]; (void)t;
                const float k = bf2f(Ks[ii * GLA_LDP + d]);
                const float kh = k * __expf(bend - bb);
                if (!isctx) { const float qt = bf2f(Qs[ii * GLA_LDP + d]) * __expf(bb) * 0.0625f, kt = k * __expf(-bb);
                    const bf16_t qb = f2bf(qt); Qs[ii * GLA_LDP + d] = qb; Ks[ii * GLA_LDP + d] = f2bf(kt); p.QT[(size_t)unit * 16384 + ((((ii >> 4) * 8 + (d >> 5)) * 64 + ((d >> 3) & 3) * 16 + (ii & 15)) * 8) + (d & 7)] = qb; }
                if (i & 1) khp[i >> 1] = cvt_pk_bf16(prev, kh); else prev = kh;
            }
            bf16_t* kd = p.KHT + (size_t)unit * 16384 + ((size_t)(((d >> 4) * 2 + hf) * 64 + (d & 15))) * 8;
#pragma unroll
            for (int q = 0; q < 4; ++q) *(uint4*)(kd + q * 128) = make_uint4(khp[4 * q], khp[4 * q + 1], khp[4 * q + 2], khp[4 * q + 3]);
            if (hf == 0) p.DEC[unit * 256 + d] = __expf(bend);
        }
        {
            const int v0 = tid;
            unsigned va[32];
#pragma unroll
            for (int i = 0; i < 64; i += 2) {
                const int idx0 = cc * 64 + i, t0 = dir ? T - 1 - idx0 : idx0, t1 = dir ? t0 - 1 : t0 + 1;
                const unsigned x0 = p.P[(size_t)(base + t0) * L1LD + 1024 + h * 512 + v0];
                const unsigned x1 = p.P[(size_t)(base + t1) * L1LD + 1024 + h * 512 + v0];
                va[i >> 1] = x0 | (x1 << 16);
            }
            bf16_t* d0 = p.VT + (size_t)unit * 32768 + ((size_t)((v0 >> 4) * 2 * 64 + (v0 & 15))) * 8;
#pragma unroll
            for (int q = 0; q < 8; ++q) *(uint4*)(d0 + ((q >> 2) * 64 + (q & 3) * 16) * 8) = make_uint4(va[4 * q], va[4 * q + 1], va[4 * q + 2], va[4 * q + 3]);
        }
        __syncthreads();
        if (!isctx) {
            const int r = lane & 15, g = lane >> 4, ti = wave >> 1;
#pragma unroll
            for (int q = 0; q < 2; ++q) {
                const int tj = (wave & 1) * 2 + q;
                pg8::f32x4 acc = {0.f, 0.f, 0.f, 0.f};
                if (tj <= ti) {
#pragma unroll
                    for (int ks = 0; ks < 8; ++ks) {
                        const pg8::bf16x8 a = *(const pg8::bf16x8*)(Ks + (tj * 16 + r) * GLA_LDP + ks * 32 + 8 * g);
                        const pg8::bf16x8 bq = *(const pg8::bf16x8*)(Qs + (ti * 16 + r) * GLA_LDP + ks * 32 + 8 * g);
                        acc = __builtin_amdgcn_mfma_f32_16x16x32_bf16(a, bq, acc, 0, 0, 0);
                    }
                }
                const int i = ti * 16 + r, j0 = tj * 16 + 4 * g;
                uint2 o;
                o.x = cvt_pk_bf16(j0 + 0 <= i ? acc[0] : 0.f, j0 + 1 <= i ? acc[1] : 0.f);
                o.y = cvt_pk_bf16(j0 + 2 <= i ? acc[2] : 0.f, j0 + 3 <= i ? acc[3] : 0.f);
                *(uint2*)(p.AM + (size_t)unit * 4096 + ((((i >> 4) * 2 + (j0 >> 5)) * 64 + ((j0 >> 3) & 3) * 16 + (i & 15)) * 8) + (j0 & 7)) = o;
            }
        }
        __syncthreads();
    }
}

#define GLA_LOAD_O(QT_, AM_, C_) do { const int c_ = (C_) < GLA_NCH ? (C_) : GLA_NCH - 1; const size_t u = (size_t)(bhd * GLA_NCH + c_); \
        _Pragma("unroll") for (int ks = 0; ks < 8; ++ks) QT_[ks] = *(const pg8::bf16x8*)(p.QT + u * 16384 + ((it * 8 + ks) * 64 + lane) * 8); \
        _Pragma("unroll") for (int ks = 0; ks < 2; ++ks) AM_[ks] = *(const pg8::bf16x8*)(p.AM + u * 4096 + ((it * 2 + ks) * 64 + lane) * 8); } while (0)
#define GLA_LOAD_S(KH_, VT_, DEC_, C_) do { const int c_ = (C_) < GLA_NCH ? (C_) : GLA_NCH - 1; const size_t u = (size_t)(bhd * GLA_NCH + c_); \
    _Pragma("unroll") for (int dt = 0; dt < 2; ++dt) { \
        _Pragma("unroll") for (int ks = 0; ks < 2; ++ks) { \
            KH_[dt][ks] = *(const pg8::bf16x8*)(p.KHT + u * 16384 + (((2 * w + dt) * 2 + ks) * 64 + lane) * 8); \
            VT_[dt][ks] = *(const pg8::bf16x8*)(p.VT + u * 32768 + (((vs * 2 + dt) * 2 + ks) * 64 + lane) * 8); } \
        DEC_[dt] = *(const pg8::f32x4*)(p.DEC + u * 256 + (2 * w + dt) * 16 + 4 * g); } } while (0)
#define GLA_LOAD_OVT(OVT_, C_) do { const size_t u = (size_t)(bhd * GLA_NCH + (C_)); _Pragma("unroll") for (int ks = 0; ks < 2; ++ks) OVT_[ks] = *(const pg8::bf16x8*)(p.VT + (u * 512 + vs * 32 + vt * 16 + r) * 64 + ks * 32 + 8 * g); } while (0)
__device__ __forceinline__ void ph_glascan(const Params& p, float* lds, int wg, int nwg, int gct_begin) {
    const unsigned long long* cttab = (const unsigned long long*)((const char*)lds + CTTAB_OFF);
    bf16_t* ST0 = (bf16_t*)lds; bf16_t* ST1 = ST0 + 32 * GLA_LDP;
    const int tid = ptid(), w = __builtin_amdgcn_readfirstlane(tid >> 6), lane = tid & 63, r = lane & 15, g = lane >> 4;
    const int it = w >> 1, vt = w & 1;
    for (int unit = wg; unit < 256; unit += nwg) {
        const int bhd = (unit & 7) * 2 + ((unit >> 3) & 1), vs = unit >> 4;
        const int b = bhd >> 3, h = (bhd >> 1) & 3, dir = bhd & 1;
        float* const Od = dir ? p.O[1] : p.O[0];
        for (int q = tid; q < 32 * GLA_LDP / 2; q += NTHR) ((unsigned*)ST0)[q] = 0u;
        pg8::f32x4 acc[2][2];
#pragma unroll
        for (int a = 0; a < 2; ++a)
#pragma unroll
            for (int c2 = 0; c2 < 2; ++c2) acc[a][c2] = (pg8::f32x4){0.f, 0.f, 0.f, 0.f};
        __syncthreads();
        pg8::bf16x8 cqt[8], cam[2], ckh[2][2], cvt[2][2], nkh[2][2], nvt[2][2]; pg8::f32x4 cdec[2], ndec[2];
        const pg8::bf16x8 zz = {0, 0, 0, 0, 0, 0, 0, 0};
#pragma unroll
        for (int ks = 0; ks < 8; ++ks) cqt[ks] = zz;
#pragma unroll
        for (int ks = 0; ks < 2; ++ks) cam[ks] = zz;
        GLA_LOAD_S(ckh, cvt, cdec, 0);
        float4 cv0, cv1, cv2, cv3, cv4, cv5, cv6, cv7; CT_LOAD(gct_begin + wg * 8 + w);
        const int gct_nch = (CT_TOTAL - gct_begin + nwg * 8 - 1) / (nwg * 8);
        for (int c = 0; c < GLA_NCH; ++c) {
            GLA_LOAD_S(nkh, nvt, ndec, c + 1);
            bf16_t* STc = (c & 1) ? ST1 : ST0; bf16_t* STn = (c & 1) ? ST0 : ST1;
#pragma unroll
            for (int dt = 0; dt < 2; ++dt)
#pragma unroll
                for (int v2 = 0; v2 < 2; ++v2) {
                    pg8::f32x4 a = acc[dt][v2] * cdec[dt];
#pragma unroll
                    for (int ks = 0; ks < 2; ++ks) a = __builtin_amdgcn_mfma_f32_16x16x32_bf16(ckh[dt][ks], cvt[v2][ks], a, 0, 0, 0);
                    acc[dt][v2] = a;
                    uint2 sv; sv.x = cvt_pk_bf16(a[0], a[1]); sv.y = cvt_pk_bf16(a[2], a[3]);
                    *(uint2*)(STn + (v2 * 16 + r) * GLA_LDP + (2 * w + dt) * 16 + 4 * g) = sv;
                }
            if (c >= 4) {
                pg8::f32x4 o = {0.f, 0.f, 0.f, 0.f};
#pragma unroll
                for (int ks = 0; ks < 8; ++ks) { const pg8::bf16x8 sa = *(const pg8::bf16x8*)(STc + (vt * 16 + r) * GLA_LDP + ks * 32 + 8 * g);
                    o = __builtin_amdgcn_mfma_f32_16x16x32_bf16(sa, cqt[ks], o, 0, 0, 0); }
                if (vt == 0) {
#pragma unroll
                    for (int ks = 0; ks < 2; ++ks) o = __builtin_amdgcn_mfma_f32_16x16x32_bf16(cvt[0][ks], cam[ks], o, 0, 0, 0);
                } else {
#pragma unroll
                    for (int ks = 0; ks < 2; ++ks) o = __builtin_amdgcn_mfma_f32_16x16x32_bf16(cvt[1][ks], cam[ks], o, 0, 0, 0);
                }
                const int idx = (c - 4) * 64 + it * 16 + r, t = dir ? TL - 1 - idx : idx;
                *(pg8::f32x4*)(Od + (size_t)(b * TL + t) * DM + h * 512 + vs * 32 + vt * 16 + 4 * g) = o;
            }
            if (c >= 3) GLA_LOAD_O(cqt, cam, c + 1);
#pragma unroll
            for (int ks = 0; ks < 2; ++ks) { cdec[ks] = ndec[ks];
#pragma unroll
                for (int q = 0; q < 2; ++q) { ckh[ks][q] = nkh[ks][q]; cvt[ks][q] = nvt[ks][q]; } }
            {
                const int tconv = gct_begin + c * (nwg * 8) + wg * 8 + w;
                if (c < gct_nch) { CT_STORE(tconv, 0); if (c + 1 < gct_nch) CT_LOAD(tconv + nwg * 8); }
            }
            lds_barrier();
        }
    }
}

__device__ __forceinline__ void ph_glaout(const Params& p, float* lds, int wg, int nwg) {
    (void)lds;
    const int tid = ptid(), wave = tid >> 6, lane = tid & 63;
    for (int row = wg * 8 + wave; row < NL; row += nwg * 8) {
        float4 o[8]; float hs[4] = {0.f, 0.f, 0.f, 0.f};
#pragma unroll
        for (int q = 0; q < 8; ++q) { const float4 a = ((const float4*)(p.O[0] + (size_t)row * DM))[lane + 64 * q], c = ((const float4*)(p.O[1] + (size_t)row * DM))[lane + 64 * q];
            o[q] = make_float4(a.x + c.x, a.y + c.y, a.z + c.z, a.w + c.w); hs[q >> 1] += o[q].x * o[q].x + o[q].y * o[q].y + o[q].z * o[q].z + o[q].w * o[q].w; }
#pragma unroll
        for (int hd = 0; hd < 4; ++hd) hs[hd] = rsqrtf(wave_sum(hs[hd]) * (1.f / 512.f) + 1e-6f);
#pragma unroll
        for (int q = 0; q < 8; ++q) {
            const float rs = hs[q >> 1];
            const float4 gn = ((const float4*)p.in[34])[lane + 64 * (q & 1)];
            const uint2 ogr = ((const uint2*)(p.P + (size_t)row * L1LD + 4128))[lane + 64 * q];
            const float4 og = make_float4(__uint_as_float(ogr.x << 16), __uint_as_float(ogr.x & 0xffff0000u), __uint_as_float(ogr.y << 16), __uint_as_float(ogr.y & 0xffff0000u));
            uint2 r;
            r.x = cvt_pk_bf16(o[q].x * rs * gn.x * siluf(og.x), o[q].y * rs * gn.y * siluf(og.y));
            r.y = cvt_pk_bf16(o[q].z * rs * gn.z * siluf(og.z), o[q].w * rs * gn.w * siluf(og.w));
            ((uint2*)(p.MIXb + (size_t)row * DM))[lane + 64 * q] = r;
        }
    }
}

__device__ __forceinline__ void ph_route(const Params& p, float* lds, int wg, int nwg) {
    float* rt = lds;
    const int tid = ptid(), wave = tid >> 6, lane = tid & 63;
    for (int i = tid; i < DM * 2; i += NTHR) { const float4 r = ((const float4*)p.in[36])[i]; const int k = i >> 1, e0 = (i & 1) * 4;
        rt[(e0 + 0) * DM + k] = r.x; rt[(e0 + 1) * DM + k] = r.y; rt[(e0 + 2) * DM + k] = r.z; rt[(e0 + 3) * DM + k] = r.w; }
    __syncthreads();
    for (int row = wg * 8 + wave; row < NL; row += nwg * 8) {
        float ss = 0.f;
#pragma unroll
        for (int q = 0; q < 8; ++q) { const float4 t = ((const float4*)(p.XA + (size_t)row * DM))[lane + 64 * q]; ss += t.x * t.x + t.y * t.y + t.z * t.z + t.w * t.w; }
        ss = wave_sum(ss);
        const float rs = rsqrtf(ss * (1.f / DM) + 1e-6f);
        const int g = row / TL;
        float l[8];
#pragma unroll
        for (int e = 0; e < 8; ++e) l[e] = 0.f;
#pragma unroll 2
        for (int q = 0; q < 8; ++q) {
            const int idx = lane + 64 * q;
            const float4 vq = ((const float4*)(p.XA + (size_t)row * DM))[idx];
            const float4 gn = ((const float4*)p.in[30])[idx];
            const float4 sh = ((const float4*)(p.mod1 + g * MODW + 3 * DM))[idx];
            const float4 sc = ((const float4*)(p.mod1 + g * MODW + 4 * DM))[idx];
            float4 hv;
            hv.x = vq.x * rs * gn.x * (1.f + sc.x) + sh.x; hv.y = vq.y * rs * gn.y * (1.f + sc.y) + sh.y;
            hv.z = vq.z * rs * gn.z * (1.f + sc.z) + sh.z; hv.w = vq.w * rs * gn.w * (1.f + sc.w) + sh.w;
            uint2 hb; hb.x = cvt_pk_bf16(hv.x, hv.y); hb.y = cvt_pk_bf16(hv.z, hv.w);
            ((uint2*)(p.Hb + (size_t)row * DM))[idx] = hb;
#pragma unroll
            for (int e = 0; e < 8; ++e) { const float4 r = ((const float4*)(rt + e * DM))[idx]; l[e] += hv.x * r.x + hv.y * r.y + hv.z * r.z + hv.w * r.w; }
        }
#pragma unroll
        for (int e = 0; e < 8; ++e) l[e] = wave_sum(l[e]);
        if (lane == 0) {
            int e0 = 0; float v0 = l[0];
#pragma unroll
            for (int e = 1; e < 8; ++e) if (l[e] > v0) { v0 = l[e]; e0 = e; }
            int e1 = -1; float v1 = -3.0e38f;
#pragma unroll
            for (int e = 0; e < 8; ++e) if (e != e0 && l[e] > v1) { v1 = l[e]; e1 = e; }
            const float w1 = 1.f / (1.f + expf(v0 - v1)), w0 = 1.f - w1;
            p.tok_e[row * 2] = e0; p.tok_e[row * 2 + 1] = e1; p.tok_w[row * 2] = w0; p.tok_w[row * 2 + 1] = w1;
        }
    }
    __syncthreads();
}

__device__ __forceinline__ void ph_dispatch_permute(const Params& p, float* lds, int wg, int nwg) {
    int* wtot = (int*)lds;
    int* pairs = wtot + 64;
    const int tid = ptid(), wave = tid >> 6, lane = tid & 63;
    int c[8];
#pragma unroll
    for (int e = 0; e < 8; ++e) c[e] = 0;
    for (int i = 0; i < 16; ++i) { const int tok = tid * 16 + i; const int ea = p.tok_e[tok * 2], eb = p.tok_e[tok * 2 + 1];
#pragma unroll
        for (int e = 0; e < 8; ++e) c[e] += (e == ea) + (e == eb); }
    int inc[8];
#pragma unroll
    for (int e = 0; e < 8; ++e) { int v = c[e];
#pragma unroll
        for (int o = 1; o < 64; o <<= 1) { const int t = __shfl_up(v, o); if (lane >= o) v += t; }
        inc[e] = v; }
    if (lane == 63) {
#pragma unroll
        for (int e = 0; e < 8; ++e) wtot[wave * 8 + e] = inc[e]; }
    __syncthreads();
    int pos[8], off[8], tot[8]; int total = 0;
#pragma unroll
    for (int e = 0; e < 8; ++e) { int base = 0, t = 0;
#pragma unroll
        for (int w8 = 0; w8 < 8; ++w8) { const int x = wtot[w8 * 8 + e]; base += (w8 < wave) ? x : 0; t += x; }
        tot[e] = t; off[e] = total; pos[e] = total + base + inc[e] - c[e]; total += ((t + 255) >> 8) << 8; }
    if (wg == 0 && tid == 0) {
#pragma unroll
        for (int e = 0; e < 8; ++e) { p.meta[e * 2] = tot[e]; p.meta[e * 2 + 1] = off[e]; const int nt = (tot[e] + 255) >> 8; for (int t = 0; t < nt; ++t) p.tile_e[(off[e] >> 8) + t] = e; }
        p.meta[16] = total;
    }
    int sl[32];
#pragma unroll
    for (int i = 0; i < 16; ++i) {
        const int tok = tid * 16 + i;
#pragma unroll
        for (int k = 0; k < 2; ++k) { const int e = p.tok_e[tok * 2 + k]; int sv = 0;
#pragma unroll
            for (int q = 0; q < 8; ++q) if (q == e) { sv = pos[q]; pos[q]++; }
            sl[i * 2 + k] = sv; }
    }
    for (int g = wg; g < NL / 32; g += nwg) {
        __syncthreads();
        if ((tid >> 1) == g) {
#pragma unroll
            for (int i = 0; i < 16; ++i)
#pragma unroll
                for (int k = 0; k < 2; ++k) { const int tok = tid * 16 + i, idx = (tid & 1) * 32 + i * 2 + k; pairs[idx * 2] = tok; pairs[idx * 2 + 1] = sl[i * 2 + k]; p.tok_slot[tok * 2 + k] = sl[i * 2 + k]; }
        }
        __syncthreads();
        const int half = tid >> 8, t4 = tid & 255;
        for (int q = half; q < 64; q += 8) {
            const int tk0 = pairs[q * 2], sv0 = pairs[q * 2 + 1], tk1 = pairs[q * 2 + 4], sv1 = pairs[q * 2 + 5], tk2 = pairs[q * 2 + 8], sv2 = pairs[q * 2 + 9], tk3 = pairs[q * 2 + 12], sv3 = pairs[q * 2 + 13];
            const uint4 r0 = ((const uint4*)(p.Hb + (size_t)tk0 * DM))[t4], r1 = ((const uint4*)(p.Hb + (size_t)tk1 * DM))[t4], r2 = ((const uint4*)(p.Hb + (size_t)tk2 * DM))[t4], r3 = ((const uint4*)(p.Hb + (size_t)tk3 * DM))[t4];
            ((uint4*)(p.Xp + (size_t)sv0 * DM))[t4] = r0; ((uint4*)(p.Xp + (size_t)sv1 * DM))[t4] = r1; ((uint4*)(p.Xp + (size_t)sv2 * DM))[t4] = r2; ((uint4*)(p.Xp + (size_t)sv3 * DM))[t4] = r3;
        }
    }
    {
        const int half = tid >> 8, t4 = tid & 255; int idx = 0;
#pragma unroll
        for (int e = 0; e < 8; ++e) { const int s0 = off[e] + tot[e], s1 = off[e] + (((tot[e] + 255) >> 8) << 8);
            for (int sv = s0 + half; sv < s1; sv += 2) { if (((idx + sv - s0) >> 1) % nwg == wg) ((uint4*)(p.Xp + (size_t)sv * DM))[t4] = make_uint4(0u, 0u, 0u, 0u); }
            idx += s1 - s0; }
    }
}

__device__ __forceinline__ void moe_tail_split(int ntm, int G, int& nfull, int& ntail, int& KS) {
    const int T = ntm * (DM / 256); nfull = (T / G) * G; ntail = T - nfull; KS = ntail == 0 ? 1 : (ntail * 4 <= G ? 4 : (ntail * 2 <= G ? 2 : 1));
    if (KS == 1) { nfull = T; ntail = 0; }
}
__device__ __forceinline__ float4 moe_fetch(const Params& p, int slot, int tid, int ntm, int nfull, int ntail, int KS) {
    const int pm = slot >> 8, pn = tid >> 6, L = pn * ntm + pm;
    if (L < nfull) { const uint2 r = ((const uint2*)(p.YE + (size_t)slot * DM))[tid]; return make_float4(__uint_as_float(r.x << 16), __uint_as_float(r.x & 0xffff0000u), __uint_as_float(r.y << 16), __uint_as_float(r.y & 0xffff0000u)); }
    const int t = L - nfull; float4 a = make_float4(0.f, 0.f, 0.f, 0.f);
    for (int ks = 0; ks < KS; ++ks) { const float4 q = *(const float4*)(p.YEP + (size_t)(ks * ntail + t) * 65536 + (slot & 255) * 256 + (tid & 63) * 4); a.x += q.x; a.y += q.y; a.z += q.z; a.w += q.w; }
    return a;
}
__device__ __forceinline__ void ph_combine(const Params& p, int wg, int nwg) {
    const int tid = ptid(), wave = tid >> 6, lane = tid & 63;
    const int ntm = p.meta[16] >> 8; int nfull, ntail, KS; moe_tail_split(ntm, nwg, nfull, ntail, KS);
    for (int row = wg * 8 + wave; row < NL; row += nwg * 8) {
        const int s0 = p.tok_slot[row * 2], s1 = p.tok_slot[row * 2 + 1];
        const float w0 = p.tok_w[row * 2], w1 = p.tok_w[row * 2 + 1];
#pragma unroll 4
        for (int q = 0; q < 8; ++q) {
            const int idx = lane + 64 * q;
            const float4 x = ((const float4*)(p.XA + (size_t)row * DM))[idx];
            const float4 g = ((const float4*)(p.mod1 + (row / TL) * MODW + 5 * DM))[idx];
            const float4 a = moe_fetch(p, s0, idx, ntm, nfull, ntail, KS), c = moe_fetch(p, s1, idx, ntm, nfull, ntail, KS);
            float4 o;
            o.x = x.x + g.x * (w0 * a.x + w1 * c.x); o.y = x.y + g.y * (w0 * a.y + w1 * c.y);
            o.z = x.z + g.z * (w0 * a.z + w1 * c.z); o.w = x.w + g.w * (w0 * a.w + w1 * c.w);
            ((float4*)(p.out + (size_t)row * DM))[idx] = o;
        }
    }
}

#define GEMM_STATIC(Aptr, Bptr, Mrows, Ncols, Kdim, EPI) do { pg8::Gemm g_{Aptr, Bptr, Kdim, Kdim}; pg8::StaticOrder S_; S_.init(Mrows, Ncols, nwg, wg); \
    pg8::gemm_phase<decltype(EPI), pg8::StaticOrder, true, true>(ldsb, g_, S_, EPI); } while (0)

__global__ void __launch_bounds__(NTHR, 2) k_all(Params p) {
    extern __shared__ __attribute__((aligned(16))) unsigned char dyn_lds[];
    float* lds = (float*)dyn_lds;
    PG8_LAS unsigned char* ldsb = (PG8_LAS unsigned char*)dyn_lds;
    volatile LAS unsigned* xbw = (volatile LAS unsigned*)(dyn_lds + 131072);
    if (threadIdx.x < 4) xbw[threadIdx.x] = 0u;
    if (threadIdx.x == 64) ct_table_init(p, (unsigned long long*)(dyn_lds + CTTAB_OFF));
    __syncthreads();
    XcdBarrier bar = xcd_barrier_post(p.bar, xbw);
    const int wg = blockIdx.x, nwg = gridDim.x;
#ifndef PROBE
#define PROBE 0
#endif
#define RUN(grp, ...) do { for (int rep_ = 0; rep_ < ((PROBE == (grp)) ? 2 : 1); ++rep_) { __VA_ARGS__ } } while (0)
    const int ct_rest = CT_TOTAL - CT_L0 - RW_NBLK * nwg * 4 - GLA_NCH * nwg * 8;
    const int ct_split = CT_L0 + (ct_rest > 0 ? ct_rest : 0);
    RUN(2, ph_mod(p, lds, wg, nwg); __syncthreads(); ph_lora_wt(p, wg, nwg); ph_convert(p, lds, wg, nwg, ct_split);); xcd_barrier(bar);
    RUN(5, ph_norm(p.in[0], p.in[2], p.in[6], p.mod0, 0, 1, p.Hb, NT, lds, wg, nwg);); xcd_barrier(bar);
    RUN(1, { EpiBf16Store E{p.P, L0LD, nullptr, 0, 0}; GEMM_STATIC(p.Hb, p.Wt_in0, NT, L0LD, DM, E); }); xcd_barrier(bar);
    RUN(3, ph_rwprep(p, lds, wg, nwg); ph_naprep(p, lds, wg, nwg);); xcd_barrier(bar);
    RUN(3, ph_rwscan(p, lds, wg, nwg, ct_split); ph_naattn(p, lds, wg, nwg);); xcd_barrier(bar);
    RUN(3, ph_rwout(p, wg, nwg);); xcd_barrier(bar);
    RUN(1, { EpiResGate E{p.in[0], p.in[2], p.mod0 + 2 * DM, p.XA}; GEMM_STATIC(p.MIXb, p.Wt_out0, NL, DM, DM, E); __syncthreads();
      pg8::Gemm g2{p.MIXb, p.Wt_out0, 256, DM}; pg8::CtxSplitOrder S2{DM / 256, 8, 256, nwg, wg}; EpiCtxPartial E2{p.PC, 256};
      pg8::gemm_phase<EpiCtxPartial, pg8::CtxSplitOrder, true, true>(ldsb, g2, S2, E2); }); xcd_barrier(bar);
    RUN(5, ph_norm(p.XA, p.in[2], p.in[7], p.mod0, 3, 4, p.Hb, NT, lds, wg, nwg, p.PC, 8, p.mod0 + 2 * MODW + 2 * DM, p.XA);); xcd_barrier(bar);
    RUN(1, { EpiSwiglu E{p.H1b, FFN, 0}; GEMM_STATIC(p.Hb, p.Wt_ffnup, NT, 2 * FFN, DM, E); }); xcd_barrier(bar);
    RUN(1, { EpiResGate E{p.XA, p.XA + (size_t)NL * DM, p.mod0 + 5 * DM, p.XB}; GEMM_STATIC(p.H1b, p.Wt_ffndn, NL, DM, FFN, E); __syncthreads();
      pg8::Gemm g2{p.H1b, p.Wt_ffndn, 512, FFN}; pg8::CtxSplitOrder S2{DM / 256, 11, 512, nwg, wg}; EpiCtxPartial E2{p.PC, 512};
      pg8::gemm_phase<EpiCtxPartial, pg8::CtxSplitOrder, true, true>(ldsb, g2, S2, E2); }); xcd_barrier(bar);
    RUN(5, ph_norm(p.XB, p.XA + (size_t)NL * DM, p.in[29], p.mod1, 0, 1, p.Hb, NT, lds, wg, nwg, p.PC, 11, p.mod0 + 2 * MODW + 5 * DM, nullptr);); xcd_barrier(bar);
    RUN(1, { EpiBf16Store E{p.P, L1LD, p.LRs, 12, 0}; GEMM_STATIC(p.Hb, p.Wt_in1, NT, L1LD, DM, E); }); xcd_barrier(bar);
    RUN(4, ph_glaprep(p, lds, wg, nwg);); xcd_barrier(bar);
    RUN(4, ph_glascan(p, lds, wg, nwg, ct_split + RW_NBLK * nwg * 4);); xcd_barrier(bar);
    RUN(4, ph_glaout(p, lds, wg, nwg);); xcd_barrier(bar);
    RUN(1, { EpiResGate E{p.XB, p.XB + (size_t)NL * DM, p.mod1 + 2 * DM, p.XA}; GEMM_STATIC(p.MIXb, p.Wt_out1, NL, DM, DM, E); }); xcd_barrier(bar);
    RUN(5, ph_route(p, lds, wg, nwg);); xcd_barrier(bar);
    RUN(5, ph_dispatch_permute(p, lds, wg, nwg);); xcd_barrier(bar);
    RUN(1, { pg8::Gemm g{p.Xp, p.Wt_expup, DM, DM}; pg8::GroupedOrder S{p.meta[16] >> 8, 2 * EXD / 256, nwg, wg, p.tile_e}; EpiSwiglu E{p.H1Eb, EXD, 2 * EXD / 256};
      pg8::gemm_phase<EpiSwiglu, pg8::GroupedOrder, true, true>(ldsb, g, S, E); }); xcd_barrier(bar);
    RUN(1, { const int ntm = p.meta[16] >> 8; int nfull, ntail, KS; moe_tail_split(ntm, nwg, nfull, ntail, KS);
      { pg8::Gemm g{p.H1Eb, p.Wt_expdn, EXD, EXD}; pg8::GroupedRange S{ntm, DM / 256, 0, nfull, nwg, wg, p.tile_e}; EpiBf16Store E{p.YE, DM, nullptr, 0, DM / 256};
        pg8::gemm_phase<EpiBf16Store, pg8::GroupedRange, true, true>(ldsb, g, S, E); }
      __syncthreads();
      { pg8::Gemm g{p.H1Eb, p.Wt_expdn, EXD / KS, EXD}; pg8::GroupedTail S{ntm, DM / 256, nfull, ntail, KS, EXD / KS, nwg, wg, p.tile_e}; EpiTailPartial E{p.YEP, ntm, DM / 256, nfull, ntail, EXD / KS};
        pg8::gemm_phase<EpiTailPartial, pg8::GroupedTail, true, true>(ldsb, g, S, E); } }); xcd_barrier(bar);
    RUN(5, ph_combine(p, wg, nwg););
}

extern "C" void kernel_launch(void* const* d_in, const int* in_sizes, int n_in, void* d_out, int out_size, void* d_ws, size_t ws_size, hipStream_t stream) {
    (void)in_sizes; (void)out_size;
    if (n_in != 40) return;
    Params p;
    memset(&p, 0, sizeof(p));
    for (int i = 0; i < 40; ++i) p.in[i] = (const float*)d_in[i];
    p.out = (float*)d_out;
    char* w = (char*)d_ws;
    size_t o = 0;
    auto take = [&](size_t bytes) { char* r = w + o; o += (bytes + 255) & ~(size_t)255; return (void*)r; };
    p.bar = (unsigned*)take(XCD_BAR_WORDS * 4);
    p.mod0 = (float*)take(3 * MODW * 4); p.mod1 = (float*)take(3 * MODW * 4);
    p.tok_e = (int*)take(NL * 2 * 4); p.tok_w = (float*)take(NL * 2 * 4); p.meta = (int*)take(256); p.slot_token = (int*)take(MAXSLOT * 4); p.tok_slot = (int*)take(NL * 2 * 4);
    p.LRs = (float*)take((size_t)NT * 256 * 4); p.tile_e = (int*)take(128 * 4); p.WTd = (bf16_t*)take(2 * 1024 * 64 * 2); p.WTi = (bf16_t*)take(2 * 1024 * 64 * 2); p.WTg = (bf16_t*)take(1024 * 128 * 2);
    p.Wt_in0 = (bf16_t*)take((size_t)L0LD * DM * 2); p.Wt_out0 = (bf16_t*)take((size_t)DM * DM * 2); p.Wt_ffnup = (bf16_t*)take((size_t)2 * FFN * DM * 2);
    p.Wt_ffndn = (bf16_t*)take((size_t)DM * FFN * 2); p.Wt_in1 = (bf16_t*)take((size_t)L1LD * DM * 2); p.Wt_out1 = (bf16_t*)take((size_t)DM * DM * 2);
    p.Wt_expup = (bf16_t*)take((size_t)NEXP * 2 * EXD * DM * 2); p.Wt_expdn = (bf16_t*)take((size_t)NEXP * DM * EXD * 2);
    p.Hb = (bf16_t*)take((size_t)NT * DM * 2); p.MIXb = (bf16_t*)take((size_t)NT * DM * 2);
    p.XA = (float*)take((size_t)NT * DM * 4); p.XB = (float*)take((size_t)NT * DM * 4);
    p.P = (bf16_t*)take((size_t)NT * L0LD * 4); p.H1b = (bf16_t*)take((size_t)NT * FFN * 2);
    p.H1Eb = (bf16_t*)p.P;
    const size_t mark = o;
    p.PC = (float*)(w + mark);
    p.R = (bf16_t*)take((size_t)NT * 2048); p.V = (float*)take((size_t)NT * 4096); p.KK = (bf16_t*)take((size_t)NT * 2048); p.G = (float*)take((size_t)NT * 4096);
    for (int d = 0; d < 2; ++d) { p.W[d] = (float*)take((size_t)NT * 4096); p.KD[d] = (bf16_t*)take((size_t)NT * 2048); p.NB[d] = (bf16_t*)take((size_t)NT * 2048); p.Y[d] = (float*)take((size_t)NT * 4096); }
    p.Qb = (bf16_t*)take((size_t)NT * 2048); p.Kb = (bf16_t*)take((size_t)32 * 136 * 2048 * 2); p.VTl = (bf16_t*)take((size_t)32 * 136 * 2048 * 2); p.VTc = p.VTl; p.QM = (float*)take((size_t)NT * 16 * 4);
    const size_t end0 = o;
    o = mark;
    p.O[0] = (float*)take((size_t)NL * DM * 4); p.O[1] = (float*)take((size_t)NL * DM * 4);
    p.QT = (bf16_t*)take((size_t)16 * GLA_NCH * 64 * 256 * 2); p.KHT = (bf16_t*)take((size_t)16 * GLA_NCH * 256 * 64 * 2); p.AM = (bf16_t*)take((size_t)16 * GLA_NCH * 64 * 64 * 2);
    p.VT = (bf16_t*)take((size_t)16 * GLA_NCH * 512 * 64 * 2); p.DEC = (float*)take((size_t)16 * GLA_NCH * 256 * 4);
    const size_t end1a = o;
    o = mark;
    p.YE = (bf16_t*)take((size_t)MAXSLOT * DM * 2);
    p.Xp = (bf16_t*)take((size_t)MAXSLOT * DM * 2);
    p.YEP = (float*)take((size_t)256 * 65536 * 4);
    if (o < end1a) o = end1a;
    const size_t end1 = o;
    const size_t need = end0 > end1 ? end0 : end1;
    static int grid = 0;
    if (!grid) {
        int dev = 0, cus = 0, per_cu = 0;
        grid = -1;
        if (need <= ws_size && hipGetDevice(&dev) == hipSuccess && hipDeviceGetAttribute(&cus, hipDeviceAttributeMultiprocessorCount, dev) == hipSuccess &&
            hipFuncSetAttribute((const void*)k_all, hipFuncAttributeMaxDynamicSharedMemorySize, LDS_BYTES) == hipSuccess &&
            hipOccupancyMaxActiveBlocksPerMultiprocessor(&per_cu, (const void*)k_all, NTHR, LDS_BYTES) == hipSuccess && per_cu >= 1) grid = cus < 256 ? cus : 256;
    }
    if (grid < 0) return;
    (void)hipMemsetAsync(p.bar, 0, (size_t)((char*)(p.mod1 + 3 * MODW) - (char*)p.bar), stream);
    hipLaunchKernelGGL(k_all, dim3(grid), dim3(NTHR), LDS_BYTES, stream, p);
}
```

```cpp
#include <hip/hip_runtime.h>
#include <stdint.h>
#include <string.h>

#define DM 2048
#define NL 8192
#define NC 512
#define NT 8704
#define TL 4096
#define TC 256
#define MODW 12288
#define L0C 6528
#define L1C 6176
#define L0LD 6656
#define L1LD 6400
#define RWC 3456
#define FFN 5632
#define EXD 7168
#define NEXP 8
#define NTHR 512
#define MAXSLOT 18432
#define LDS_BYTES (131072 + 64 + 256)

typedef unsigned short bf16_t;
__device__ __forceinline__ int ptid() { int t = threadIdx.x; asm volatile("" : "+v"(t)); return t; }
#define XB_TMO      128
#define XB_XCNT(j)  (256  + 64 * (j))
#define XB_XSUB(j)  (1280 + 64 * (j))
#define XB_XGEN(j)  (2304 + 64 * (j))
#define XB_TOP      3328
#define XB_TOPGEN   3392
#define XCD_BAR_WORDS 3456
#define XB_SPIN_CAP (1u << 22)
#define LAS __attribute__((address_space(3)))
__device__ __forceinline__ unsigned xb_ld(unsigned* p)              { return __hip_atomic_load(p, __ATOMIC_RELAXED, __HIP_MEMORY_SCOPE_AGENT); }
__device__ __forceinline__ unsigned xb_add(unsigned* p, unsigned v) { return __hip_atomic_fetch_add(p, v, __ATOMIC_RELAXED, __HIP_MEMORY_SCOPE_AGENT); }
__device__ __forceinline__ unsigned xb_xcc_id() { return (unsigned)__builtin_amdgcn_s_getreg((3 << 11) | 20) & 0xFu; }
#define XB_SPIN(cond, bar) do { unsigned _sp = 0; while (cond) { __builtin_amdgcn_s_sleep(1); \
    if ((++_sp & 255u) == 0u) { if (xb_ld(&(bar)[XB_TMO])) break; if (_sp > XB_SPIN_CAP) { atomicAdd(&(bar)[XB_TMO], 1u); break; } } } } while (0)
struct XcdBarrier { unsigned* bar; unsigned x; volatile LAS unsigned* st; };
__device__ __forceinline__ XcdBarrier xcd_barrier_post(unsigned* bar, volatile LAS unsigned* st) {
    XcdBarrier b; b.bar = bar; b.x = xb_xcc_id(); b.st = st;
    if (threadIdx.x == 0) (void)xb_add(&bar[XB_XCNT(b.x)], 1u);
    return b;
}
__device__ __forceinline__ void xcd_barrier_complete(unsigned* bar, unsigned x, unsigned& nloc, unsigned& nx) {
    const unsigned G = gridDim.x * gridDim.y * gridDim.z;
    unsigned sum, cnt, mine, sp = 0u;
    for (;;) {
        sum = 0u; cnt = 0u; mine = 0u;
#pragma unroll
        for (unsigned j = 0; j < 16; ++j) { const unsigned c = xb_ld(&bar[XB_XCNT(j)]); sum += c; cnt += (c > 0u) ? 1u : 0u; mine = (j == x) ? c : mine; }
        if (sum == G) break;
        __builtin_amdgcn_s_sleep(1);
        if ((++sp & 255u) == 0u) { if (xb_ld(&bar[XB_TMO])) break; if (sp > XB_SPIN_CAP) { atomicAdd(&bar[XB_TMO], 1u); break; } }
    }
    nloc = mine > 0u ? mine : 1u; nx = cnt > 0u ? cnt : 1u;
}
__device__ __forceinline__ void xcd_barrier(const XcdBarrier& b) {
    asm volatile("s_waitcnt vmcnt(0)" ::: "memory");
    __syncthreads();
    if (threadIdx.x == 0) {
        unsigned* bar = b.bar;
        __builtin_amdgcn_s_waitcnt(0);
        unsigned nloc = b.st[0], nx = b.st[1];
        if (nloc == 0u) { xcd_barrier_complete(bar, b.x, nloc, nx); b.st[0] = nloc; b.st[1] = nx; }
        const unsigned old = xb_add(&bar[XB_XSUB(b.x)], 1u);
        const unsigned gen = old / nloc;
        if (old + 1u == (gen + 1u) * nloc) {
            __builtin_amdgcn_fence(__ATOMIC_RELEASE, "agent");
            asm volatile("s_waitcnt vmcnt(0)" ::: "memory");
            const unsigned og = xb_add(&bar[XB_TOP], 1u);
            const unsigned tg = og / nx;
            if (og + 1u == (tg + 1u) * nx) xb_add(&bar[XB_TOPGEN], 1u);
            else XB_SPIN(xb_ld(&bar[XB_TOPGEN]) == tg, bar);
            __builtin_amdgcn_fence(__ATOMIC_ACQUIRE, "agent");
            xb_add(&bar[XB_XGEN(b.x)], 1u);
            asm volatile("s_waitcnt vmcnt(0)" ::: "memory");
        } else {
            XB_SPIN(xb_ld(&bar[XB_XGEN(b.x)]) == gen, bar);
            __builtin_amdgcn_fence(__ATOMIC_ACQUIRE, "agent");
            asm volatile("s_waitcnt vmcnt(0)" ::: "memory");
        }
    }
    __syncthreads();
}


namespace pg8 {
#define PG8_LAS __attribute__((address_space(3)))
typedef short bf16x8 __attribute__((ext_vector_type(8)));
typedef float f32x4 __attribute__((ext_vector_type(4)));
typedef unsigned u32x4 __attribute__((ext_vector_type(4)));
constexpr int BM = 256, BK = 64, HALF = 128, HTB = HALF * BK * 2, STAGE_BYTES = 8 * HTB, NXCD = 8, WGM = 8;
__host__ __device__ __forceinline__ int lds_byte(int r, int c) { const int st = (r >> 4) * 2 + (c >> 5), rr = r & 15, cc = c & 31, ob = rr * 64 + cc * 2; return st * 1024 + (ob ^ (((ob >> 9) & 1) << 5)); }
__host__ __device__ __forceinline__ void stage_rc(int b, int& R, int& C) { const int st = b / 1024, sb = b % 1024, swz = sb ^ (((sb >> 9) & 1) << 5); R = (st >> 1) * 16 + swz / 64; C = (st & 1) * 32 + (swz % 64) / 2; }
__host__ __device__ __forceinline__ int perm32(int rho) { const int n = rho >> 4, i = rho & 15; return 8 * (i >> 2) + 4 * n + (i & 3); }
struct Unit { int pm, pn, k0; };
struct Gemm { const bf16_t* A; const bf16_t* Bt; int K; int ld; };
struct StaticOrder {
    int nM, nN, nwg, G, c;
    __device__ void init(int M, int N, int G_, int c_) { nM = M / BM; nN = N / BM; nwg = nM * nN; G = G_; c = c_; }
    __device__ bool next(int i, Unit& u) const {
        const long L = (long)i * G + c; if (L >= nwg) return false;
        int wgid = (int)L; { const int q = nwg / NXCD, r = nwg % NXCD, xcd = wgid % NXCD, off = wgid / NXCD; wgid = (xcd < r ? xcd * (q + 1) : r * (q + 1) + (xcd - r) * q) + off; }
        const int nig = WGM * nN, gid = wgid / nig, fm = gid * WGM, gsz = (nM - fm) < WGM ? (nM - fm) : WGM;
        u.pm = fm + ((wgid % nig) % gsz); u.pn = (wgid % nig) / gsz; u.k0 = 0; return true;
    }
    __device__ __forceinline__ void a_ready(const Unit&) const {}
    __device__ __forceinline__ void done(const Unit&) const {}
};
struct CtxSplitOrder {
    int nN, KS, ksub, G, c;
    __device__ bool next(int i, Unit& u) const {
        const long L = (long)i * G + c; if (L >= (long)2 * nN * KS) return false;
        const int l = (int)L; u.pm = 32 + (l & 1); u.pn = (l >> 1) % nN; u.k0 = ((l >> 1) / nN) * ksub; return true;
    }
    __device__ __forceinline__ void a_ready(const Unit&) const {}
    __device__ __forceinline__ void done(const Unit&) const {}
};
struct GroupedRange {
    int ntm, nN, lo, hi, G, c; const int* tile_e;
    __device__ bool next(int i, Unit& u) const {
        const long L0 = (long)i * G + c; const int n = hi - lo; if (L0 >= n) return false;
        int e = (int)L0; { const int q = n / NXCD, r = n % NXCD, xcd = e % NXCD, off = e / NXCD; e = (xcd < r ? xcd * (q + 1) : r * (q + 1) + (xcd - r) * q) + off; }
        const int L = lo + e; const int pm = L % ntm, pn = L / ntm;
        u.pm = pm; u.pn = tile_e[pm] * nN + pn; u.k0 = 0; return true;
    }
    __device__ __forceinline__ void a_ready(const Unit&) const {}
    __device__ __forceinline__ void done(const Unit&) const {}
};
struct GroupedTail {
    int ntm, nN, lo, ntail, KS, ksub, G, c; const int* tile_e;
    __device__ bool next(int i, Unit& u) const {
        const long J = (long)i * G + c; if (J >= (long)ntail * KS) return false;
        const int t = (int)(J % ntail), ks = (int)(J / ntail); const int L = lo + t;
        const int pm = L % ntm, pn = L / ntm;
        u.pm = pm; u.pn = tile_e[pm] * nN + pn; u.k0 = ks * ksub; return true;
    }
    __device__ __forceinline__ void a_ready(const Unit&) const {}
    __device__ __forceinline__ void done(const Unit&) const {}
};
struct GroupedOrder {
    int ntm, nN, G, c; const int* tile_e;
    __device__ bool next(int i, Unit& u) const {
        const int nwg = ntm * nN; const long L = (long)i * G + c; if (L >= nwg) return false;
        int wgid = (int)L; { const int q = nwg / NXCD, r = nwg % NXCD, xcd = wgid % NXCD, off = wgid / NXCD; wgid = (xcd < r ? xcd * (q + 1) : r * (q + 1) + (xcd - r) * q) + off; }
        const int nig = WGM * nN, gid = wgid / nig, fm = gid * WGM, gsz = (ntm - fm) < WGM ? (ntm - fm) : WGM;
        const int pm = fm + ((wgid % nig) % gsz), pn = (wgid % nig) / gsz;
        u.pm = pm; u.pn = tile_e[pm] * nN + pn; u.k0 = 0; return true;
    }
    __device__ __forceinline__ void a_ready(const Unit&) const {}
    __device__ __forceinline__ void done(const Unit&) const {}
};
template <class Epi, class Sched, bool ALIGN_EPI = false, bool SP2 = false>
__device__ __forceinline__ void gemm_phase(PG8_LAS unsigned char* lds, const Gemm g, const Sched& S, const Epi& E) {
    const int tid = ptid(), wid = __builtin_amdgcn_readfirstlane(tid >> 6), lane = tid & 63, wr = wid >> 2, wc = wid & 3, fr = lane & 15, fq = lane >> 4;
    const int K = g.K, nt = K / BK, LD = g.ld;
    unsigned voffA[2], voffB[2];
#pragma unroll
    for (int i = 0; i < 2; ++i) { int R, C; stage_rc(tid * 16 + i * 8192, R, C); const int Rb = Epi::PERM ? ((R & ~31) + perm32(R & 31)) : R;
        voffA[i] = (unsigned)(R * LD + C) * 2u; voffB[i] = (unsigned)(Rb * LD + C) * 2u; }
    const size_t kstep = (size_t)(BK * 2);
    const size_t hstep = (size_t)HALF * LD * 2;
    const size_t tstep = 2 * hstep;
    const unsigned ldsw = (unsigned)wid * 1024u;
    const int aoff = lds_byte(wr * 64 + fr, fq * 8), boff = lds_byte(wc * 32 + fr, fq * 8);
#define PG8_SA(b, h) (((b) * 2 + (h)) * HTB)
#define PG8_SB(b, h) ((4 + (b) * 2 + (h)) * HTB)
#define PG8_STAGE(bufoff, gbase, voff) do { _Pragma("unroll") for (int _i = 0; _i < 2; ++_i) \
        __builtin_amdgcn_global_load_lds((const unsigned*)((const char*)(gbase) + (voff)[_i]), (PG8_LAS unsigned*)(lds + (bufoff) + ldsw + _i * 8192), 16, 0, 0); } while (0)
#define PG8_LDA(dst, b, h) do { _Pragma("unroll") for (int m = 0; m < 4; ++m) _Pragma("unroll") for (int k = 0; k < 2; ++k) dst[m][k] = *(const PG8_LAS bf16x8*)(lds + PG8_SA(b, h) + aoff + m * 2048 + k * 1024); } while (0)
#define PG8_LDB(dst, b, h) do { _Pragma("unroll") for (int n = 0; n < 2; ++n) _Pragma("unroll") for (int k = 0; k < 2; ++k) dst[n][k] = *(const PG8_LAS bf16x8*)(lds + PG8_SB(b, h) + boff + n * 2048 + k * 1024); } while (0)
#define PG8_MMA(ai, bj, At, Bt) do { __builtin_amdgcn_s_setprio(1); _Pragma("unroll") for (int m = 0; m < 4; ++m) _Pragma("unroll") for (int n = 0; n < 2; ++n) _Pragma("unroll") for (int k = 0; k < 2; ++k) \
        acc[ai][bj][m][n] = __builtin_amdgcn_mfma_f32_16x16x32_bf16(Bt[n][k], At[m][k], acc[ai][bj][m][n], 0, 0, 0); __builtin_amdgcn_s_setprio(0); } while (0)
#define PG8_WAIT_V(n) asm volatile("s_waitcnt vmcnt(" #n ")" ::: "memory")
#define PG8_WAIT_L(n) asm volatile("s_waitcnt lgkmcnt(" #n ")" ::: "memory")
#define PG8_BAR __builtin_amdgcn_s_barrier()
#define PG8_SCHED __builtin_amdgcn_sched_barrier(0)
    Unit cur, nxt; int ui = 0;
    if (!S.next(0, cur)) return;
    f32x4 acc[2][2][4][2];
#pragma unroll
    for (int a = 0; a < 2; ++a)
#pragma unroll
        for (int b = 0; b < 2; ++b)
#pragma unroll
            for (int m = 0; m < 4; ++m)
#pragma unroll
                for (int n = 0; n < 2; ++n) acc[a][b][m][n] = (f32x4){0.f, 0.f, 0.f, 0.f};
    bf16x8 At[4][2], B0[2][2], B1[2][2];
    const char* cA = (const char*)g.A + (size_t)cur.pm * tstep + (size_t)cur.k0 * 2; const char* cB = (const char*)g.Bt + (size_t)cur.pn * tstep + (size_t)cur.k0 * 2;
    S.a_ready(cur);
    if constexpr (SP2) {
        PG8_STAGE(PG8_SB(0, 0), cB, voffB); PG8_STAGE(PG8_SB(0, 1), cB + hstep, voffB); PG8_STAGE(PG8_SA(0, 0), cA, voffA); PG8_STAGE(PG8_SA(0, 1), cA + hstep, voffA);
        if (wr == 1) PG8_BAR;
        PG8_WAIT_V(2); PG8_BAR;
        PG8_STAGE(PG8_SB(1, 0), cB + kstep, voffB); PG8_STAGE(PG8_SA(1, 0), cA + kstep, voffA); PG8_STAGE(PG8_SB(1, 1), cB + hstep + kstep, voffB);
        PG8_WAIT_V(6); PG8_BAR;
    } else {
        PG8_STAGE(PG8_SB(0, 0), cB, voffB); PG8_STAGE(PG8_SA(0, 0), cA, voffA); PG8_STAGE(PG8_SB(0, 1), cB + hstep, voffB); PG8_STAGE(PG8_SA(0, 1), cA + hstep, voffA);
        if (wr == 1) PG8_BAR;
        PG8_WAIT_V(4); PG8_BAR;
        PG8_STAGE(PG8_SB(1, 0), cB + kstep, voffB); PG8_STAGE(PG8_SA(1, 0), cA + kstep, voffA); PG8_STAGE(PG8_SB(1, 1), cB + hstep + kstep, voffB);
        PG8_WAIT_V(6); PG8_BAR;
    }
    for (;;) {
        const bool has_next = S.next(ui + 1, nxt);
        const char* nA = has_next ? (const char*)g.A + (size_t)nxt.pm * tstep + (size_t)nxt.k0 * 2 : cA; const char* nB = has_next ? (const char*)g.Bt + (size_t)nxt.pn * tstep + (size_t)nxt.k0 * 2 : cB;
        for (int t = 0; t < nt; t += 2) {
            const bool last = (t == nt - 2);
            const char* a1 = cA + (size_t)(t + 1) * kstep;
            const char* a2 = last ? nA : cA + (size_t)(t + 2) * kstep; const char* b2 = last ? nB : cB + (size_t)(t + 2) * kstep;
            const char* a3 = a2 + kstep; const char* b3 = b2 + kstep;
            if (last && has_next) S.a_ready(nxt);
            if constexpr (SP2) {
            PG8_LDB(B0, 0, 0); PG8_LDB(B1, 0, 1); PG8_SCHED; PG8_LDA(At, 0, 0); PG8_STAGE(PG8_SA(1, 1), a1 + hstep, voffA);
            PG8_WAIT_V(8); PG8_WAIT_L(0); PG8_BAR; PG8_MMA(0, 0, At, B0); PG8_MMA(0, 1, At, B1); PG8_BAR; PG8_SCHED;
            PG8_LDA(At, 0, 1); PG8_STAGE(PG8_SB(0, 0), b2, voffB); PG8_STAGE(PG8_SB(0, 1), b2 + hstep, voffB); PG8_STAGE(PG8_SA(0, 0), a2, voffA);
            PG8_WAIT_V(8); PG8_WAIT_L(0); PG8_BAR; PG8_MMA(1, 0, At, B0); PG8_MMA(1, 1, At, B1); PG8_BAR; PG8_SCHED;
            PG8_LDB(B0, 1, 0); PG8_LDB(B1, 1, 1); PG8_SCHED; PG8_LDA(At, 1, 0); PG8_STAGE(PG8_SA(0, 1), a2 + hstep, voffA);
            PG8_WAIT_V(8); PG8_WAIT_L(0); PG8_BAR; PG8_MMA(0, 0, At, B0); PG8_MMA(0, 1, At, B1); PG8_BAR; PG8_SCHED;
            PG8_LDA(At, 1, 1); PG8_STAGE(PG8_SB(1, 0), b3, voffB); PG8_STAGE(PG8_SB(1, 1), b3 + hstep, voffB); PG8_STAGE(PG8_SA(1, 0), a3, voffA);
            PG8_WAIT_V(8); PG8_WAIT_L(0); PG8_BAR; PG8_MMA(1, 0, At, B0); PG8_MMA(1, 1, At, B1); PG8_BAR; PG8_SCHED;
            } else {
            PG8_LDB(B0, 0, 0); PG8_SCHED; PG8_LDA(At, 0, 0); PG8_STAGE(PG8_SA(1, 1), a1 + hstep, voffA);
            PG8_WAIT_L(8); PG8_BAR; PG8_WAIT_L(0); PG8_MMA(0, 0, At, B0); PG8_BAR; PG8_SCHED;
            PG8_LDB(B1, 0, 1); PG8_STAGE(PG8_SB(0, 0), b2, voffB);
            PG8_BAR; PG8_WAIT_L(0); PG8_MMA(0, 1, At, B1); PG8_BAR;
            PG8_LDA(At, 0, 1); PG8_STAGE(PG8_SA(0, 0), a2, voffA);
            PG8_BAR; PG8_WAIT_L(0); PG8_MMA(1, 0, At, B0); PG8_BAR; PG8_SCHED;
            PG8_STAGE(PG8_SB(0, 1), b2 + hstep, voffB);
            PG8_WAIT_V(6); PG8_BAR; PG8_MMA(1, 1, At, B1); PG8_BAR;
            PG8_LDB(B0, 1, 0); PG8_SCHED; PG8_LDA(At, 1, 0); PG8_STAGE(PG8_SA(0, 1), a2 + hstep, voffA);
            PG8_WAIT_L(8); PG8_BAR; PG8_WAIT_L(0); PG8_MMA(0, 0, At, B0); PG8_BAR; PG8_SCHED;
            PG8_LDB(B1, 1, 1); PG8_STAGE(PG8_SB(1, 0), b3, voffB);
            PG8_BAR; PG8_WAIT_L(0); PG8_MMA(0, 1, At, B1); PG8_BAR;
            PG8_LDA(At, 1, 1); PG8_STAGE(PG8_SA(1, 0), a3, voffA);
            PG8_BAR; PG8_WAIT_L(0); PG8_MMA(1, 0, At, B0); PG8_BAR; PG8_SCHED;
            PG8_STAGE(PG8_SB(1, 1), b3 + hstep, voffB);
            PG8_WAIT_V(6); PG8_BAR; PG8_MMA(1, 1, At, B1); PG8_BAR;
            }
        }
        if constexpr (ALIGN_EPI) { if (wr == 0) PG8_BAR; }
        if constexpr (!Epi::AFTER_DRAIN) { E(acc, cur, wr, wc, fr, fq); S.done(cur); }
        if (!has_next) break;
#pragma unroll
        for (int a = 0; a < 2; ++a)
#pragma unroll
            for (int b = 0; b < 2; ++b)
#pragma unroll
                for (int m = 0; m < 4; ++m)
#pragma unroll
                    for (int n = 0; n < 2; ++n) acc[a][b][m][n] = (f32x4){0.f, 0.f, 0.f, 0.f};
        cur = nxt; cA = nA; cB = nB; ++ui;
        if constexpr (ALIGN_EPI) { if (wr == 1) PG8_BAR; }
    }
    PG8_WAIT_V(0);
    if constexpr (!ALIGN_EPI) { if (wr == 0) PG8_BAR; }
    PG8_BAR;
    if constexpr (Epi::AFTER_DRAIN) { E.fused(acc, cur, wr, wc, fr, fq, lds, wid, lane); S.done(cur); }
#undef PG8_SA
#undef PG8_SB
#undef PG8_STAGE
#undef PG8_LDA
#undef PG8_LDB
#undef PG8_MMA
#undef PG8_WAIT_V
#undef PG8_WAIT_L
#undef PG8_BAR
#undef PG8_SCHED
}

}

struct Params {
    const float* in[40];
    float* out;
    unsigned* bar;
    float* mod0; float* mod1;
    bf16_t* Hb; bf16_t* MIXb; bf16_t* H1b; bf16_t* Xp; bf16_t* H1Eb;
    bf16_t* Wt_in0; bf16_t* Wt_out0; bf16_t* Wt_ffnup; bf16_t* Wt_ffndn; bf16_t* Wt_in1; bf16_t* Wt_out1; bf16_t* Wt_expup; bf16_t* Wt_expdn;
    bf16_t* P; float* LRs;
    bf16_t* R; float* V; bf16_t* KK; float* G; float* W[2]; bf16_t* KD[2]; bf16_t* NB[2];
    float* Y[2];
    bf16_t* Qb; bf16_t* Kb; bf16_t* VTl; bf16_t* VTc; float* QM; float* XA; float* XB;
    float* O[2]; bf16_t* QT; bf16_t* KHT; bf16_t* AM; bf16_t* VT; float* DEC;
    int* tok_e; float* tok_w; int* meta; int* slot_token; int* tok_slot; int* tile_e;
    bf16_t* YE; float* YEP; float* PC; bf16_t* WTd; bf16_t* WTi; bf16_t* WTg;
};

__device__ __forceinline__ void lds_barrier() { asm volatile("s_waitcnt lgkmcnt(0)" ::: "memory"); __builtin_amdgcn_s_barrier(); asm volatile("" ::: "memory"); }
__device__ __forceinline__ float bf2f(bf16_t b) { return __uint_as_float(((unsigned)b) << 16); }
typedef float f32x2_t __attribute__((ext_vector_type(2)));
typedef __bf16 bf16x2_t __attribute__((ext_vector_type(2)));
__device__ __forceinline__ unsigned cvt_pk_bf16(float lo, float hi) { const f32x2_t v = {lo, hi}; return __builtin_bit_cast(unsigned, __builtin_convertvector(v, bf16x2_t)); }
__device__ __forceinline__ bf16_t f2bf(float f) { return (bf16_t)(cvt_pk_bf16(f, 0.f) & 0xffffu); }
__device__ __forceinline__ float sigm(float x) { return __builtin_amdgcn_rcpf(1.f + __expf(-x)); }
__device__ __forceinline__ float siluf(float x) { return x * __builtin_amdgcn_rcpf(1.f + __expf(-x)); }
__device__ __forceinline__ float silu_fast(float x) { return x * __builtin_amdgcn_rcpf(1.f + __expf(-x)); }
__device__ __forceinline__ float softplusf(float x) { return x > 20.f ? x : __logf(1.f + __expf(x)); }
__device__ __forceinline__ int rowgrp(int row) { return row < NL ? row / TL : 2; }
__device__ __forceinline__ float dpp_add16(float x) {
    x += __builtin_bit_cast(float, __builtin_amdgcn_update_dpp(0, __builtin_bit_cast(int, x), 0xB1, 0xF, 0xF, true));
    x += __builtin_bit_cast(float, __builtin_amdgcn_update_dpp(0, __builtin_bit_cast(int, x), 0x4E, 0xF, 0xF, true));
    x += __builtin_bit_cast(float, __builtin_amdgcn_update_dpp(0, __builtin_bit_cast(int, x), 0x141, 0xF, 0xF, true));
    x += __builtin_bit_cast(float, __builtin_amdgcn_update_dpp(0, __builtin_bit_cast(int, x), 0x140, 0xF, 0xF, true));
    return x;
}
__device__ __forceinline__ float wave_sum(float v) {
    v = dpp_add16(v);
    v += __shfl_xor(v, 16); v += __shfl_xor(v, 32);
    return v;
}
__device__ __forceinline__ float wave_max(float v) {
#pragma unroll
    for (int o = 32; o >= 1; o >>= 1) v = fmaxf(v, __shfl_xor(v, o));
    return v;
}
__device__ __forceinline__ float block_sum(float v, float* red) {
    v = wave_sum(v);
    __syncthreads();
    const int bt_ = ptid();
    if ((bt_ & 63) == 0) red[bt_ >> 6] = v;
    __syncthreads();
    float s = 0.f;
#pragma unroll
    for (int i = 0; i < 8; ++i) s += red[i];
    return s;
}

__device__ __forceinline__ void conv_T(const float* W0, const float* W1, int K, int N, int Nt, int mode, bf16_t* Bt, float* ldsf, int wg, int nwg) {
    bf16_t (*T)[66] = (bf16_t (*)[66])ldsf;
    const int tid = ptid();
    const int tn = Nt / 64, tk = K / 64;
    for (int tile = wg; tile < tn * tk; tile += nwg) {
        const int n0 = (tile % tn) * 64, k0 = (tile / tn) * 64;
        const float* src = W0; int col0 = n0;
        if (mode == 1) { const int t = n0 >> 8, h = (n0 >> 7) & 1, j0 = n0 & 127; src = h ? W1 : W0; col0 = t * 128 + j0; }
        const int kk = tid >> 4, c4 = (tid & 15) * 4;
#pragma unroll
        for (int r = 0; r < 2; ++r) {
            const int k = kk + 32 * r;
            float4 v = make_float4(0.f, 0.f, 0.f, 0.f);
            if (col0 + c4 < N) v = *(const float4*)(src + (size_t)(k0 + k) * N + col0 + c4);
            T[c4 + 0][k] = f2bf(v.x); T[c4 + 1][k] = f2bf(v.y); T[c4 + 2][k] = f2bf(v.z); T[c4 + 3][k] = f2bf(v.w);
        }
        __syncthreads();
        {
            const int n = tid >> 3, k8 = (tid & 7) * 8;
            const unsigned* tp = (const unsigned*)&T[n][k8];
            uint4 o; o.x = tp[0]; o.y = tp[1]; o.z = tp[2]; o.w = tp[3];
            *(uint4*)(Bt + (size_t)(n0 + n) * K + k0 + k8) = o;
        }
        __syncthreads();
    }
}
#define CT_L0A 6656
#define CT_L0B (CT_L0A + 2048)
#define CT_L0C (CT_L0B + 11264)
#define CT_L0 (CT_L0C + 5632)
#define CT_A (CT_L0 + 6400)
#define CT_B (CT_A + 2048)
#define CT_C (CT_B + 8 * 14336)
#define CT_TOTAL (CT_C + 8 * 7168)
#define CT_LDS_BYTES 5120
struct ConvTile { const float* src; bf16_t* dst; int N; int K; int nvalid; };
#define CTTAB_OFF (131072 + 64)
__device__ __forceinline__ void ct_table_init(const Params& p, unsigned long long* tab) {
    tab[0] = (unsigned long long)p.in[8]; tab[1] = (unsigned long long)p.in[23]; tab[2] = (unsigned long long)p.in[24]; tab[3] = (unsigned long long)p.in[25]; tab[4] = (unsigned long long)p.in[26];
    tab[5] = (unsigned long long)p.in[31]; tab[6] = (unsigned long long)p.in[35]; tab[7] = (unsigned long long)p.in[37]; tab[8] = (unsigned long long)p.in[38]; tab[9] = (unsigned long long)p.in[39];
    tab[10] = (unsigned long long)p.Wt_in0; tab[11] = (unsigned long long)p.Wt_out0; tab[12] = (unsigned long long)p.Wt_ffnup; tab[13] = (unsigned long long)p.Wt_ffndn;
    tab[14] = (unsigned long long)p.Wt_in1; tab[15] = (unsigned long long)p.Wt_out1; tab[16] = (unsigned long long)p.Wt_expup; tab[17] = (unsigned long long)p.Wt_expdn;
}
__device__ __forceinline__ ConvTile conv_tile_desc(const unsigned long long* tab, int t) {
    int si, di, N, K, nb, kb, e = 0, mode = 0, npad = 0;
    if (t < CT_L0A) { si = 0; di = 10; N = L0C; K = DM; nb = t % 104; kb = t / 104; npad = 1; }
    else if (t < CT_L0B) { const int u = t - CT_L0A; si = 1; di = 11; N = DM; K = DM; nb = u & 31; kb = u >> 5; }
    else if (t < CT_L0C) { const int u = t - CT_L0B; si = 2; di = 12; N = FFN; K = DM; nb = u % 176; kb = u / 176; mode = 1; }
    else if (t < CT_L0) { const int u = t - CT_L0C; si = 4; di = 13; N = DM; K = FFN; nb = u & 31; kb = u >> 5; }
    else if (t < CT_A) { const int u = t - CT_L0; si = 5; di = 14; N = L1C; K = DM; nb = u % 100; kb = u / 100; npad = 1; }
    else if (t < CT_B) { const int u = t - CT_A; si = 6; di = 15; N = DM; K = DM; nb = u & 31; kb = u >> 5; }
    else if (t < CT_C) { const int u = t - CT_B; e = u / 14336; const int v = u % 14336; si = 7; di = 16; N = EXD; K = DM; nb = v % 224; kb = v / 224; mode = 1; }
    else { const int u = (t < CT_TOTAL ? t : CT_TOTAL - 1) - CT_C; e = u / 7168; const int v = u % 7168; si = 9; di = 17; N = DM; K = EXD; nb = v & 31; kb = v >> 5; }
    const int n0 = nb * 64;
    int col0 = n0, nvalid = 64;
    if (mode) { col0 = (n0 >> 8) * 128 + (n0 & 127); si += (n0 >> 7) & 1; }
    if (npad) { nvalid = N - n0; if (nvalid <= 0) col0 = 0; }
    ConvTile c;
    const size_t KN = (size_t)K * N;
    c.src = (const float*)tab[si] + (size_t)e * KN + (size_t)(kb * 32) * N + col0;
    c.dst = (bf16_t*)tab[di] + (size_t)e * (mode ? 2 * KN : KN) + (size_t)n0 * K + kb * 32;
    c.N = N; c.K = K; c.nvalid = nvalid;
    return c;
}
#define CT_FORQ(X) X(0) X(1) X(2) X(3) X(4) X(5) X(6) X(7)
#define CT_LOAD1(q) cv##q = *(const float4*)(ct_.src + (size_t)(ckq_ * 8 + (q)) * ct_.N + ccol_);
#define CT_LOAD(T_) do { const int tt_ = (T_) < CT_TOTAL ? (T_) : CT_TOTAL - 1; const ConvTile ct_ = conv_tile_desc(cttab, tt_); const int ckq_ = lane >> 4, ccol_ = ((lane & 15) * 4 < ct_.nvalid) ? (lane & 15) * 4 : 0; CT_FORQ(CT_LOAD1) } while (0)
#define CT_ATOM(e, C) { uint4 a_; a_.x = cvt_pk_bf16(cv0.C, cv1.C); a_.y = cvt_pk_bf16(cv2.C, cv3.C); a_.z = cvt_pk_bf16(cv4.C, cv5.C); a_.w = cvt_pk_bf16(cv6.C, cv7.C); \
    if (!cok_) a_ = make_uint4(0u, 0u, 0u, 0u); *(uint4*)(cdst_ + (size_t)(e) * ct_.K) = a_; }
#define CT_STORE(T_, LDSW_) do { const int tt_ = (T_) < CT_TOTAL ? (T_) : CT_TOTAL - 1; const ConvTile ct_ = conv_tile_desc(cttab, tt_); const bool cok_ = (lane & 15) * 4 < ct_.nvalid; \
    bf16_t* cdst_ = ct_.dst + (size_t)((lane & 15) * 4) * ct_.K + (lane >> 4) * 8; CT_ATOM(0, x) CT_ATOM(1, y) CT_ATOM(2, z) CT_ATOM(3, w) } while (0)
__device__ __forceinline__ void ph_convert(const Params& p, float* lds, int wg, int nwg, int ct_end) {
    const int tid = ptid(), wave = __builtin_amdgcn_readfirstlane(tid >> 6), lane = tid & 63;
    const unsigned long long* cttab = (const unsigned long long*)((const char*)lds + CTTAB_OFF);
    float4 cv0, cv1, cv2, cv3, cv4, cv5, cv6, cv7;
    for (int t = wg * 8 + wave; t < ct_end; t += nwg * 8) { CT_LOAD(t); CT_STORE(t, 0); }
}

__device__ __forceinline__ void ph_mod(const Params& p, float* lds, int wg, int nwg) {
    float* cs = lds;
    float* red = lds + 3 * DM;
    const int tid = ptid(), wave = tid >> 6, lane = tid & 63;
    if (wg >= 4 * (MODW / 256)) return;
    for (int i = tid; i < 3 * DM; i += NTHR) {
        const int r = i / DM, k = i % DM;
        const float c = r < 2 ? p.in[1][r * DM + k] : p.in[3][k];
        cs[i] = siluf(c);
    }
    __syncthreads();
    for (int item = wg; item < 4 * (MODW / 256); item += nwg) {
        const int kh = item & 1, it2 = item >> 1, layer = it2 / (MODW / 256), cb = (it2 % (MODW / 256)) * 256;
        const float* w = (layer ? p.in[27] : p.in[4]) + cb + lane * 4;
        const float* b = layer ? p.in[28] : p.in[5];
        float* out = layer ? p.mod1 : p.mod0;
        float a0[4] = {0.f, 0.f, 0.f, 0.f}, a1[4] = {0.f, 0.f, 0.f, 0.f}, a2[4] = {0.f, 0.f, 0.f, 0.f};
        const int kbeg = kh * 1024 + wave * 128;
#pragma unroll 8
        for (int k = kbeg; k < kbeg + 128; ++k) {
            const float4 wv = *(const float4*)(w + (size_t)k * MODW);
            const float c0 = cs[k], c1 = cs[DM + k], c2 = cs[2 * DM + k];
            a0[0] += c0 * wv.x; a0[1] += c0 * wv.y; a0[2] += c0 * wv.z; a0[3] += c0 * wv.w;
            a1[0] += c1 * wv.x; a1[1] += c1 * wv.y; a1[2] += c1 * wv.z; a1[3] += c1 * wv.w;
            a2[0] += c2 * wv.x; a2[1] += c2 * wv.y; a2[2] += c2 * wv.z; a2[3] += c2 * wv.w;
        }
        *(float4*)(red + (wave * 3 + 0) * 256 + lane * 4) = make_float4(a0[0], a0[1], a0[2], a0[3]);
        *(float4*)(red + (wave * 3 + 1) * 256 + lane * 4) = make_float4(a1[0], a1[1], a1[2], a1[3]);
        *(float4*)(red + (wave * 3 + 2) * 256 + lane * 4) = make_float4(a2[0], a2[1], a2[2], a2[3]);
        __syncthreads();
        for (int q = tid; q < 768; q += NTHR) {
            const int r = q >> 8, c = q & 255;
            float sum = kh ? 0.f : b[cb + c];
#pragma unroll
            for (int w8 = 0; w8 < 8; ++w8) sum += red[(w8 * 3 + r) * 256 + c];
            unsafeAtomicAdd(out + r * MODW + cb + c, sum);
        }
        __syncthreads();
    }
}

__device__ __forceinline__ void ph_norm(const float* src_lat, const float* src_ctx, const float* gain, const float* mod, int shift_idx, int scale_idx,
                        bf16_t* out, int nrows, float* lds, int wg, int nwg,
                        const float* part = nullptr, int nparts = 0, const float* pgate = nullptr, float* wb = nullptr) {
    (void)lds;
    const int tid = ptid(), wave = tid >> 6, lane = tid & 63;
    for (int row = wg * 8 + wave; row < nrows; row += nwg * 8) {
        const float4* x = (const float4*)(row < NL ? src_lat + (size_t)row * DM : src_ctx + (size_t)(row - NL) * DM);
        float4 v[8];
#pragma unroll
        for (int q = 0; q < 8; ++q) v[q] = x[lane + 64 * q];
        if (part != nullptr && row >= NL) {
#pragma unroll
            for (int q = 0; q < 8; ++q) {
                float4 a = make_float4(0.f, 0.f, 0.f, 0.f);
                for (int sidx = 0; sidx < nparts; ++sidx) { const float4 t = ((const float4*)(part + ((size_t)sidx * NC + (row - NL)) * DM))[lane + 64 * q]; a.x += t.x; a.y += t.y; a.z += t.z; a.w += t.w; }
                const float4 g4 = ((const float4*)pgate)[lane + 64 * q];
                v[q].x += g4.x * a.x; v[q].y += g4.y * a.y; v[q].z += g4.z * a.z; v[q].w += g4.w * a.w;
                if (wb) ((float4*)(wb + (size_t)row * DM))[lane + 64 * q] = v[q];
            }
        }
        float ss = 0.f;
#pragma unroll
        for (int q = 0; q < 8; ++q) ss += v[q].x * v[q].x + v[q].y * v[q].y + v[q].z * v[q].z + v[q].w * v[q].w;
        ss = wave_sum(ss);
        const float rs = rsqrtf(ss * (1.f / DM) + 1e-6f);
        const int g = rowgrp(row);
#pragma unroll
        for (int q = 0; q < 8; ++q) {
            const float4 gn = ((const float4*)gain)[lane + 64 * q];
            const float4 sh = ((const float4*)(mod + g * MODW + shift_idx * DM))[lane + 64 * q];
            const float4 sc = ((const float4*)(mod + g * MODW + scale_idx * DM))[lane + 64 * q];
            uint2 o;
            o.x = cvt_pk_bf16(v[q].x * rs * gn.x * (1.f + sc.x) + sh.x, v[q].y * rs * gn.y * (1.f + sc.y) + sh.y);
            o.y = cvt_pk_bf16(v[q].z * rs * gn.z * (1.f + sc.z) + sh.z, v[q].w * rs * gn.w * (1.f + sc.w) + sh.w);
            ((uint2*)(out + (size_t)row * DM))[lane + 64 * q] = o;
        }
    }
}

struct EpiF32Store {
    static constexpr bool PERM = false, AFTER_DRAIN = false;
    float* C; int ldc; int nn;
    __device__ __forceinline__ void operator()(const pg8::f32x4 (&acc)[2][2][4][2], const pg8::Unit& u, int wr, int wc, int fr, int fq) const {
        const int row0 = u.pm * 256 + wr * 64 + fr, pnl = nn ? u.pn % nn : u.pn, col0 = pnl * 256 + wc * 32 + 4 * fq;
#pragma unroll
        for (int ai = 0; ai < 2; ++ai)
#pragma unroll
            for (int m = 0; m < 4; ++m) { float* rowp = C + (size_t)(row0 + ai * 128 + m * 16) * ldc + col0;
#pragma unroll
                for (int bj = 0; bj < 2; ++bj)
#pragma unroll
                    for (int n = 0; n < 2; ++n) *(pg8::f32x4*)(rowp + bj * 128 + n * 16) = acc[ai][bj][m][n]; }
    }
};
struct EpiResGate {
    static constexpr bool PERM = false, AFTER_DRAIN = false;
    const float* res_lat; const float* res_ctx; const float* gate; float* C;
    __device__ __forceinline__ void operator()(const pg8::f32x4 (&acc)[2][2][4][2], const pg8::Unit& u, int wr, int wc, int fr, int fq) const {
        const int row0 = u.pm * 256 + wr * 64 + fr, col0 = u.pn * 256 + wc * 32 + 4 * fq;
#pragma unroll
        for (int ai = 0; ai < 2; ++ai)
#pragma unroll
            for (int m = 0; m < 4; ++m) { const int row = row0 + ai * 128 + m * 16;
                const float* rp = (row < NL ? res_lat + (size_t)row * DM : res_ctx + (size_t)(row - NL) * DM) + col0;
                const float* gp = gate + rowgrp(row) * MODW + col0;
                float* cp = C + (size_t)row * DM + col0;
#pragma unroll
                for (int bj = 0; bj < 2; ++bj)
#pragma unroll
                    for (int n = 0; n < 2; ++n) { const pg8::f32x4 r = *(const pg8::f32x4*)(rp + bj * 128 + n * 16), g = *(const pg8::f32x4*)(gp + bj * 128 + n * 16);
                        *(pg8::f32x4*)(cp + bj * 128 + n * 16) = r + g * acc[ai][bj][m][n]; } }
    }
};
struct EpiCtxPartial {
    static constexpr bool PERM = false, AFTER_DRAIN = false;
    float* P; int ksub;
    __device__ __forceinline__ void operator()(const pg8::f32x4 (&acc)[2][2][4][2], const pg8::Unit& u, int wr, int wc, int fr, int fq) const {
        const int row0 = (u.pm - 32) * 256 + wr * 64 + fr, col0 = u.pn * 256 + wc * 32 + 4 * fq; float* base = P + (size_t)(u.k0 / ksub) * NC * DM;
#pragma unroll
        for (int ai = 0; ai < 2; ++ai)
#pragma unroll
            for (int m = 0; m < 4; ++m) { float* rowp = base + (size_t)(row0 + ai * 128 + m * 16) * DM + col0;
#pragma unroll
                for (int bj = 0; bj < 2; ++bj)
#pragma unroll
                    for (int n = 0; n < 2; ++n) *(pg8::f32x4*)(rowp + bj * 128 + n * 16) = acc[ai][bj][m][n]; }
    }
};
struct EpiTailPartial {
    static constexpr bool PERM = false, AFTER_DRAIN = false;
    float* P; int ntm, nN, lo, ntail, ksub;
    __device__ __forceinline__ void operator()(const pg8::f32x4 (&acc)[2][2][4][2], const pg8::Unit& u, int wr, int wc, int fr, int fq) const {
        const int pnl = u.pn % nN, t = pnl * ntm + u.pm - lo, ks = u.k0 / ksub;
        float* base = P + (size_t)(ks * ntail + t) * 65536 + (wr * 64 + fr) * 256 + wc * 32 + 4 * fq;
#pragma unroll
        for (int ai = 0; ai < 2; ++ai)
#pragma unroll
            for (int m = 0; m < 4; ++m) { float* rowp = base + (ai * 128 + m * 16) * 256;
#pragma unroll
                for (int bj = 0; bj < 2; ++bj)
#pragma unroll
                    for (int n = 0; n < 2; ++n) *(pg8::f32x4*)(rowp + bj * 128 + n * 16) = acc[ai][bj][m][n]; }
    }
};
struct EpiBf16Store {
    static constexpr bool PERM = true, AFTER_DRAIN = false;
    bf16_t* O; int ldc; float* side; int side_pn; int nn;
    __device__ __forceinline__ void operator()(const pg8::f32x4 (&acc)[2][2][4][2], const pg8::Unit& u, int wr, int wc, int fr, int fq) const {
        const int row0 = u.pm * 256 + wr * 64 + fr, col0 = (nn ? u.pn % nn : u.pn) * 256 + wc * 32 + 8 * fq;
#pragma unroll
        for (int ai = 0; ai < 2; ++ai)
#pragma unroll
            for (int m = 0; m < 4; ++m) { const int row = row0 + ai * 128 + m * 16; bf16_t* rowp = O + (size_t)row * ldc + col0;
#pragma unroll
                for (int bj = 0; bj < 2; ++bj) { const pg8::f32x4 v0 = acc[ai][bj][m][0], v1 = acc[ai][bj][m][1];
                    pg8::u32x4 w; w.x = cvt_pk_bf16(v0[0], v0[1]); w.y = cvt_pk_bf16(v0[2], v0[3]); w.z = cvt_pk_bf16(v1[0], v1[1]); w.w = cvt_pk_bf16(v1[2], v1[3]);
                    *(pg8::u32x4*)(rowp + bj * 128) = w;
                    if (side != nullptr && u.pn == side_pn) { float* sp = side + (size_t)row * 256 + bj * 128 + wc * 32 + 8 * fq; *(pg8::f32x4*)sp = v0; *(pg8::f32x4*)(sp + 4) = v1; } } }
    }
};
struct EpiSwiglu {
    static constexpr bool PERM = true, AFTER_DRAIN = false;
    bf16_t* O; int ldc; int nn;
    __device__ __forceinline__ void operator()(const pg8::f32x4 (&acc)[2][2][4][2], const pg8::Unit& u, int wr, int wc, int fr, int fq) const {
        const int row0 = u.pm * 256 + wr * 64 + fr, pnl = nn ? u.pn % nn : u.pn, col0 = pnl * 128 + wc * 32 + 8 * fq;
#pragma unroll
        for (int ai = 0; ai < 2; ++ai)
#pragma unroll
            for (int m = 0; m < 4; ++m) { bf16_t* rowp = O + (size_t)(row0 + ai * 128 + m * 16) * ldc + col0;
                const pg8::f32x4 g0 = acc[ai][0][m][0], g1 = acc[ai][0][m][1], u0 = acc[ai][1][m][0], u1 = acc[ai][1][m][1];
                pg8::u32x4 w;
                w.x = cvt_pk_bf16(silu_fast(g0[0]) * u0[0], silu_fast(g0[1]) * u0[1]); w.y = cvt_pk_bf16(silu_fast(g0[2]) * u0[2], silu_fast(g0[3]) * u0[3]);
                w.z = cvt_pk_bf16(silu_fast(g1[0]) * u1[0], silu_fast(g1[1]) * u1[1]); w.w = cvt_pk_bf16(silu_fast(g1[2]) * u1[2], silu_fast(g1[3]) * u1[3]);
                *(pg8::u32x4*)rowp = w; }
    }
};

__device__ __forceinline__ float rp_shift(const bf16_t* P, int row, int col, float mu) {
    int t, T;
    if (row < NL) { t = row % TL; T = TL; } else { t = (row - NL) % TC; T = TC; }
    const bf16_t* pc = P + (size_t)row * L0LD + col;
    const float c = bf2f(pc[0]), pv = t > 0 ? bf2f(pc[-L0LD]) : 0.f, nx = t < T - 1 ? bf2f(pc[L0LD]) : 0.f;
    return c + mu * (0.5f * (pv + nx) - c);
}
__device__ __forceinline__ void ph_lora_wt(const Params& p, int wg, int nwg) {
    const int tid = ptid();
    for (int idx = wg * NTHR + tid; idx < 384 * 1024; idx += nwg * NTHR) {
        const int ch = idx & 1023, j = idx >> 10;
        if (j < 128) p.WTd[((size_t)(j >> 6) * 1024 + ch) * 64 + (j & 63)] = f2bf(p.in[11][(size_t)j * 1024 + ch]);
        else if (j < 256) { const int q = j - 128; p.WTi[((size_t)(q >> 6) * 1024 + ch) * 64 + (q & 63)] = f2bf(p.in[13][(size_t)q * 1024 + ch]); }
        else { const int q = j - 256; p.WTg[(size_t)ch * 128 + q] = f2bf(p.in[14][(size_t)q * 1024 + ch]); }
    }
}
#define RPM_LD 392
__device__ __forceinline__ void ph_rwprep(const Params& p, float* lds, int wg, int nwg) {
    bf16_t* X = (bf16_t*)lds;
    const int tid = ptid(), wave = __builtin_amdgcn_readfirstlane(tid >> 6), lane = tid & 63, r16 = lane & 15, g = lane >> 4;
    for (int item = wg; item < NT / 34; item += nwg) {
        const int rowI = item * 34;
        for (int z = tid; z < 14 * RPM_LD / 2; z += NTHR) ((unsigned*)(X + 34 * RPM_LD))[z] = 0u;
#pragma unroll
        for (int q12 = 0; q12 < 4; ++q12) {
            const int idx = tid + q12 * NTHR; if (idx >= 34 * 48) break; const int rr = idx / 48, j = (idx % 48) * 8; const int row = rowI + rr;
            int t, T; if (row < NL) { t = row % TL; T = TL; } else { t = (row - NL) % TC; T = TC; }
            const bf16_t* pc = p.P + (size_t)row * L0LD + 3072 + j;
            const uint4 zc = *(const uint4*)pc, z0 = {0u, 0u, 0u, 0u};
            const uint4 zp = t > 0 ? *(const uint4*)(pc - L0LD) : z0, zn = t < T - 1 ? *(const uint4*)(pc + L0LD) : z0;
            const float4 mA = *(const float4*)(p.in[9] + 3072 + j), mB = *(const float4*)(p.in[9] + 3072 + j + 4);
            const unsigned cu[4] = {zc.x, zc.y, zc.z, zc.w}, pu[4] = {zp.x, zp.y, zp.z, zp.w}, nu[4] = {zn.x, zn.y, zn.z, zn.w};
            const float mu[8] = {mA.x, mA.y, mA.z, mA.w, mB.x, mB.y, mB.z, mB.w};
            unsigned ou[4];
#pragma unroll
            for (int e = 0; e < 4; ++e) {
                float vv[2];
#pragma unroll
                for (int hf = 0; hf < 2; ++hf) {
                    const float c = hf ? __uint_as_float(cu[e] & 0xffff0000u) : __uint_as_float(cu[e] << 16);
                    const float pv = hf ? __uint_as_float(pu[e] & 0xffff0000u) : __uint_as_float(pu[e] << 16);
                    const float nx = hf ? __uint_as_float(nu[e] & 0xffff0000u) : __uint_as_float(nu[e] << 16);
                    float v = c + mu[2 * e + hf] * (0.5f * (pv + nx) - c);
                    v = j < 128 ? (1.f - 2.f * __builtin_amdgcn_rcpf(1.f + __expf(2.f * v))) : (j < 256 ? v : sigm(v));
                    vv[hf] = v;
                }
                ou[e] = cvt_pk_bf16(vv[0], vv[1]);
            }
            *(uint4*)(X + rr * RPM_LD + j) = make_uint4(ou[0], ou[1], ou[2], ou[3]);
        }
        __syncthreads();
#pragma unroll 1
        for (int rt = 0; rt < 3; ++rt) {
        const int row0 = rowI + rt * 16, rowEnd = rowI + 34;
        pg8::bf16x8 af[12];
#pragma unroll
        for (int ks = 0; ks < 12; ++ks) af[ks] = *(const pg8::bf16x8*)(X + (rt * 16 + r16) * RPM_LD + ks * 32 + 8 * g);
#pragma unroll 1
        for (int hh = 0; hh < 2; ++hh) {
            const int h = wave * 2 + hh;
            pg8::f32x4 dA0[4], dA1[4], iA0[4], iA1[4], gG[4];
#pragma unroll
            for (int cb = 0; cb < 4; ++cb) {
                const int chb = h * 64 + cb * 16 + r16;
                pg8::f32x4 z = {0.f, 0.f, 0.f, 0.f};
                dA0[cb] = z; dA1[cb] = z; iA0[cb] = z; iA1[cb] = z; gG[cb] = z;
#pragma unroll
                for (int kk = 0; kk < 2; ++kk) {
                    dA0[cb] = __builtin_amdgcn_mfma_f32_16x16x32_bf16(af[kk], *(const pg8::bf16x8*)(p.WTd + ((size_t)chb) * 64 + kk * 32 + 8 * g), dA0[cb], 0, 0, 0);
                    dA1[cb] = __builtin_amdgcn_mfma_f32_16x16x32_bf16(af[2 + kk], *(const pg8::bf16x8*)(p.WTd + ((size_t)1024 + chb) * 64 + kk * 32 + 8 * g), dA1[cb], 0, 0, 0);
                    iA0[cb] = __builtin_amdgcn_mfma_f32_16x16x32_bf16(af[4 + kk], *(const pg8::bf16x8*)(p.WTi + ((size_t)chb) * 64 + kk * 32 + 8 * g), iA0[cb], 0, 0, 0);
                    iA1[cb] = __builtin_amdgcn_mfma_f32_16x16x32_bf16(af[6 + kk], *(const pg8::bf16x8*)(p.WTi + ((size_t)1024 + chb) * 64 + kk * 32 + 8 * g), iA1[cb], 0, 0, 0);
                }
#pragma unroll
                for (int kk = 0; kk < 4; ++kk)
                    gG[cb] = __builtin_amdgcn_mfma_f32_16x16x32_bf16(af[8 + kk], *(const pg8::bf16x8*)(p.WTg + (size_t)chb * 128 + kk * 32 + 8 * g), gG[cb], 0, 0, 0);
            }
            float* T = lds + 9472 + wave * 2560;
            const int ch = h * 64 + lane;
            const float mur = p.in[9][ch], muk = p.in[9][1024 + ch], muv = p.in[9][2048 + ch], kkc = p.in[15][ch], ka = p.in[16][ch];
            const float w00 = p.in[10][ch], w01 = p.in[10][1024 + ch], a00 = p.in[12][ch], a01 = p.in[12][1024 + ch];
            float nr_[6], nk_[6], nv_[6];
#define RP_LOADP(Q4) do { _Pragma("unroll") for (int q = 0; q < 6; ++q) { int rq = row0 + (Q4) * 4 - 1 + q; rq = rq < 0 ? 0 : (rq > NT - 1 ? NT - 1 : rq); \
                const bf16_t* pp = p.P + (size_t)rq * L0LD + ch; nr_[q] = bf2f(pp[0]); nk_[q] = bf2f(pp[1024]); nv_[q] = bf2f(pp[2048]); } } while (0)
            RP_LOADP(0);
#pragma unroll 1
            for (int q4 = 0; q4 < 4; ++q4) {
                if (row0 + q4 * 4 >= rowEnd) break;
                if ((q4 & 1) == 0 && (g >> 1) == (q4 >> 1)) {
#pragma unroll
                    for (int cb = 0; cb < 4; ++cb)
#pragma unroll
                        for (int reg = 0; reg < 4; ++reg) { const int o = (((4 * g + reg) & 7) * 64) + cb * 16 + r16;
                            T[o] = dA0[cb][reg]; T[512 + o] = dA1[cb][reg]; T[1024 + o] = iA0[cb][reg]; T[1536 + o] = iA1[cb][reg]; T[2048 + o] = gG[cb][reg]; }
                }
                float pr_[6], pk_[6], pv_[6];
#pragma unroll
                for (int q = 0; q < 6; ++q) { pr_[q] = nr_[q]; pk_[q] = nk_[q]; pv_[q] = nv_[q]; }
                RP_LOADP(q4 + 1);
#pragma unroll
                for (int r4 = 0; r4 < 4; ++r4) {
                    const int rr = (q4 & 1) * 4 + r4;
                    const int row = row0 + q4 * 4 + r4; const size_t o = (size_t)row * 1024 + ch;
                    if (row >= rowEnd) break;
                    const float d0 = T[rr * 64 + lane], d1 = T[512 + rr * 64 + lane], i0 = T[1024 + rr * 64 + lane], i1 = T[1536 + rr * 64 + lane], gv = T[2048 + rr * 64 + lane];
                    int tt, TT; if (row < NL) { tt = row % TL; TT = TL; } else { tt = (row - NL) % TC; TT = TC; }
                    const bool hp = tt > 0, hn = tt < TT - 1;
                    const float rv = pr_[r4 + 1] + mur * (0.5f * ((hp ? pr_[r4] : 0.f) + (hn ? pr_[r4 + 2] : 0.f)) - pr_[r4 + 1]);
                    const float k = pk_[r4 + 1] + muk * (0.5f * ((hp ? pk_[r4] : 0.f) + (hn ? pk_[r4 + 2] : 0.f)) - pk_[r4 + 1]);
                    const float v = pv_[r4 + 1] + muv * (0.5f * ((hp ? pv_[r4] : 0.f) + (hn ? pv_[r4 + 2] : 0.f)) - pv_[r4 + 1]);
                    const float kq = k * kkc; const float ssum = wave_sum(kq * kq); const float kkn = kq * rsqrtf(ssum + 1e-12f);
                    p.R[o] = f2bf(rv); p.V[o] = v; p.G[o] = gv; p.KK[o] = f2bf(kkn);
                    {   const float wlog = -softplusf(-(w00 + d0)) - 0.5f; const float a = sigm(a00 + i0);
                        p.W[0][o] = __expf(-__expf(wlog)); p.NB[0][o] = f2bf(-kkn * a); p.KD[0][o] = f2bf(k * (1.f + (a - 1.f) * ka)); }
                    {   const float wlog = -softplusf(-(w01 + d1)) - 0.5f; const float a = sigm(a01 + i1);
                        p.W[1][o] = __expf(-__expf(wlog)); p.NB[1][o] = f2bf(-kkn * a); p.KD[1][o] = f2bf(k * (1.f + (a - 1.f) * ka)); }
                }
            }
        }
        }
        __syncthreads();
    }
}

typedef float f2v __attribute__((ext_vector_type(2)));
#define RW_TB 32
#define RW_STEPF 336
#define RW_NBLK ((TC + TL) / RW_TB)
#define RW_LJ 11
__device__ __forceinline__ void ph_rwscan(const Params& p, float* lds, int wg, int nwg, int ct_begin) {
    const int tid = ptid(), wave = __builtin_amdgcn_readfirstlane(tid >> 6), lane = tid & 63;
    const bool loader = wave >= 4;
    for (int unit = wg; unit < 256; unit += nwg) {
        const int b = unit >> 7, h = (unit >> 3) & 15, dir = (unit >> 2) & 1, rg = unit & 3;
        const int lt = tid & 255;
        const float* const aW = dir ? p.W[1] : p.W[0]; const bf16_t* const aN = dir ? p.NB[1] : p.NB[0]; const bf16_t* const aD = dir ? p.KD[1] : p.KD[0];
        const int st0 = lt >> 4, st1 = 16 + (lt >> 4), c4l = lt & 15, sth = lt >> 3, c8l = lt & 7, qv = lt < 128 ? lt : 127, stv = qv >> 2, cvl = qv & 3;
        float4 rAW0, rAW1, rAV, rBW0, rBW1, rBV; uint4 rAK, rAN, rAD, rAR, rBK, rBN, rBD, rBR;
#define RW_LOAD_BLOCK(BLK, S) do { const int blk_ = (BLK) < RW_NBLK ? (BLK) : RW_NBLK - 1; const int T_ = blk_ < TC / RW_TB ? TC : TL, base_ = blk_ < TC / RW_TB ? NL + b * TC : b * TL, i0_ = blk_ < TC / RW_TB ? blk_ * RW_TB : (blk_ - TC / RW_TB) * RW_TB; \
        const int ta_ = dir ? T_ - 1 - (i0_ + st0) : i0_ + st0, tb_ = dir ? T_ - 1 - (i0_ + st1) : i0_ + st1, th_ = dir ? T_ - 1 - (i0_ + sth) : i0_ + sth, tv_ = dir ? T_ - 1 - (i0_ + stv) : i0_ + stv; \
        const size_t oa_ = (size_t)(base_ + ta_) * 1024 + h * 64 + c4l * 4, ob_ = (size_t)(base_ + tb_) * 1024 + h * 64 + c4l * 4, oh_ = (size_t)(base_ + th_) * 1024 + h * 64 + c8l * 8, ov_ = (size_t)(base_ + tv_) * 1024 + h * 64 + rg * 16 + cvl * 4; \
        r##S##W0 = *(const float4*)(aW + oa_); r##S##W1 = *(const float4*)(aW + ob_); r##S##K = *(const uint4*)(p.KK + oh_); r##S##N = *(const uint4*)(aN + oh_); \
        r##S##D = *(const uint4*)(aD + oh_); r##S##R = *(const uint4*)(p.R + oh_); r##S##V = *(const float4*)(p.V + ov_); } while (0)
#define RW_BF4LO(U) make_float4(__uint_as_float((U).x << 16), __uint_as_float((U).x & 0xffff0000u), __uint_as_float((U).y << 16), __uint_as_float((U).y & 0xffff0000u))
#define RW_BF4HI(U) make_float4(__uint_as_float((U).z << 16), __uint_as_float((U).z & 0xffff0000u), __uint_as_float((U).w << 16), __uint_as_float((U).w & 0xffff0000u))
#define RW_WRITE_BLOCK(BUF, S) do { float4* wq_ = (float4*)(BUF); wq_[st0 * 84 + c4l * 5] = r##S##W0; wq_[st1 * 84 + c4l * 5] = r##S##W1; \
        float4* wh_ = wq_ + sth * 84 + (2 * c8l) * 5 + 1; \
        wh_[0] = RW_BF4LO(r##S##K); wh_[5] = RW_BF4HI(r##S##K); wh_[1] = RW_BF4LO(r##S##N); wh_[6] = RW_BF4HI(r##S##N); \
        wh_[2] = RW_BF4LO(r##S##D); wh_[7] = RW_BF4HI(r##S##D); wh_[3] = RW_BF4LO(r##S##R); wh_[8] = RW_BF4HI(r##S##R); \
        wq_[stv * 84 + 80 + cvl] = r##S##V; } while (0)
        float* buf0 = lds; float* buf1 = lds + RW_TB * RW_STEPF;
        float4 cv0, cv1, cv2, cv3, cv4, cv5, cv6, cv7;
        const unsigned long long* cttab = (const unsigned long long*)((const char*)lds + CTTAB_OFF);
        const int cgw = wg * 4 + (wave - 4), cnw = nwg * 4;
        char* const ctlds = (char*)lds + 2 * RW_TB * RW_STEPF * 4 + (wave - 4) * CT_LDS_BYTES;
        if (loader) { RW_LOAD_BLOCK(0, A); RW_WRITE_BLOCK(buf0, A); RW_LOAD_BLOCK(1, A); RW_LOAD_BLOCK(2, B); CT_LOAD(ct_begin + cgw); }
        __syncthreads();
        f2v Sa = {0.f, 0.f}, Sb = {0.f, 0.f};
        float* const Yd = dir ? p.Y[1] : p.Y[0];
        const int seg = lane & 15, vrl = wave * 4 + (lane >> 4);
#define RW_LOADER_STEP(BLK, NXT, S) do { __builtin_amdgcn_s_setprio(0); RW_WRITE_BLOCK(NXT, S); RW_LOAD_BLOCK((BLK) + 3, S); \
        { const int tcur = ct_begin + (BLK) * cnw + cgw; CT_STORE(tcur, ctlds); CT_LOAD(tcur + cnw); } } while (0)
#define RW_CONSUME(BLK, CUR) do { __builtin_amdgcn_s_setprio(3); \
        float ylo = 0.f, yhi = 0.f; \
        const float* sp0 = (CUR) + seg * 20; const float* vp0 = (CUR) + 320 + vrl; \
        float4 w4 = *(const float4*)(sp0), k4 = *(const float4*)(sp0 + 4), n4 = *(const float4*)(sp0 + 8), d4 = *(const float4*)(sp0 + 12), r4 = *(const float4*)(sp0 + 16); \
        float v = vp0[0]; \
        _Pragma("unroll") for (int s = 0; s < RW_TB; ++s) { \
            float4 w4n = w4, k4n = k4, n4n = n4, d4n = d4, r4n = r4; float vn = v; \
            if (s + 1 < RW_TB) { const float* sp = sp0 + (s + 1) * RW_STEPF; \
                w4n = *(const float4*)(sp); k4n = *(const float4*)(sp + 4); n4n = *(const float4*)(sp + 8); d4n = *(const float4*)(sp + 12); r4n = *(const float4*)(sp + 16); \
                vn = vp0[(s + 1) * RW_STEPF]; } \
            __builtin_amdgcn_sched_barrier(0); \
            const f2v wA = {w4.x, w4.y}, wB = {w4.z, w4.w}, kA = {k4.x, k4.y}, kB = {k4.z, k4.w}, nA = {n4.x, n4.y}, nB = {n4.z, n4.w}; \
            const f2v dA = {d4.x, d4.y}, dB = {d4.z, d4.w}, rA = {r4.x, r4.y}, rB = {r4.z, r4.w}; \
            f2v t = Sa * kA; t = __builtin_elementwise_fma(Sb, kB, t); \
            const float sa = dpp_add16(t.x + t.y); \
            const f2v sav = {sa, sa}, vv = {v, v}; \
            const f2v tA = __builtin_elementwise_fma(sav, nA, vv * dA), tB = __builtin_elementwise_fma(sav, nB, vv * dB); \
            Sa = __builtin_elementwise_fma(Sa, wA, tA); Sb = __builtin_elementwise_fma(Sb, wB, tB); \
            f2v yy = Sa * rA; yy = __builtin_elementwise_fma(Sb, rB, yy); \
            const float y = dpp_add16(yy.x + yy.y); \
            if (s < 16) ylo = (seg == s) ? y : ylo; else yhi = (seg == (s - 16)) ? y : yhi; \
            w4 = w4n; k4 = k4n; n4 = n4n; d4 = d4n; r4 = r4n; v = vn; } \
        const int blk_ = (BLK); const int T = blk_ < TC / RW_TB ? TC : TL, base = blk_ < TC / RW_TB ? NL + b * TC : b * TL, i0 = blk_ < TC / RW_TB ? blk_ * RW_TB : (blk_ - TC / RW_TB) * RW_TB; \
        const int ia = i0 + seg, ib = i0 + 16 + seg; \
        const int ta = dir ? T - 1 - ia : ia, tb = dir ? T - 1 - ib : ib; \
        Yd[(size_t)(base + ta) * 1024 + h * 64 + rg * 16 + vrl] = ylo; \
        Yd[(size_t)(base + tb) * 1024 + h * 64 + rg * 16 + vrl] = yhi; \
        __builtin_amdgcn_s_setprio(0); } while (0)
        for (int blk = 0; blk < RW_NBLK; blk += 2) {
            if (loader) RW_LOADER_STEP(blk, buf1, A); else RW_CONSUME(blk, buf0);
            lds_barrier();
            if (loader) RW_LOADER_STEP(blk + 1, buf0, B); else RW_CONSUME(blk + 1, buf1);
            lds_barrier();
        }
        __syncthreads();
    }
}

__device__ __forceinline__ void ph_rwout(const Params& p, int wg, int nwg) {
    const int tid_ = ptid(); const int wave = tid_ >> 6, lane = tid_ & 63;
    for (int row = wg; row < NT; row += nwg) {
#pragma unroll
        for (int hh = 0; hh < 2; ++hh) {
            const int h = wave * 2 + hh;
            const size_t o = (size_t)row * 1024 + h * 64 + lane;
            const float y = p.Y[0][o] + p.Y[1][o];
            const float mu = wave_sum(y) * (1.f / 64.f);
            const float dlt = y - mu;
            const float var = wave_sum(dlt * dlt) * (1.f / 64.f);
            const float yn = dlt * rsqrtf(var + 64e-5f) * p.in[18][h * 64 + lane] + p.in[19][h * 64 + lane];
            const float r = bf2f(p.R[o]), kb = 0.5f * (bf2f(p.KD[0][o]) + bf2f(p.KD[1][o]));
            const float bs = wave_sum(r * kb * p.in[17][h * 64 + lane]);
            p.MIXb[(size_t)row * DM + h * 64 + lane] = f2bf((yn + bs * p.V[o]) * p.G[o]);
        }
    }
}

__device__ __forceinline__ void ph_naprep(const Params& p, float* lds, int wg, int nwg) {
    const int tid = ptid(), wave = tid >> 6, lane = tid & 63;
    {
        const float kb = 8.f * wave_max(fabsf(p.in[21][lane]));
        float bmax[2];
#pragma unroll
        for (int hh = 0; hh < 2; ++hh) { float m = 0.f; for (int i = lane; i < 465; i += 64) m = fmaxf(m, fabsf(p.in[22][(wave * 2 + hh) * 465 + i])); bmax[hh] = wave_max(m); }
        const float qw = p.in[20][lane] * 0.125f, kw = p.in[21][lane];
        float nq[2], nk[2];
#define NAP_LOAD(ROW) do { const bf16_t* pp_ = p.P + (size_t)(ROW) * L0LD + RWC + wave * 128 + lane; \
        nq[0] = bf2f(pp_[0]); nq[1] = bf2f(pp_[64]); nk[0] = bf2f(pp_[1024]); nk[1] = bf2f(pp_[1088]); } while (0)
        NAP_LOAD(wg < NT ? wg : 0);
        for (int row = wg; row < NT; row += nwg) {
            const float cq[2] = {nq[0], nq[1]}, ck[2] = {nk[0], nk[1]};
            NAP_LOAD(row + nwg < NT ? row + nwg : row);
#pragma unroll
            for (int hh = 0; hh < 2; ++hh) {
                const int h = wave * 2 + hh;
                const float q = cq[hh], k = ck[hh];
                const float qs = wave_sum(q * q) * (1.f / 64.f), ks = wave_sum(k * k) * (1.f / 64.f);
                const float qn = q * rsqrtf(qs + 1e-6f) * qw, kn = k * rsqrtf(ks + 1e-6f) * kw;
                p.Qb[(size_t)row * 1024 + h * 64 + lane] = f2bf(qn);
                { const int kb_ = row < NL ? row / TL : (row - NL) / TC, tp_ = row < NL ? row % TL : TL + (row - NL) % TC;
                  p.Kb[((((size_t)(kb_ * 16 + h) * 136 + (tp_ >> 5)) * 4 + (lane >> 4)) * 64 + ((lane >> 3) & 1) * 32 + (tp_ & 31)) * 8 + (lane & 7)] = f2bf(kn); }
                const float qq = wave_sum(qn * qn);
                if (lane == 0) p.QM[row * 16 + h] = (sqrtf(qq) * kb * 1.01f + bmax[hh]) * 1.44269504f;
            }
        }
    }
    {
        bf16_t* T = (bf16_t*)lds;
        for (int item = wg; item < 136 * 8; item += nwg) {
            const int tb = item >> 3, hg = item & 7;
            const int row0 = tb < 128 ? tb * 64 : NL + (tb - 128) * 64;
            {
                const int tok = tid >> 3, c16 = (tid & 7) * 16;
                const bf16_t* src = p.P + (size_t)(row0 + tok) * L0LD + RWC + 2048 + hg * 128 + c16;
                const uint4 va4 = *(const uint4*)src, vb4 = *(const uint4*)(src + 8);
                const unsigned wv[8] = {va4.x, va4.y, va4.z, va4.w, vb4.x, vb4.y, vb4.z, vb4.w};
#pragma unroll
                for (int q = 0; q < 8; ++q) { T[(c16 + 2 * q) * 72 + tok] = (bf16_t)(wv[q] & 0xffffu); T[(c16 + 2 * q + 1) * 72 + tok] = (bf16_t)(wv[q] >> 16); }
            }
            __syncthreads();
            {
                const int b = tb < 128 ? tb >> 6 : (tb - 128) >> 2, tile0 = tb < 128 ? (tb & 63) * 2 : 128 + ((tb - 128) & 3) * 2;
#pragma unroll
                for (int q = 0; q < 2; ++q) {
                    const int idx = tid + NTHR * q, ln = idx & 63, sq = (idx >> 6) & 1, nt = (idx >> 7) & 1, tl = (idx >> 8) & 1, hl = idx >> 9;
                    const int rr = ln & 31, hh2 = ln >> 5, ch = hl * 64 + 32 * nt + rr, tk0 = tl * 32 + 16 * sq + 4 * hh2;
                    const uint2 lo = *(const uint2*)(T + ch * 72 + tk0), hi = *(const uint2*)(T + ch * 72 + tk0 + 8);
                    *(uint4*)(p.VTl + ((((size_t)(b * 16 + 2 * hg + hl) * 136 + tile0 + tl) * 2 + nt) * 2 + sq) * 512 + ln * 8) = make_uint4(lo.x, lo.y, hi.x, hi.y);
                }
            }
            __syncthreads();
        }
    }
}

typedef float f32x16 __attribute__((ext_vector_type(16)));
template <bool BAND>
__device__ __forceinline__ void na_tile(const Params& p, const float* tab, const pg8::bf16x8 (&qf)[4], int keyrow0, const bf16_t* vtp, int vstride, int h, int r, int hh,
                                        int kc0, int q, int c0, int browoff, float mq, f32x16& o0, f32x16& o1, float& l) {
    pg8::bf16x8 kf[4];
#pragma unroll
    for (int ks = 0; ks < 4; ++ks) kf[ks] = *(const pg8::bf16x8*)(p.Kb + ((size_t)keyrow0 * 4 + ks) * 512 + (hh * 32 + r) * 8);
    pg8::bf16x8 vf[2][2];
#pragma unroll
    for (int nt = 0; nt < 2; ++nt)
#pragma unroll
        for (int s = 0; s < 2; ++s) vf[nt][s] = *(const pg8::bf16x8*)(vtp + ((nt * 2 + s) * 64 + hh * 32 + r) * 8);
    f32x16 sacc;
#pragma unroll
    for (int i = 0; i < 16; ++i) sacc[i] = 0.f;
#pragma unroll
    for (int ks = 0; ks < 4; ++ks) sacc = __builtin_amdgcn_mfma_f32_32x32x16_bf16(kf[ks], qf[ks], sacc, 0, 0, 0);
    float pv[16];
#pragma unroll
    for (int reg = 0; reg < 16; ++reg) {
        float sc = sacc[reg];
        if (BAND) {
            const int kc = kc0 + (reg & 3) + 8 * (reg >> 2) + 4 * hh;
            const bool valid = (unsigned)(kc - c0) < 16u;
            const int bi = valid ? browoff + kc - q + 15 : 0;
            sc += tab[bi];
            pv[reg] = valid ? __builtin_amdgcn_exp2f(sc * 1.44269504f - mq) : 0.f;
        } else pv[reg] = __builtin_amdgcn_exp2f(sc * 1.44269504f - mq);
        l += pv[reg];
    }
    pg8::bf16x8 pf[2];
#pragma unroll
    for (int s = 0; s < 2; ++s) { const pg8::u32x4 w = {cvt_pk_bf16(pv[8 * s], pv[8 * s + 1]), cvt_pk_bf16(pv[8 * s + 2], pv[8 * s + 3]), cvt_pk_bf16(pv[8 * s + 4], pv[8 * s + 5]), cvt_pk_bf16(pv[8 * s + 6], pv[8 * s + 7])};
        pf[s] = __builtin_bit_cast(pg8::bf16x8, w); }
#pragma unroll
    for (int s = 0; s < 2; ++s) { o0 = __builtin_amdgcn_mfma_f32_32x32x16_bf16(vf[0][s], pf[s], o0, 0, 0, 0); o1 = __builtin_amdgcn_mfma_f32_32x32x16_bf16(vf[1][s], pf[s], o1, 0, 0, 0); }
}
__device__ __forceinline__ void ph_naattn(const Params& p, float* lds, int wg, int nwg) {
    const int tid = ptid(), wave = __builtin_amdgcn_readfirstlane(tid >> 6), lane = tid & 63, r = lane & 31, hh = lane >> 5;
    float* tab = lds + wave * 512;
    for (int u = wg * 8 + wave; u < 4096 + 256; u += nwg * 8) {
        int b, h, qrow0, nband = 0, gr = 0, r0 = 0, q0 = 0;
        if (u < 4096) { h = u & 15; int x = u >> 4; q0 = (x & 1) * 32; x >>= 1; gr = x & 63; b = x >> 6; qrow0 = b * TL + gr * 64 + q0; r0 = gr - 4; r0 = r0 < 0 ? 0 : (r0 > 56 ? 56 : r0); nband = 8; }
        else { int x = u - 4096; h = x & 15; x >>= 4; b = x >> 3; qrow0 = NL + b * TC + (x & 7) * 32; }
        if (nband) for (int i = lane; i < 465; i += 64) tab[i] = p.in[22][h * 465 + i];
        pg8::bf16x8 qf[4];
#pragma unroll
        for (int ks = 0; ks < 4; ++ks) qf[ks] = *(const pg8::bf16x8*)(p.Qb + (size_t)(qrow0 + r) * 1024 + h * 64 + 16 * ks + 8 * hh);
        const float mq = p.QM[(qrow0 + r) * 16 + h];
        f32x16 o0, o1;
#pragma unroll
        for (int i = 0; i < 16; ++i) { o0[i] = 0.f; o1[i] = 0.f; }
        float l = 0.f;
        const int q = q0 + r; int c0 = q - 8; c0 = c0 < 0 ? 0 : (c0 > 48 ? 48 : c0);
        for (int tl = 0; tl < nband * 2; ++tl) {
            const int i = tl >> 1, kt = tl & 1;
            { const int tid_ = (b * 16 + h) * 136 + (r0 + i) * 2 + kt; na_tile<true>(p, tab, qf, tid_, p.VTl + (size_t)tid_ * 2048, TL, h, r, hh, 32 * kt, q, c0, (r0 + i - gr + 7) * 31, mq, o0, o1, l); }
        }
        for (int kt = 0; kt < 8; ++kt)
            { const int tid_ = (b * 16 + h) * 136 + 128 + kt; na_tile<false>(p, tab, qf, tid_, p.VTl + (size_t)tid_ * 2048, TC, h, r, hh, 0, 0, 0, 0, mq, o0, o1, l); }
        l += __shfl_xor(l, 32);
        const float inv = 1.f / l;
        bf16_t* dst = p.MIXb + (size_t)(qrow0 + r) * DM + 1024 + h * 64 + 4 * hh;
#pragma unroll
        for (int g4 = 0; g4 < 4; ++g4) {
            uint2 w0, w1;
            w0.x = cvt_pk_bf16(o0[4 * g4] * inv, o0[4 * g4 + 1] * inv); w0.y = cvt_pk_bf16(o0[4 * g4 + 2] * inv, o0[4 * g4 + 3] * inv);
            w1.x = cvt_pk_bf16(o1[4 * g4] * inv, o1[4 * g4 + 1] * inv); w1.y = cvt_pk_bf16(o1[4 * g4 + 2] * inv, o1[4 * g4 + 3] * inv);
            *(uint2*)(dst + 8 * g4) = w0; *(uint2*)(dst + 32 + 8 * g4) = w1;
        }
    }
}

#define GLA_NCH 68
#define GLA_LDP 264
__device__ __forceinline__ void ph_glaprep(const Params& p, float* lds, int wg, int nwg) {
    bf16_t* Qs = (bf16_t*)lds;
    bf16_t* Ks = Qs + 64 * GLA_LDP;
    float* lrs = (float*)(Ks + 64 * GLA_LDP);
    float* hsum = lrs + 64 * 16;
    const int tid = ptid(), wave = __builtin_amdgcn_readfirstlane(tid >> 6), lane = tid & 63;
    for (int unit = wg; unit < 16 * GLA_NCH; unit += nwg) {
        const int bhd = unit / GLA_NCH, c = unit % GLA_NCH;
        const int b = bhd >> 3, h = (bhd >> 1) & 3, dir = bhd & 1;
        const bool isctx = c < 4;
        const int T = isctx ? TC : TL, base = isctx ? NL + b * TC : b * TL, cc = isctx ? c : c - 4;
        for (int q = tid; q < 64 * 16; q += NTHR) { const int i = q >> 4, j = q & 15, idx = cc * 64 + i, t = dir ? T - 1 - idx : idx;
            lrs[q] = p.LRs[(size_t)(base + t) * 256 + 16 * dir + j]; }
#pragma unroll
        for (int q4 = 0; q4 < 4; ++q4) { const int e = tid + q4 * NTHR, i = e >> 5, c8 = e & 31, idx = cc * 64 + i, t = dir ? T - 1 - idx : idx;
            const bf16_t* pr = p.P + (size_t)(base + t) * L1LD + h * 256 + c8 * 8;
            *(uint4*)(Ks + i * GLA_LDP + c8 * 8) = *(const uint4*)pr;
            if (!isctx) *(uint4*)(Qs + i * GLA_LDP + c8 * 8) = *(const uint4*)(pr + 3104); }
        __syncthreads();
        {
            const int d = tid & 255, hf = tid >> 8, ch = h * 256 + d;
            float w2[16];
#pragma unroll
            for (int j = 0; j < 16; ++j) w2[j] = p.in[32][(size_t)(dir * 16 + j) * 1024 + ch];
            const float bias = p.in[33][dir * 1024 + ch];
            float lg[32]; float ls = 0.f;
#pragma unroll
            for (int i = 0; i < 32; ++i) { float x = bias;
#pragma unroll
                for (int j = 0; j < 16; ++j) x += lrs[(32 * hf + i) * 16 + j] * w2[j];
                lg[i] = -softplusf(-x) * (1.f / 16.f); ls += lg[i]; }
            hsum[hf * 256 + d] = ls;
            __syncthreads();
            const float bend = hsum[d] + hsum[256 + d];
            float bb = hf ? hsum[d] : 0.f, prev = 0.f; unsigned khp[16];
#pragma unroll
            for (int i = 0; i < 32; ++i) {
                const int ii = 32 * hf + i, idx = cc * 64 + ii, t = dir ? T - 1 - idx : idx;
                bb += lg[i]; (void)t;
                const float k = bf2f(Ks[ii * GLA_LDP + d]);
                const float kh = k * __expf(bend - bb);
                if (!isctx) { const float qt = bf2f(Qs[ii * GLA_LDP + d]) * __expf(bb) * 0.0625f, kt = k * __expf(-bb);
                    const bf16_t qb = f2bf(qt); Qs[ii * GLA_LDP + d] = qb; Ks[ii * GLA_LDP + d] = f2bf(kt); p.QT[(size_t)unit * 16384 + ((((ii >> 4) * 8 + (d >> 5)) * 64 + ((d >> 3) & 3) * 16 + (ii & 15)) * 8) + (d & 7)] = qb; }
                if (i & 1) khp[i >> 1] = cvt_pk_bf16(prev, kh); else prev = kh;
            }
            bf16_t* kd = p.KHT + (size_t)unit * 16384 + ((size_t)(((d >> 4) * 2 + hf) * 64 + (d & 15))) * 8;
#pragma unroll
            for (int q = 0; q < 4; ++q) *(uint4*)(kd + q * 128) = make_uint4(khp[4 * q], khp[4 * q + 1], khp[4 * q + 2], khp[4 * q + 3]);
            if (hf == 0) p.DEC[unit * 256 + d] = __expf(bend);
        }
        {
            const int v0 = tid;
            unsigned va[32];
#pragma unroll
            for (int i = 0; i < 64; i += 2) {
                const int idx0 = cc * 64 + i, t0 = dir ? T - 1 - idx0 : idx0, t1 = dir ? t0 - 1 : t0 + 1;
                const unsigned x0 = p.P[(size_t)(base + t0) * L1LD + 1024 + h * 512 + v0];
                const unsigned x1 = p.P[(size_t)(base + t1) * L1LD + 1024 + h * 512 + v0];
                va[i >> 1] = x0 | (x1 << 16);
            }
            bf16_t* d0 = p.VT + (size_t)unit * 32768 + ((size_t)((v0 >> 4) * 2 * 64 + (v0 & 15))) * 8;
#pragma unroll
            for (int q = 0; q < 8; ++q) *(uint4*)(d0 + ((q >> 2) * 64 + (q & 3) * 16) * 8) = make_uint4(va[4 * q], va[4 * q + 1], va[4 * q + 2], va[4 * q + 3]);
        }
        __syncthreads();
        if (!isctx) {
            const int r = lane & 15, g = lane >> 4, ti = wave >> 1;
#pragma unroll
            for (int q = 0; q < 2; ++q) {
                const int tj = (wave & 1) * 2 + q;
                pg8::f32x4 acc = {0.f, 0.f, 0.f, 0.f};
                if (tj <= ti) {
#pragma unroll
                    for (int ks = 0; ks < 8; ++ks) {
                        const pg8::bf16x8 a = *(const pg8::bf16x8*)(Ks + (tj * 16 + r) * GLA_LDP + ks * 32 + 8 * g);
                        const pg8::bf16x8 bq = *(const pg8::bf16x8*)(Qs + (ti * 16 + r) * GLA_LDP + ks * 32 + 8 * g);
                        acc = __builtin_amdgcn_mfma_f32_16x16x32_bf16(a, bq, acc, 0, 0, 0);
                    }
                }
                const int i = ti * 16 + r, j0 = tj * 16 + 4 * g;
                uint2 o;
                o.x = cvt_pk_bf16(j0 + 0 <= i ? acc[0] : 0.f, j0 + 1 <= i ? acc[1] : 0.f);
                o.y = cvt_pk_bf16(j0 + 2 <= i ? acc[2] : 0.f, j0 + 3 <= i ? acc[3] : 0.f);
                *(uint2*)(p.AM + (size_t)unit * 4096 + ((((i >> 4) * 2 + (j0 >> 5)) * 64 + ((j0 >> 3) & 3) * 16 + (i & 15)) * 8) + (j0 & 7)) = o;
            }
        }
        __syncthreads();
    }
}

#define GLA_LOAD_O(QT_, AM_, C_) do { const int c_ = (C_) < GLA_NCH ? (C_) : GLA_NCH - 1; const size_t u = (size_t)(bhd * GLA_NCH + c_); \
        _Pragma("unroll") for (int ks = 0; ks < 8; ++ks) QT_[ks] = *(const pg8::bf16x8*)(p.QT + u * 16384 + ((it * 8 + ks) * 64 + lane) * 8); \
        _Pragma("unroll") for (int ks = 0; ks < 2; ++ks) AM_[ks] = *(const pg8::bf16x8*)(p.AM + u * 4096 + ((it * 2 + ks) * 64 + lane) * 8); } while (0)
#define GLA_LOAD_S(KH_, VT_, DEC_, C_) do { const int c_ = (C_) < GLA_NCH ? (C_) : GLA_NCH - 1; const size_t u = (size_t)(bhd * GLA_NCH + c_); \
    _Pragma("unroll") for (int dt = 0; dt < 2; ++dt) { \
        _Pragma("unroll") for (int ks = 0; ks < 2; ++ks) { \
            KH_[dt][ks] = *(const pg8::bf16x8*)(p.KHT + u * 16384 + (((2 * w + dt) * 2 + ks) * 64 + lane) * 8); \
            VT_[dt][ks] = *(const pg8::bf16x8*)(p.VT + u * 32768 + (((vs * 2 + dt) * 2 + ks) * 64 + lane) * 8); } \
        DEC_[dt] = *(const pg8::f32x4*)(p.DEC + u * 256 + (2 * w + dt) * 16 + 4 * g); } } while (0)
#define GLA_LOAD_OVT(OVT_, C_) do { const size_t u = (size_t)(bhd * GLA_NCH + (C_)); _Pragma("unroll") for (int ks = 0; ks < 2; ++ks) OVT_[ks] = *(const pg8::bf16x8*)(p.VT + (u * 512 + vs * 32 + vt * 16 + r) * 64 + ks * 32 + 8 * g); } while (0)
__device__ __forceinline__ void ph_glascan(const Params& p, float* lds, int wg, int nwg, int gct_begin) {
    const unsigned long long* cttab = (const unsigned long long*)((const char*)lds + CTTAB_OFF);
    bf16_t* ST0 = (bf16_t*)lds; bf16_t* ST1 = ST0 + 32 * GLA_LDP;
    const int tid = ptid(), w = __builtin_amdgcn_readfirstlane(tid >> 6), lane = tid & 63, r = lane & 15, g = lane >> 4;
    const int it = w >> 1, vt = w & 1;
    for (int unit = wg; unit < 256; unit += nwg) {
        const int bhd = (unit & 7) * 2 + ((unit >> 3) & 1), vs = unit >> 4;
        const int b = bhd >> 3, h = (bhd >> 1) & 3, dir = bhd & 1;
        float* const Od = dir ? p.O[1] : p.O[0];
        for (int q = tid; q < 32 * GLA_LDP / 2; q += NTHR) ((unsigned*)ST0)[q] = 0u;
        pg8::f32x4 acc[2][2];
#pragma unroll
        for (int a = 0; a < 2; ++a)
#pragma unroll
            for (int c2 = 0; c2 < 2; ++c2) acc[a][c2] = (pg8::f32x4){0.f, 0.f, 0.f, 0.f};
        __syncthreads();
        pg8::bf16x8 cqt[8], cam[2], ckh[2][2], cvt[2][2], nkh[2][2], nvt[2][2]; pg8::f32x4 cdec[2], ndec[2];
        const pg8::bf16x8 zz = {0, 0, 0, 0, 0, 0, 0, 0};
#pragma unroll
        for (int ks = 0; ks < 8; ++ks) cqt[ks] = zz;
#pragma unroll
        for (int ks = 0; ks < 2; ++ks) cam[ks] = zz;
        GLA_LOAD_S(ckh, cvt, cdec, 0);
        float4 cv0, cv1, cv2, cv3, cv4, cv5, cv6, cv7; CT_LOAD(gct_begin + wg * 8 + w);
        const int gct_nch = (CT_TOTAL - gct_begin + nwg * 8 - 1) / (nwg * 8);
        for (int c = 0; c < GLA_NCH; ++c) {
            GLA_LOAD_S(nkh, nvt, ndec, c + 1);
            bf16_t* STc = (c & 1) ? ST1 : ST0; bf16_t* STn = (c & 1) ? ST0 : ST1;
#pragma unroll
            for (int dt = 0; dt < 2; ++dt)
#pragma unroll
                for (int v2 = 0; v2 < 2; ++v2) {
                    pg8::f32x4 a = acc[dt][v2] * cdec[dt];
#pragma unroll
                    for (int ks = 0; ks < 2; ++ks) a = __builtin_amdgcn_mfma_f32_16x16x32_bf16(ckh[dt][ks], cvt[v2][ks], a, 0, 0, 0);
                    acc[dt][v2] = a;
                    uint2 sv; sv.x = cvt_pk_bf16(a[0], a[1]); sv.y = cvt_pk_bf16(a[2], a[3]);
                    *(uint2*)(STn + (v2 * 16 + r) * GLA_LDP + (2 * w + dt) * 16 + 4 * g) = sv;
                }
            if (c >= 4) {
                pg8::f32x4 o = {0.f, 0.f, 0.f, 0.f};
#pragma unroll
                for (int ks = 0; ks < 8; ++ks) { const pg8::bf16x8 sa = *(const pg8::bf16x8*)(STc + (vt * 16 + r) * GLA_LDP + ks * 32 + 8 * g);
                    o = __builtin_amdgcn_mfma_f32_16x16x32_bf16(sa, cqt[ks], o, 0, 0, 0); }
                if (vt == 0) {
#pragma unroll
                    for (int ks = 0; ks < 2; ++ks) o = __builtin_amdgcn_mfma_f32_16x16x32_bf16(cvt[0][ks], cam[ks], o, 0, 0, 0);
                } else {
#pragma unroll
                    for (int ks = 0; ks < 2; ++ks) o = __builtin_amdgcn_mfma_f32_16x16x32_bf16(cvt[1][ks], cam[ks], o, 0, 0, 0);
                }
                const int idx = (c - 4) * 64 + it * 16 + r, t = dir ? TL - 1 - idx : idx;
                *(pg8::f32x4*)(Od + (size_t)(b * TL + t) * DM + h * 512 + vs * 32 + vt * 16 + 4 * g) = o;
            }
            if (c >= 3) GLA_LOAD_O(cqt, cam, c + 1);
#pragma unroll
            for (int ks = 0; ks < 2; ++ks) { cdec[ks] = ndec[ks];
#pragma unroll
                for (int q = 0; q < 2; ++q) { ckh[ks][q] = nkh[ks][q]; cvt[ks][q] = nvt[ks][q]; } }
            {
                const int tconv = gct_begin + c * (nwg * 8) + wg * 8 + w;
                if (c < gct_nch) { CT_STORE(tconv, 0); if (c + 1 < gct_nch) CT_LOAD(tconv + nwg * 8); }
            }
            lds_barrier();
        }
    }
}

__device__ __forceinline__ void ph_glaout(const Params& p, float* lds, int wg, int nwg) {
    (void)lds;
    const int tid = ptid(), wave = tid >> 6, lane = tid & 63;
    for (int row = wg * 8 + wave; row < NL; row += nwg * 8) {
        float4 o[8]; float hs[4] = {0.f, 0.f, 0.f, 0.f};
#pragma unroll
        for (int q = 0; q < 8; ++q) { const float4 a = ((const float4*)(p.O[0] + (size_t)row * DM))[lane + 64 * q], c = ((const float4*)(p.O[1] + (size_t)row * DM))[lane + 64 * q];
            o[q] = make_float4(a.x + c.x, a.y + c.y, a.z + c.z, a.w + c.w); hs[q >> 1] += o[q].x * o[q].x + o[q].y * o[q].y + o[q].z * o[q].z + o[q].w * o[q].w; }
#pragma unroll
        for (int hd = 0; hd < 4; ++hd) hs[hd] = rsqrtf(wave_sum(hs[hd]) * (1.f / 512.f) + 1e-6f);
#pragma unroll
        for (int q = 0; q < 8; ++q) {
            const float rs = hs[q >> 1];
            const float4 gn = ((const float4*)p.in[34])[lane + 64 * (q & 1)];
            const uint2 ogr = ((const uint2*)(p.P + (size_t)row * L1LD + 4128))[lane + 64 * q];
            const float4 og = make_float4(__uint_as_float(ogr.x << 16), __uint_as_float(ogr.x & 0xffff0000u), __uint_as_float(ogr.y << 16), __uint_as_float(ogr.y & 0xffff0000u));
            uint2 r;
            r.x = cvt_pk_bf16(o[q].x * rs * gn.x * siluf(og.x), o[q].y * rs * gn.y * siluf(og.y));
            r.y = cvt_pk_bf16(o[q].z * rs * gn.z * siluf(og.z), o[q].w * rs * gn.w * siluf(og.w));
            ((uint2*)(p.MIXb + (size_t)row * DM))[lane + 64 * q] = r;
        }
    }
}

__device__ __forceinline__ void ph_route(const Params& p, float* lds, int wg, int nwg) {
    float* rt = lds;
    const int tid = ptid(), wave = tid >> 6, lane = tid & 63;
    for (int i = tid; i < DM * 2; i += NTHR) { const float4 r = ((const float4*)p.in[36])[i]; const int k = i >> 1, e0 = (i & 1) * 4;
        rt[(e0 + 0) * DM + k] = r.x; rt[(e0 + 1) * DM + k] = r.y; rt[(e0 + 2) * DM + k] = r.z; rt[(e0 + 3) * DM + k] = r.w; }
    __syncthreads();
    for (int row = wg * 8 + wave; row < NL; row += nwg * 8) {
        float ss = 0.f;
#pragma unroll
        for (int q = 0; q < 8; ++q) { const float4 t = ((const float4*)(p.XA + (size_t)row * DM))[lane + 64 * q]; ss += t.x * t.x + t.y * t.y + t.z * t.z + t.w * t.w; }
        ss = wave_sum(ss);
        const float rs = rsqrtf(ss * (1.f / DM) + 1e-6f);
        const int g = row / TL;
        float l[8];
#pragma unroll
        for (int e = 0; e < 8; ++e) l[e] = 0.f;
#pragma unroll 2
        for (int q = 0; q < 8; ++q) {
            const int idx = lane + 64 * q;
            const float4 vq = ((const float4*)(p.XA + (size_t)row * DM))[idx];
            const float4 gn = ((const float4*)p.in[30])[idx];
            const float4 sh = ((const float4*)(p.mod1 + g * MODW + 3 * DM))[idx];
            const float4 sc = ((const float4*)(p.mod1 + g * MODW + 4 * DM))[idx];
            float4 hv;
            hv.x = vq.x * rs * gn.x * (1.f + sc.x) + sh.x; hv.y = vq.y * rs * gn.y * (1.f + sc.y) + sh.y;
            hv.z = vq.z * rs * gn.z * (1.f + sc.z) + sh.z; hv.w = vq.w * rs * gn.w * (1.f + sc.w) + sh.w;
            uint2 hb; hb.x = cvt_pk_bf16(hv.x, hv.y); hb.y = cvt_pk_bf16(hv.z, hv.w);
            ((uint2*)(p.Hb + (size_t)row * DM))[idx] = hb;
#pragma unroll
            for (int e = 0; e < 8; ++e) { const float4 r = ((const float4*)(rt + e * DM))[idx]; l[e] += hv.x * r.x + hv.y * r.y + hv.z * r.z + hv.w * r.w; }
        }
#pragma unroll
        for (int e = 0; e < 8; ++e) l[e] = wave_sum(l[e]);
        if (lane == 0) {
            int e0 = 0; float v0 = l[0];
#pragma unroll
            for (int e = 1; e < 8; ++e) if (l[e] > v0) { v0 = l[e]; e0 = e; }
            int e1 = -1; float v1 = -3.0e38f;
#pragma unroll
            for (int e = 0; e < 8; ++e) if (e != e0 && l[e] > v1) { v1 = l[e]; e1 = e; }
            const float w1 = 1.f / (1.f + expf(v0 - v1)), w0 = 1.f - w1;
            p.tok_e[row * 2] = e0; p.tok_e[row * 2 + 1] = e1; p.tok_w[row * 2] = w0; p.tok_w[row * 2 + 1] = w1;
        }
    }
    __syncthreads();
}

__device__ __forceinline__ void ph_dispatch_permute(const Params& p, float* lds, int wg, int nwg) {
    int* wtot = (int*)lds;
    int* pairs = wtot + 64;
    const int tid = ptid(), wave = tid >> 6, lane = tid & 63;
    int c[8];
#pragma unroll
    for (int e = 0; e < 8; ++e) c[e] = 0;
    for (int i = 0; i < 16; ++i) { const int tok = tid * 16 + i; const int ea = p.tok_e[tok * 2], eb = p.tok_e[tok * 2 + 1];
#pragma unroll
        for (int e = 0; e < 8; ++e) c[e] += (e == ea) + (e == eb); }
    int inc[8];
#pragma unroll
    for (int e = 0; e < 8; ++e) { int v = c[e];
#pragma unroll
        for (int o = 1; o < 64; o <<= 1) { const int t = __shfl_up(v, o); if (lane >= o) v += t; }
        inc[e] = v; }
    if (lane == 63) {
#pragma unroll
        for (int e = 0; e < 8; ++e) wtot[wave * 8 + e] = inc[e]; }
    __syncthreads();
    int pos[8], off[8], tot[8]; int total = 0;
#pragma unroll
    for (int e = 0; e < 8; ++e) { int base = 0, t = 0;
#pragma unroll
        for (int w8 = 0; w8 < 8; ++w8) { const int x = wtot[w8 * 8 + e]; base += (w8 < wave) ? x : 0; t += x; }
        tot[e] = t; off[e] = total; pos[e] = total + base + inc[e] - c[e]; total += ((t + 255) >> 8) << 8; }
    if (wg == 0 && tid == 0) {
#pragma unroll
        for (int e = 0; e < 8; ++e) { p.meta[e * 2] = tot[e]; p.meta[e * 2 + 1] = off[e]; const int nt = (tot[e] + 255) >> 8; for (int t = 0; t < nt; ++t) p.tile_e[(off[e] >> 8) + t] = e; }
        p.meta[16] = total;
    }
    int sl[32];
#pragma unroll
    for (int i = 0; i < 16; ++i) {
        const int tok = tid * 16 + i;
#pragma unroll
        for (int k = 0; k < 2; ++k) { const int e = p.tok_e[tok * 2 + k]; int sv = 0;
#pragma unroll
            for (int q = 0; q < 8; ++q) if (q == e) { sv = pos[q]; pos[q]++; }
            sl[i * 2 + k] = sv; }
    }
    for (int g = wg; g < NL / 32; g += nwg) {
        __syncthreads();
        if ((tid >> 1) == g) {
#pragma unroll
            for (int i = 0; i < 16; ++i)
#pragma unroll
                for (int k = 0; k < 2; ++k) { const int tok = tid * 16 + i, idx = (tid & 1) * 32 + i * 2 + k; pairs[idx * 2] = tok; pairs[idx * 2 + 1] = sl[i * 2 + k]; p.tok_slot[tok * 2 + k] = sl[i * 2 + k]; }
        }
        __syncthreads();
        const int half = tid >> 8, t4 = tid & 255;
        for (int q = half; q < 64; q += 8) {
            const int tk0 = pairs[q * 2], sv0 = pairs[q * 2 + 1], tk1 = pairs[q * 2 + 4], sv1 = pairs[q * 2 + 5], tk2 = pairs[q * 2 + 8], sv2 = pairs[q * 2 + 9], tk3 = pairs[q * 2 + 12], sv3 = pairs[q * 2 + 13];
            const uint4 r0 = ((const uint4*)(p.Hb + (size_t)tk0 * DM))[t4], r1 = ((const uint4*)(p.Hb + (size_t)tk1 * DM))[t4], r2 = ((const uint4*)(p.Hb + (size_t)tk2 * DM))[t4], r3 = ((const uint4*)(p.Hb + (size_t)tk3 * DM))[t4];
            ((uint4*)(p.Xp + (size_t)sv0 * DM))[t4] = r0; ((uint4*)(p.Xp + (size_t)sv1 * DM))[t4] = r1; ((uint4*)(p.Xp + (size_t)sv2 * DM))[t4] = r2; ((uint4*)(p.Xp + (size_t)sv3 * DM))[t4] = r3;
        }
    }
    {
        const int half = tid >> 8, t4 = tid & 255; int idx = 0;
#pragma unroll
        for (int e = 0; e < 8; ++e) { const int s0 = off[e] + tot[e], s1 = off[e] + (((tot[e] + 255) >> 8) << 8);
            for (int sv = s0 + half; sv < s1; sv += 2) { if (((idx + sv - s0) >> 1) % nwg == wg) ((uint4*)(p.Xp + (size_t)sv * DM))[t4] = make_uint4(0u, 0u, 0u, 0u); }
            idx += s1 - s0; }
    }
}

__device__ __forceinline__ void moe_tail_split(int ntm, int G, int& nfull, int& ntail, int& KS) {
    const int T = ntm * (DM / 256); nfull = (T / G) * G; ntail = T - nfull; KS = ntail == 0 ? 1 : (ntail * 4 <= G ? 4 : (ntail * 2 <= G ? 2 : 1));
    if (KS == 1) { nfull = T; ntail = 0; }
}
__device__ __forceinline__ float4 moe_fetch(const Params& p, int slot, int tid, int ntm, int nfull, int ntail, int KS) {
    const int pm = slot >> 8, pn = tid >> 6, L = pn * ntm + pm;
    if (L < nfull) { const uint2 r = ((const uint2*)(p.YE + (size_t)slot * DM))[tid]; return make_float4(__uint_as_float(r.x << 16), __uint_as_float(r.x & 0xffff0000u), __uint_as_float(r.y << 16), __uint_as_float(r.y & 0xffff0000u)); }
    const int t = L - nfull; float4 a = make_float4(0.f, 0.f, 0.f, 0.f);
    for (int ks = 0; ks < KS; ++ks) { const float4 q = *(const float4*)(p.YEP + (size_t)(ks * ntail + t) * 65536 + (slot & 255) * 256 + (tid & 63) * 4); a.x += q.x; a.y += q.y; a.z += q.z; a.w += q.w; }
    return a;
}
__device__ __forceinline__ void ph_combine(const Params& p, int wg, int nwg) {
    const int tid = ptid(), wave = tid >> 6, lane = tid & 63;
    const int ntm = p.meta[16] >> 8; int nfull, ntail, KS; moe_tail_split(ntm, nwg, nfull, ntail, KS);
    for (int row = wg * 8 + wave; row < NL; row += nwg * 8) {
        const int s0 = p.tok_slot[row * 2], s1 = p.tok_slot[row * 2 + 1];
        const float w0 = p.tok_w[row * 2], w1 = p.tok_w[row * 2 + 1];
#pragma unroll 4
        for (int q = 0; q < 8; ++q) {
            const int idx = lane + 64 * q;
            const float4 x = ((const float4*)(p.XA + (size_t)row * DM))[idx];
            const float4 g = ((const float4*)(p.mod1 + (row / TL) * MODW + 5 * DM))[idx];
            const float4 a = moe_fetch(p, s0, idx, ntm, nfull, ntail, KS), c = moe_fetch(p, s1, idx, ntm, nfull, ntail, KS);
            float4 o;
            o.x = x.x + g.x * (w0 * a.x + w1 * c.x); o.y = x.y + g.y * (w0 * a.y + w1 * c.y);
            o.z = x.z + g.z * (w0 * a.z + w1 * c.z); o.w = x.w + g.w * (w0 * a.w + w1 * c.w);
            ((float4*)(p.out + (size_t)row * DM))[idx] = o;
        }
    }
}

#define GEMM_STATIC(Aptr, Bptr, Mrows, Ncols, Kdim, EPI) do { pg8::Gemm g_{Aptr, Bptr, Kdim, Kdim}; pg8::StaticOrder S_; S_.init(Mrows, Ncols, nwg, wg); \
    pg8::gemm_phase<decltype(EPI), pg8::StaticOrder, true, true>(ldsb, g_, S_, EPI); } while (0)

__global__ void __launch_bounds__(NTHR, 2) k_all(Params p) {
    extern __shared__ __attribute__((aligned(16))) unsigned char dyn_lds[];
    float* lds = (float*)dyn_lds;
    PG8_LAS unsigned char* ldsb = (PG8_LAS unsigned char*)dyn_lds;
    volatile LAS unsigned* xbw = (volatile LAS unsigned*)(dyn_lds + 131072);
    if (threadIdx.x < 4) xbw[threadIdx.x] = 0u;
    if (threadIdx.x == 64) ct_table_init(p, (unsigned long long*)(dyn_lds + CTTAB_OFF));
    __syncthreads();
    XcdBarrier bar = xcd_barrier_post(p.bar, xbw);
    const int wg = blockIdx.x, nwg = gridDim.x;
#ifndef PROBE
#define PROBE 0
#endif
#define RUN(grp, ...) do { for (int rep_ = 0; rep_ < ((PROBE == (grp)) ? 2 : 1); ++rep_) { __VA_ARGS__ } } while (0)
    const int ct_rest = CT_TOTAL - CT_L0 - RW_NBLK * nwg * 4 - GLA_NCH * nwg * 8;
    const int ct_split = CT_L0 + (ct_rest > 0 ? ct_rest : 0);
    RUN(2, ph_mod(p, lds, wg, nwg); __syncthreads(); ph_lora_wt(p, wg, nwg); ph_convert(p, lds, wg, nwg, ct_split);); xcd_barrier(bar);
    RUN(5, ph_norm(p.in[0], p.in[2], p.in[6], p.mod0, 0, 1, p.Hb, NT, lds, wg, nwg);); xcd_barrier(bar);
    RUN(1, { EpiBf16Store E{p.P, L0LD, nullptr, 0, 0}; GEMM_STATIC(p.Hb, p.Wt_in0, NT, L0LD, DM, E); }); xcd_barrier(bar);
    RUN(3, ph_rwprep(p, lds, wg, nwg); ph_naprep(p, lds, wg, nwg);); xcd_barrier(bar);
    RUN(3, ph_rwscan(p, lds, wg, nwg, ct_split); ph_naattn(p, lds, wg, nwg);); xcd_barrier(bar);
    RUN(3, ph_rwout(p, wg, nwg);); xcd_barrier(bar);
    RUN(1, { EpiResGate E{p.in[0], p.in[2], p.mod0 + 2 * DM, p.XA}; GEMM_STATIC(p.MIXb, p.Wt_out0, NL, DM, DM, E); __syncthreads();
      pg8::Gemm g2{p.MIXb, p.Wt_out0, 256, DM}; pg8::CtxSplitOrder S2{DM / 256, 8, 256, nwg, wg}; EpiCtxPartial E2{p.PC, 256};
      pg8::gemm_phase<EpiCtxPartial, pg8::CtxSplitOrder, true, true>(ldsb, g2, S2, E2); }); xcd_barrier(bar);
    RUN(5, ph_norm(p.XA, p.in[2], p.in[7], p.mod0, 3, 4, p.Hb, NT, lds, wg, nwg, p.PC, 8, p.mod0 + 2 * MODW + 2 * DM, p.XA);); xcd_barrier(bar);
    RUN(1, { EpiSwiglu E{p.H1b, FFN, 0}; GEMM_STATIC(p.Hb, p.Wt_ffnup, NT, 2 * FFN, DM, E); }); xcd_barrier(bar);
    RUN(1, { EpiResGate E{p.XA, p.XA + (size_t)NL * DM, p.mod0 + 5 * DM, p.XB}; GEMM_STATIC(p.H1b, p.Wt_ffndn, NL, DM, FFN, E); __syncthreads();
      pg8::Gemm g2{p.H1b, p.Wt_ffndn, 512, FFN}; pg8::CtxSplitOrder S2{DM / 256, 11, 512, nwg, wg}; EpiCtxPartial E2{p.PC, 512};
      pg8::gemm_phase<EpiCtxPartial, pg8::CtxSplitOrder, true, true>(ldsb, g2, S2, E2); }); xcd_barrier(bar);
    RUN(5, ph_norm(p.XB, p.XA + (size_t)NL * DM, p.in[29], p.mod1, 0, 1, p.Hb, NT, lds, wg, nwg, p.PC, 11, p.mod0 + 2 * MODW + 5 * DM, nullptr);); xcd_barrier(bar);
    RUN(1, { EpiBf16Store E{p.P, L1LD, p.LRs, 12, 0}; GEMM_STATIC(p.Hb, p.Wt_in1, NT, L1LD, DM, E); }); xcd_barrier(bar);
    RUN(4, ph_glaprep(p, lds, wg, nwg);); xcd_barrier(bar);
    RUN(4, ph_glascan(p, lds, wg, nwg, ct_split + RW_NBLK * nwg * 4);); xcd_barrier(bar);
    RUN(4, ph_glaout(p, lds, wg, nwg);); xcd_barrier(bar);
    RUN(1, { EpiResGate E{p.XB, p.XB + (size_t)NL * DM, p.mod1 + 2 * DM, p.XA}; GEMM_STATIC(p.MIXb, p.Wt_out1, NL, DM, DM, E); }); xcd_barrier(bar);
    RUN(5, ph_route(p, lds, wg, nwg);); xcd_barrier(bar);
    RUN(5, ph_dispatch_permute(p, lds, wg, nwg);); xcd_barrier(bar);
    RUN(1, { pg8::Gemm g{p.Xp, p.Wt_expup, DM, DM}; pg8::GroupedOrder S{p.meta[16] >> 8, 2 * EXD / 256, nwg, wg, p.tile_e}; EpiSwiglu E{p.H1Eb, EXD, 2 * EXD / 256};
      pg8::gemm_phase<EpiSwiglu, pg8::GroupedOrder, true, true>(ldsb, g, S, E); }); xcd_barrier(bar);
    RUN(1, { const int ntm = p.meta[16] >> 8; int nfull, ntail, KS; moe_tail_split(ntm, nwg, nfull, ntail, KS);
      { pg8::Gemm g{p.H1Eb, p.Wt_expdn, EXD, EXD}; pg8::GroupedRange S{ntm, DM / 256, 0, nfull, nwg, wg, p.tile_e}; EpiBf16Store E{p.YE, DM, nullptr, 0, DM / 256};
        pg8::gemm_phase<EpiBf16Store, pg8::GroupedRange, true, true>(ldsb, g, S, E); }
      __syncthreads();
      { pg8::Gemm g{p.H1Eb, p.Wt_expdn, EXD / KS, EXD}; pg8::GroupedTail S{ntm, DM / 256, nfull, ntail, KS, EXD / KS, nwg, wg, p.tile_e}; EpiTailPartial E{p.YEP, ntm, DM / 256, nfull, ntail, EXD / KS};
        pg8::gemm_phase<EpiTailPartial, pg8::GroupedTail, true, true>(ldsb, g, S, E); } }); xcd_barrier(bar);
    RUN(5, ph_combine(p, wg, nwg););
}

extern "C" void kernel_launch(void* const* d_in, const int* in_sizes, int n_in, void* d_out, int out_size, void* d_ws, size_t ws_size, hipStream_t stream) {
    (void)in_sizes; (void)out_size;
    if (n_in != 40) return;
    Params p;
    memset(&p, 0, sizeof(p));
    for (int i = 0; i < 40; ++i) p.in[i] = (const float*)d_in[i];
    p.out = (float*)d_out;
    char* w = (char*)d_ws;
    size_t o = 0;
    auto take = [&](size_t bytes) { char* r = w + o; o += (bytes + 255) & ~(size_t)255; return (void*)r; };
    p.bar = (unsigned*)take(XCD_BAR_WORDS * 4);
    p.mod0 = (float*)take(3 * MODW * 4); p.mod1 = (float*)take(3 * MODW * 4);
    p.tok_e = (int*)take(NL * 2 * 4); p.tok_w = (float*)take(NL * 2 * 4); p.meta = (int*)take(256); p.slot_token = (int*)take(MAXSLOT * 4); p.tok_slot = (int*)take(NL * 2 * 4);
    p.LRs = (float*)take((size_t)NT * 256 * 4); p.tile_e = (int*)take(128 * 4); p.WTd = (bf16_t*)take(2 * 1024 * 64 * 2); p.WTi = (bf16_t*)take(2 * 1024 * 64 * 2); p.WTg = (bf16_t*)take(1024 * 128 * 2);
    p.Wt_in0 = (bf16_t*)take((size_t)L0LD * DM * 2); p.Wt_out0 = (bf16_t*)take((size_t)DM * DM * 2); p.Wt_ffnup = (bf16_t*)take((size_t)2 * FFN * DM * 2);
    p.Wt_ffndn = (bf16_t*)take((size_t)DM * FFN * 2); p.Wt_in1 = (bf16_t*)take((size_t)L1LD * DM * 2); p.Wt_out1 = (bf16_t*)take((size_t)DM * DM * 2);
    p.Wt_expup = (bf16_t*)take((size_t)NEXP * 2 * EXD * DM * 2); p.Wt_expdn = (bf16_t*)take((size_t)NEXP * DM * EXD * 2);
    p.Hb = (bf16_t*)take((size_t)NT * DM * 2); p.MIXb = (bf16_t*)take((size_t)NT * DM * 2);
    p.XA = (float*)take((size_t)NT * DM * 4); p.XB = (float*)take((size_t)NT * DM * 4);
    p.P = (bf16_t*)take((size_t)NT * L0LD * 4); p.H1b = (bf16_t*)take((size_t)NT * FFN * 2);
    p.H1Eb = (bf16_t*)p.P;
    const size_t mark = o;
    p.PC = (float*)(w + mark);
    p.R = (bf16_t*)take((size_t)NT * 2048); p.V = (float*)take((size_t)NT * 4096); p.KK = (bf16_t*)take((size_t)NT * 2048); p.G = (float*)take((size_t)NT * 4096);
    for (int d = 0; d < 2; ++d) { p.W[d] = (float*)take((size_t)NT * 4096); p.KD[d] = (bf16_t*)take((size_t)NT * 2048); p.NB[d] = (bf16_t*)take((size_t)NT * 2048); p.Y[d] = (float*)take((size_t)NT * 4096); }
    p.Qb = (bf16_t*)take((size_t)NT * 2048); p.Kb = (bf16_t*)take((size_t)32 * 136 * 2048 * 2); p.VTl = (bf16_t*)take((size_t)32 * 136 * 2048 * 2); p.VTc = p.VTl; p.QM = (float*)take((size_t)NT * 16 * 4);
    const size_t end0 = o;
    o = mark;
    p.O[0] = (float*)take((size_t)NL * DM * 4); p.O[1] = (float*)take((size_t)NL * DM * 4);
    p.QT = (bf16_t*)take((size_t)16 * GLA_NCH * 64 * 256 * 2); p.KHT = (bf16_t*)take((size_t)16 * GLA_NCH * 256 * 64 * 2); p.AM = (bf16_t*)take((size_t)16 * GLA_NCH * 64 * 64 * 2);
    p.VT = (bf16_t*)take((size_t)16 * GLA_NCH * 512 * 64 * 2); p.DEC = (float*)take((size_t)16 * GLA_NCH * 256 * 4);
    const size_t end1a = o;
    o = mark;
    p.YE = (bf16_t*)take((size_t)MAXSLOT * DM * 2);
    p.Xp = (bf16_t*)take((size_t)MAXSLOT * DM * 2);
    p.YEP = (float*)take((size_t)256 * 65536 * 4);
    if (o < end1a) o = end1a;
    const size_t end1 = o;
    const size_t need = end0 > end1 ? end0 : end1;
    static int grid = 0;
    if (!grid) {
        int dev = 0, cus = 0, per_cu = 0;
        grid = -1;
        if (need <= ws_size && hipGetDevice(&dev) == hipSuccess && hipDeviceGetAttribute(&cus, hipDeviceAttributeMultiprocessorCount, dev) == hipSuccess &&
            hipFuncSetAttribute((const void*)k_all, hipFuncAttributeMaxDynamicSharedMemorySize, LDS_BYTES) == hipSuccess &&
            hipOccupancyMaxActiveBlocksPerMultiprocessor(&per_cu, (const void*)k_all, NTHR, LDS_BYTES) == hipSuccess && per_cu >= 1) grid = cus < 256 ? cus : 256;
    }
    if (grid < 0) return;
    (void)hipMemsetAsync(p.bar, 0, (size_t)((char*)(p.mod1 + 3 * MODW) - (char*)p.bar), stream);
    hipLaunchKernelGGL(k_all, dim3(grid), dim3(NTHR), LDS_BYTES, stream, p);
}
```

```cpp
#include <hip/hip_runtime.h>
#include <stdint.h>
#include <string.h>

#define DM 2048
#define NL 8192
#define NC 512
#define NT 8704
#define TL 4096
#define TC 256
#define MODW 12288
#define L0C 6528
#define L1C 6176
#define L0LD 6656
#define L1LD 6400
#define RWC 3456
#define FFN 5632
#define EXD 7168
#define NEXP 8
#define NTHR 512
#define MAXSLOT 18432
#define LDS_BYTES (131072 + 64 + 256)

typedef unsigned short bf16_t;
__device__ __forceinline__ int ptid() { int t = threadIdx.x; asm volatile("" : "+v"(t)); return t; }
#define XB_TMO      128
#define XB_XCNT(j)  (256  + 64 * (j))
#define XB_XSUB(j)  (1280 + 64 * (j))
#define XB_XGEN(j)  (2304 + 64 * (j))
#define XB_TOP      3328
#define XB_TOPGEN   3392
#define XCD_BAR_WORDS 3456
#define XB_SPIN_CAP (1u << 22)
#define LAS __attribute__((address_space(3)))
__device__ __forceinline__ unsigned xb_ld(unsigned* p)              { return __hip_atomic_load(p, __ATOMIC_RELAXED, __HIP_MEMORY_SCOPE_AGENT); }
__device__ __forceinline__ unsigned xb_add(unsigned* p, unsigned v) { return __hip_atomic_fetch_add(p, v, __ATOMIC_RELAXED, __HIP_MEMORY_SCOPE_AGENT); }
__device__ __forceinline__ unsigned xb_xcc_id() { return (unsigned)__builtin_amdgcn_s_getreg((3 << 11) | 20) & 0xFu; }
#define XB_SPIN(cond, bar) do { unsigned _sp = 0; while (cond) { __builtin_amdgcn_s_sleep(1); \
    if ((++_sp & 255u) == 0u) { if (xb_ld(&(bar)[XB_TMO])) break; if (_sp > XB_SPIN_CAP) { atomicAdd(&(bar)[XB_TMO], 1u); break; } } } } while (0)
struct XcdBarrier { unsigned* bar; unsigned x; volatile LAS unsigned* st; };
__device__ __forceinline__ XcdBarrier xcd_barrier_post(unsigned* bar, volatile LAS unsigned* st) {
    XcdBarrier b; b.bar = bar; b.x = xb_xcc_id(); b.st = st;
    if (threadIdx.x == 0) (void)xb_add(&bar[XB_XCNT(b.x)], 1u);
    return b;
}
__device__ __forceinline__ void xcd_barrier_complete(unsigned* bar, unsigned x, unsigned& nloc, unsigned& nx) {
    const unsigned G = gridDim.x * gridDim.y * gridDim.z;
    unsigned sum, cnt, mine, sp = 0u;
    for (;;) {
        sum = 0u; cnt = 0u; mine = 0u;
#pragma unroll
        for (unsigned j = 0; j < 16; ++j) { const unsigned c = xb_ld(&bar[XB_XCNT(j)]); sum += c; cnt += (c > 0u) ? 1u : 0u; mine = (j == x) ? c : mine; }
        if (sum == G) break;
        __builtin_amdgcn_s_sleep(1);
        if ((++sp & 255u) == 0u) { if (xb_ld(&bar[XB_TMO])) break; if (sp > XB_SPIN_CAP) { atomicAdd(&bar[XB_TMO], 1u); break; } }
    }
    nloc = mine > 0u ? mine : 1u; nx = cnt > 0u ? cnt : 1u;
}
__device__ __forceinline__ void xcd_barrier(const XcdBarrier& b) {
    asm volatile("s_waitcnt vmcnt(0)" ::: "memory");
    __syncthreads();
    if (threadIdx.x == 0) {
        unsigned* bar = b.bar;
        __builtin_amdgcn_s_waitcnt(0);
        unsigned nloc = b.st[0], nx = b.st[1];
        if (nloc == 0u) { xcd_barrier_complete(bar, b.x, nloc, nx); b.st[0] = nloc; b.st[1] = nx; }
        const unsigned old = xb_add(&bar[XB_XSUB(b.x)], 1u);
        const unsigned gen = old / nloc;
        if (old + 1u == (gen + 1u) * nloc) {
            __builtin_amdgcn_fence(__ATOMIC_RELEASE, "agent");
            asm volatile("s_waitcnt vmcnt(0)" ::: "memory");
            const unsigned og = xb_add(&bar[XB_TOP], 1u);
            const unsigned tg = og / nx;
            if (og + 1u == (tg + 1u) * nx) xb_add(&bar[XB_TOPGEN], 1u);
            else XB_SPIN(xb_ld(&bar[XB_TOPGEN]) == tg, bar);
            __builtin_amdgcn_fence(__ATOMIC_ACQUIRE, "agent");
            xb_add(&bar[XB_XGEN(b.x)], 1u);
            asm volatile("s_waitcnt vmcnt(0)" ::: "memory");
        } else {
            XB_SPIN(xb_ld(&bar[XB_XGEN(b.x)]) == gen, bar);
            __builtin_amdgcn_fence(__ATOMIC_ACQUIRE, "agent");
            asm volatile("s_waitcnt vmcnt(0)" ::: "memory");
        }
    }
    __syncthreads();
}


namespace pg8 {
#define PG8_LAS __attribute__((address_space(3)))
typedef short bf16x8 __attribute__((ext_vector_type(8)));
typedef float f32x4 __attribute__((ext_vector_type(4)));
typedef unsigned u32x4 __attribute__((ext_vector_type(4)));
constexpr int BM = 256, BK = 64, HALF = 128, HTB = HALF * BK * 2, STAGE_BYTES = 8 * HTB, NXCD = 8, WGM = 8;
__host__ __device__ __forceinline__ int lds_byte(int r, int c) { const int st = (r >> 4) * 2 + (c >> 5), rr = r & 15, cc = c & 31, ob = rr * 64 + cc * 2; return st * 1024 + (ob ^ (((ob >> 9) & 1) << 5)); }
__host__ __device__ __forceinline__ void stage_rc(int b, int& R, int& C) { const int st = b / 1024, sb = b % 1024, swz = sb ^ (((sb >> 9) & 1) << 5); R = (st >> 1) * 16 + swz / 64; C = (st & 1) * 32 + (swz % 64) / 2; }
__host__ __device__ __forceinline__ int perm32(int rho) { const int n = rho >> 4, i = rho & 15; return 8 * (i >> 2) + 4 * n + (i & 3); }
struct Unit { int pm, pn, k0; };
struct Gemm { const bf16_t* A; const bf16_t* Bt; int K; int ld; };
struct StaticOrder {
    int nM, nN, nwg, G, c;
    __device__ void init(int M, int N, int G_, int c_) { nM = M / BM; nN = N / BM; nwg = nM * nN; G = G_; c = c_; }
    __device__ bool next(int i, Unit& u) const {
        const long L = (long)i * G + c; if (L >= nwg) return false;
        int wgid = (int)L; { const int q = nwg / NXCD, r = nwg % NXCD, xcd = wgid % NXCD, off = wgid / NXCD; wgid = (xcd < r ? xcd * (q + 1) : r * (q + 1) + (xcd - r) * q) + off; }
        const int nig = WGM * nN, gid = wgid / nig, fm = gid * WGM, gsz = (nM - fm) < WGM ? (nM - fm) : WGM;
        u.pm = fm + ((wgid % nig) % gsz); u.pn = (wgid % nig) / gsz; u.k0 = 0; return true;
    }
    __device__ __forceinline__ void a_ready(const Unit&) const {}
    __device__ __forceinline__ void done(const Unit&) const {}
};
struct CtxSplitOrder {
    int nN, KS, ksub, G, c;
    __device__ bool next(int i, Unit& u) const {
        const long L = (long)i * G + c; if (L >= (long)2 * nN * KS) return false;
        const int l = (int)L; u.pm = 32 + (l & 1); u.pn = (l >> 1) % nN; u.k0 = ((l >> 1) / nN) * ksub; return true;
    }
    __device__ __forceinline__ void a_ready(const Unit&) const {}
    __device__ __forceinline__ void done(const Unit&) const {}
};
struct GroupedRange {
    int ntm, nN, lo, hi, G, c; const int* tile_e;
    __device__ bool next(int i, Unit& u) const {
        const long L0 = (long)i * G + c; const int n = hi - lo; if (L0 >= n) return false;
        int e = (int)L0; { const int q = n / NXCD, r = n % NXCD, xcd = e % NXCD, off = e / NXCD; e = (xcd < r ? xcd * (q + 1) : r * (q + 1) + (xcd - r) * q) + off; }
        const int L = lo + e; const int pm = L % ntm, pn = L / ntm;
        u.pm = pm; u.pn = tile_e[pm] * nN + pn; u.k0 = 0; return true;
    }
    __device__ __forceinline__ void a_ready(const Unit&) const {}
    __device__ __forceinline__ void done(const Unit&) const {}
};
struct GroupedTail {
    int ntm, nN, lo, ntail, KS, ksub, G, c; const int* tile_e;
    __device__ bool next(int i, Unit& u) const {
        const long J = (long)i * G + c; if (J >= (long)ntail * KS) return false;
        const int t = (int)(J % ntail), ks = (int)(J / ntail); const int L = lo + t;
        const int pm = L % ntm, pn = L / ntm;
        u.pm = pm; u.pn = tile_e[pm] * nN + pn; u.k0 = ks * ksub; return true;
    }
    __device__ __forceinline__ void a_ready(const Unit&) const {}
    __device__ __forceinline__ void done(const Unit&) const {}
};
struct GroupedOrder {
    int ntm, nN, G, c; const int* tile_e;
    __device__ bool next(int i, Unit& u) const {
        const int nwg = ntm * nN; const long L = (long)i * G + c; if (L >= nwg) return false;
        int wgid = (int)L; { const int q = nwg / NXCD, r = nwg % NXCD, xcd = wgid % NXCD, off = wgid / NXCD; wgid = (xcd < r ? xcd * (q + 1) : r * (q + 1) + (xcd - r) * q) + off; }
        const int nig = WGM * nN, gid = wgid / nig, fm = gid * WGM, gsz = (ntm - fm) < WGM ? (ntm - fm) : WGM;
        const int pm = fm + ((wgid % nig) % gsz), pn = (wgid % nig) / gsz;
        u.pm = pm; u.pn = tile_e[pm] * nN + pn; u.k0 = 0; return true;
    }
    __device__ __forceinline__ void a_ready(const Unit&) const {}
    __device__ __forceinline__ void done(const Unit&) const {}
};
template <class Epi, class Sched, bool ALIGN_EPI = false, bool SP2 = false>
__device__ __forceinline__ void gemm_phase(PG8_LAS unsigned char* lds, const Gemm g, const Sched& S, const Epi& E) {
    const int tid = ptid(), wid = __builtin_amdgcn_readfirstlane(tid >> 6), lane = tid & 63, wr = wid >> 2, wc = wid & 3, fr = lane & 15, fq = lane >> 4;
    const int K = g.K, nt = K / BK, LD = g.ld;
    unsigned voffA[2], voffB[2];
#pragma unroll
    for (int i = 0; i < 2; ++i) { int R, C; stage_rc(tid * 16 + i * 8192, R, C); const int Rb = Epi::PERM ? ((R & ~31) + perm32(R & 31)) : R;
        voffA[i] = (unsigned)(R * LD + C) * 2u; voffB[i] = (unsigned)(Rb * LD + C) * 2u; }
    const size_t kstep = (size_t)(BK * 2);
    const size_t hstep = (size_t)HALF * LD * 2;
    const size_t tstep = 2 * hstep;
    const unsigned ldsw = (unsigned)wid * 1024u;
    const int aoff = lds_byte(wr * 64 + fr, fq * 8), boff = lds_byte(wc * 32 + fr, fq * 8);
#define PG8_SA(b, h) (((b) * 2 + (h)) * HTB)
#define PG8_SB(b, h) ((4 + (b) * 2 + (h)) * HTB)
#define PG8_STAGE(bufoff, gbase, voff) do { _Pragma("unroll") for (int _i = 0; _i < 2; ++_i) \
        __builtin_amdgcn_global_load_lds((const unsigned*)((const char*)(gbase) + (voff)[_i]), (PG8_LAS unsigned*)(lds + (bufoff) + ldsw + _i * 8192), 16, 0, 0); } while (0)
#define PG8_LDA(dst, b, h) do { _Pragma("unroll") for (int m = 0; m < 4; ++m) _Pragma("unroll") for (int k = 0; k < 2; ++k) dst[m][k] = *(const PG8_LAS bf16x8*)(lds + PG8_SA(b, h) + aoff + m * 2048 + k * 1024); } while (0)
#define PG8_LDB(dst, b, h) do { _Pragma("unroll") for (int n = 0; n < 2; ++n) _Pragma("unroll") for (int k = 0; k < 2; ++k) dst[n][k] = *(const PG8_LAS bf16x8*)(lds + PG8_SB(b, h) + boff + n * 2048 + k * 1024); } while (0)
#define PG8_MMA(ai, bj, At, Bt) do { __builtin_amdgcn_s_setprio(1); _Pragma("unroll") for (int m = 0; m < 4; ++m) _Pragma("unroll") for (int n = 0; n < 2; ++n) _Pragma("unroll") for (int k = 0; k < 2; ++k) \
        acc[ai][bj][m][n] = __builtin_amdgcn_mfma_f32_16x16x32_bf16(Bt[n][k], At[m][k], acc[ai][bj][m][n], 0, 0, 0); __builtin_amdgcn_s_setprio(0); } while (0)
#define PG8_WAIT_V(n) asm volatile("s_waitcnt vmcnt(" #n ")" ::: "memory")
#define PG8_WAIT_L(n) asm volatile("s_waitcnt lgkmcnt(" #n ")" ::: "memory")
#define PG8_BAR __builtin_amdgcn_s_barrier()
#define PG8_SCHED __builtin_amdgcn_sched_barrier(0)
    Unit cur, nxt; int ui = 0;
    if (!S.next(0, cur)) return;
    f32x4 acc[2][2][4][2];
#pragma unroll
    for (int a = 0; a < 2; ++a)
#pragma unroll
        for (int b = 0; b < 2; ++b)
#pragma unroll
            for (int m = 0; m < 4; ++m)
#pragma unroll
                for (int n = 0; n < 2; ++n) acc[a][b][m][n] = (f32x4){0.f, 0.f, 0.f, 0.f};
    bf16x8 At[4][2], B0[2][2], B1[2][2];
    const char* cA = (const char*)g.A + (size_t)cur.pm * tstep + (size_t)cur.k0 * 2; const char* cB = (const char*)g.Bt + (size_t)cur.pn * tstep + (size_t)cur.k0 * 2;
    S.a_ready(cur);
    if constexpr (SP2) {
        PG8_STAGE(PG8_SB(0, 0), cB, voffB); PG8_STAGE(PG8_SB(0, 1), cB + hstep, voffB); PG8_STAGE(PG8_SA(0, 0), cA, voffA); PG8_STAGE(PG8_SA(0, 1), cA + hstep, voffA);
        if (wr == 1) PG8_BAR;
        PG8_WAIT_V(2); PG8_BAR;
        PG8_STAGE(PG8_SB(1, 0), cB + kstep, voffB); PG8_STAGE(PG8_SA(1, 0), cA + kstep, voffA); PG8_STAGE(PG8_SB(1, 1), cB + hstep + kstep, voffB);
        PG8_WAIT_V(6); PG8_BAR;
    } else {
        PG8_STAGE(PG8_SB(0, 0), cB, voffB); PG8_STAGE(PG8_SA(0, 0), cA, voffA); PG8_STAGE(PG8_SB(0, 1), cB + hstep, voffB); PG8_STAGE(PG8_SA(0, 1), cA + hstep, voffA);
        if (wr == 1) PG8_BAR;
        PG8_WAIT_V(4); PG8_BAR;
        PG8_STAGE(PG8_SB(1, 0), cB + kstep, voffB); PG8_STAGE(PG8_SA(1, 0), cA + kstep, voffA); PG8_STAGE(PG8_SB(1, 1), cB + hstep + kstep, voffB);
        PG8_WAIT_V(6); PG8_BAR;
    }
    for (;;) {
        const bool has_next = S.next(ui + 1, nxt);
        const char* nA = has_next ? (const char*)g.A + (size_t)nxt.pm * tstep + (size_t)nxt.k0 * 2 : cA; const char* nB = has_next ? (const char*)g.Bt + (size_t)nxt.pn * tstep + (size_t)nxt.k0 * 2 : cB;
        for (int t = 0; t < nt; t += 2) {
            const bool last = (t == nt - 2);
            const char* a1 = cA + (size_t)(t + 1) * kstep;
            const char* a2 = last ? nA : cA + (size_t)(t + 2) * kstep; const char* b2 = last ? nB : cB + (size_t)(t + 2) * kstep;
            const char* a3 = a2 + kstep; const char* b3 = b2 + kstep;
            if (last && has_next) S.a_ready(nxt);
            if constexpr (SP2) {
            PG8_LDB(B0, 0, 0); PG8_LDB(B1, 0, 1); PG8_SCHED; PG8_LDA(At, 0, 0); PG8_STAGE(PG8_SA(1, 1), a1 + hstep, voffA);
            PG8_WAIT_V(8); PG8_WAIT_L(0); PG8_BAR; PG8_MMA(0, 0, At, B0); PG8_MMA(0, 1, At, B1); PG8_BAR; PG8_SCHED;
            PG8_LDA(At, 0, 1); PG8_STAGE(PG8_SB(0, 0), b2, voffB); PG8_STAGE(PG8_SB(0, 1), b2 + hstep, voffB); PG8_STAGE(PG8_SA(0, 0), a2, voffA);
            PG8_WAIT_V(8); PG8_WAIT_L(0); PG8_BAR; PG8_MMA(1, 0, At, B0); PG8_MMA(1, 1, At, B1); PG8_BAR; PG8_SCHED;
            PG8_LDB(B0, 1, 0); PG8_LDB(B1, 1, 1); PG8_SCHED; PG8_LDA(At, 1, 0); PG8_STAGE(PG8_SA(0, 1), a2 + hstep, voffA);
            PG8_WAIT_V(8); PG8_WAIT_L(0); PG8_BAR; PG8_MMA(0, 0, At, B0); PG8_MMA(0, 1, At, B1); PG8_BAR; PG8_SCHED;
            PG8_LDA(At, 1, 1); PG8_STAGE(PG8_SB(1, 0), b3, voffB); PG8_STAGE(PG8_SB(1, 1), b3 + hstep, voffB); PG8_STAGE(PG8_SA(1, 0), a3, voffA);
            PG8_WAIT_V(8); PG8_WAIT_L(0); PG8_BAR; PG8_MMA(1, 0, At, B0); PG8_MMA(1, 1, At, B1); PG8_BAR; PG8_SCHED;
            } else {
            PG8_LDB(B0, 0, 0); PG8_SCHED; PG8_LDA(At, 0, 0); PG8_STAGE(PG8_SA(1, 1), a1 + hstep, voffA);
            PG8_WAIT_L(8); PG8_BAR; PG8_WAIT_L(0); PG8_MMA(0, 0, At, B0); PG8_BAR; PG8_SCHED;
            PG8_LDB(B1, 0, 1); PG8_STAGE(PG8_SB(0, 0), b2, voffB);
            PG8_BAR; PG8_WAIT_L(0); PG8_MMA(0, 1, At, B1); PG8_BAR;
            PG8_LDA(At, 0, 1); PG8_STAGE(PG8_SA(0, 0), a2, voffA);
            PG8_BAR; PG8_WAIT_L(0); PG8_MMA(1, 0, At, B0); PG8_BAR; PG8_SCHED;
            PG8_STAGE(PG8_SB(0, 1), b2 + hstep, voffB);
            PG8_WAIT_V(6); PG8_BAR; PG8_MMA(1, 1, At, B1); PG8_BAR;
            PG8_LDB(B0, 1, 0); PG8_SCHED; PG8_LDA(At, 1, 0); PG8_STAGE(PG8_SA(0, 1), a2 + hstep, voffA);
            PG8_WAIT_L(8); PG8_BAR; PG8_WAIT_L(0); PG8_MMA(0, 0, At, B0); PG8_BAR; PG8_SCHED;
            PG8_LDB(B1, 1, 1); PG8_STAGE(PG8_SB(1, 0), b3, voffB);
            PG8_BAR; PG8_WAIT_L(0); PG8_MMA(0, 1, At, B1); PG8_BAR;
            PG8_LDA(At, 1, 1); PG8_STAGE(PG8_SA(1, 0), a3, voffA);
            PG8_BAR; PG8_WAIT_L(0); PG8_MMA(1, 0, At, B0); PG8_BAR; PG8_SCHED;
            PG8_STAGE(PG8_SB(1, 1), b3 + hstep, voffB);
            PG8_WAIT_V(6); PG8_BAR; PG8_MMA(1, 1, At, B1); PG8_BAR;
            }
        }
        if constexpr (ALIGN_EPI) { if (wr == 0) PG8_BAR; }
        if constexpr (!Epi::AFTER_DRAIN) { E(acc, cur, wr, wc, fr, fq); S.done(cur); }
        if (!has_next) break;
#pragma unroll
        for (int a = 0; a < 2; ++a)
#pragma unroll
            for (int b = 0; b < 2; ++b)
#pragma unroll
                for (int m = 0; m < 4; ++m)
#pragma unroll
                    for (int n = 0; n < 2; ++n) acc[a][b][m][n] = (f32x4){0.f, 0.f, 0.f, 0.f};
        cur = nxt; cA = nA; cB = nB; ++ui;
        if constexpr (ALIGN_EPI) { if (wr == 1) PG8_BAR; }
    }
    PG8_WAIT_V(0);
    if constexpr (!ALIGN_EPI) { if (wr == 0) PG8_BAR; }
    PG8_BAR;
    if constexpr (Epi::AFTER_DRAIN) { E.fused(acc, cur, wr, wc, fr, fq, lds, wid, lane); S.done(cur); }
#undef PG8_SA
#undef PG8_SB
#undef PG8_STAGE
#undef PG8_LDA
#undef PG8_LDB
#undef PG8_MMA
#undef PG8_WAIT_V
#undef PG8_WAIT_L
#undef PG8_BAR
#undef PG8_SCHED
}

}

struct Params {
    const float* in[40];
    float* out;
    unsigned* bar;
    float* mod0; float* mod1;
    bf16_t* Hb; bf16_t* MIXb; bf16_t* H1b; bf16_t* Xp; bf16_t* H1Eb;
    bf16_t* Wt_in0; bf16_t* Wt_out0; bf16_t* Wt_ffnup; bf16_t* Wt_ffndn; bf16_t* Wt_in1; bf16_t* Wt_out1; bf16_t* Wt_expup; bf16_t* Wt_expdn;
    bf16_t* P; float* LRs;
    bf16_t* R; float* V; bf16_t* KK; float* G; float* W[2]; bf16_t* KD[2]; bf16_t* NB[2];
    float* Y[2];
    bf16_t* Qb; bf16_t* Kb; bf16_t* VTl; bf16_t* VTc; float* QM; float* XA; float* XB;
    float* O[2]; bf16_t* QT; bf16_t* KHT; bf16_t* AM; bf16_t* VT; float* DEC;
    int* tok_e; float* tok_w; int* meta; int* slot_token; int* tok_slot; int* tile_e;
    bf16_t* YE; float* YEP; float* PC; bf16_t* WTd; bf16_t* WTi; bf16_t* WTg;
};

__device__ __forceinline__ void lds_barrier() { asm volatile("s_waitcnt lgkmcnt(0)" ::: "memory"); __builtin_amdgcn_s_barrier(); asm volatile("" ::: "memory"); }
__device__ __forceinline__ float bf2f(bf16_t b) { return __uint_as_float(((unsigned)b) << 16); }
typedef float f32x2_t __attribute__((ext_vector_type(2)));
typedef __bf16 bf16x2_t __attribute__((ext_vector_type(2)));
__device__ __forceinline__ unsigned cvt_pk_bf16(float lo, float hi) { const f32x2_t v = {lo, hi}; return __builtin_bit_cast(unsigned, __builtin_convertvector(v, bf16x2_t)); }
__device__ __forceinline__ bf16_t f2bf(float f) { return (bf16_t)(cvt_pk_bf16(f, 0.f) & 0xffffu); }
__device__ __forceinline__ float sigm(float x) { return __builtin_amdgcn_rcpf(1.f + __expf(-x)); }
__device__ __forceinline__ float siluf(float x) { return x * __builtin_amdgcn_rcpf(1.f + __expf(-x)); }
__device__ __forceinline__ float silu_fast(float x) { return x * __builtin_amdgcn_rcpf(1.f + __expf(-x)); }
__device__ __forceinline__ float softplusf(float x) { return x > 20.f ? x : __logf(1.f + __expf(x)); }
__device__ __forceinline__ int rowgrp(int row) { return row < NL ? row / TL : 2; }
__device__ __forceinline__ float dpp_add16(float x) {
    x += __builtin_bit_cast(float, __builtin_amdgcn_update_dpp(0, __builtin_bit_cast(int, x), 0xB1, 0xF, 0xF, true));
    x += __builtin_bit_cast(float, __builtin_amdgcn_update_dpp(0, __builtin_bit_cast(int, x), 0x4E, 0xF, 0xF, true));
    x += __builtin_bit_cast(float, __builtin_amdgcn_update_dpp(0, __builtin_bit_cast(int, x), 0x141, 0xF, 0xF, true));
    x += __builtin_bit_cast(float, __builtin_amdgcn_update_dpp(0, __builtin_bit_cast(int, x), 0x140, 0xF, 0xF, true));
    return x;
}
__device__ __forceinline__ float wave_sum(float v) {
    v = dpp_add16(v);
    v += __shfl_xor(v, 16); v += __shfl_xor(v, 32);
    return v;
}
__device__ __forceinline__ float wave_max(float v) {
#pragma unroll
    for (int o = 32; o >= 1; o >>= 1) v = fmaxf(v, __shfl_xor(v, o));
    return v;
}
__device__ __forceinline__ float block_sum(float v, float* red) {
    v = wave_sum(v);
    __syncthreads();
    const int bt_ = ptid();
    if ((bt_ & 63) == 0) red[bt_ >> 6] = v;
    __syncthreads();
    float s = 0.f;
#pragma unroll
    for (int i = 0; i < 8; ++i) s += red[i];
    return s;
}

__device__ __forceinline__ void conv_T(const float* W0, const float* W1, int K, int N, int Nt, int mode, bf16_t* Bt, float* ldsf, int wg, int nwg) {
    bf16_t (*T)[66] = (bf16_t (*)[66])ldsf;
    const int tid = ptid();
    const int tn = Nt / 64, tk = K / 64;
    for (int tile = wg; tile < tn * tk; tile += nwg) {
        const int n0 = (tile % tn) * 64, k0 = (tile / tn) * 64;
        const float* src = W0; int col0 = n0;
        if (mode == 1) { const int t = n0 >> 8, h = (n0 >> 7) & 1, j0 = n0 & 127; src = h ? W1 : W0; col0 = t * 128 + j0; }
        const int kk = tid >> 4, c4 = (tid & 15) * 4;
#pragma unroll
        for (int r = 0; r < 2; ++r) {
            const int k = kk + 32 * r;
            float4 v = make_float4(0.f, 0.f, 0.f, 0.f);
            if (col0 + c4 < N) v = *(const float4*)(src + (size_t)(k0 + k) * N + col0 + c4);
            T[c4 + 0][k] = f2bf(v.x); T[c4 + 1][k] = f2bf(v.y); T[c4 + 2][k] = f2bf(v.z); T[c4 + 3][k] = f2bf(v.w);
        }
        __syncthreads();
        {
            const int n = tid >> 3, k8 = (tid & 7) * 8;
            const unsigned* tp = (const unsigned*)&T[n][k8];
            uint4 o; o.x = tp[0]; o.y = tp[1]; o.z = tp[2]; o.w = tp[3];
            *(uint4*)(Bt + (size_t)(n0 + n) * K + k0 + k8) = o;
        }
        __syncthreads();
    }
}
#define CT_L0A 6656
#define CT_L0B (CT_L0A + 2048)
#define CT_L0C (CT_L0B + 11264)
#define CT_L0 (CT_L0C + 5632)
#define CT_A (CT_L0 + 6400)
#define CT_B (CT_A + 2048)
#define CT_C (CT_B + 8 * 14336)
#define CT_TOTAL (CT_C + 8 * 7168)
#define CT_LDS_BYTES 5120
struct ConvTile { const float* src; bf16_t* dst; int N; int K; int nvalid; };
#define CTTAB_OFF (131072 + 64)
__device__ __forceinline__ void ct_table_init(const Params& p, unsigned long long* tab) {
    tab[0] = (unsigned long long)p.in[8]; tab[1] = (unsigned long long)p.in[23]; tab[2] = (unsigned long long)p.in[24]; tab[3] = (unsigned long long)p.in[25]; tab[4] = (unsigned long long)p.in[26];
    tab[5] = (unsigned long long)p.in[31]; tab[6] = (unsigned long long)p.in[35]; tab[7] = (unsigned long long)p.in[37]; tab[8] = (unsigned long long)p.in[38]; tab[9] = (unsigned long long)p.in[39];
    tab[10] = (unsigned long long)p.Wt_in0; tab[11] = (unsigned long long)p.Wt_out0; tab[12] = (unsigned long long)p.Wt_ffnup; tab[13] = (unsigned long long)p.Wt_ffndn;
    tab[14] = (unsigned long long)p.Wt_in1; tab[15] = (unsigned long long)p.Wt_out1; tab[16] = (unsigned long long)p.Wt_expup; tab[17] = (unsigned long long)p.Wt_expdn;
}
__device__ __forceinline__ ConvTile conv_tile_desc(const unsigned long long* tab, int t) {
    int si, di, N, K, nb, kb, e = 0, mode = 0, npad = 0;
    if (t < CT_L0A) { si = 0; di = 10; N = L0C; K = DM; nb = t % 104; kb = t / 104; npad = 1; }
    else if (t < CT_L0B) { const int u = t - CT_L0A; si = 1; di = 11; N = DM; K = DM; nb = u & 31; kb = u >> 5; }
    else if (t < CT_L0C) { const int u = t - CT_L0B; si = 2; di = 12; N = FFN; K = DM; nb = u % 176; kb = u / 176; mode = 1; }
    else if (t < CT_L0) { const int u = t - CT_L0C; si = 4; di = 13; N = DM; K = FFN; nb = u & 31; kb = u >> 5; }
    else if (t < CT_A) { const int u = t - CT_L0; si = 5; di = 14; N = L1C; K = DM; nb = u % 100; kb = u / 100; npad = 1; }
    else if (t < CT_B) { const int u = t - CT_A; si = 6; di = 15; N = DM; K = DM; nb = u & 31; kb = u >> 5; }
    else if (t < CT_C) { const int u = t - CT_B; e = u / 14336; const int v = u % 14336; si = 7; di = 16; N = EXD; K = DM; nb = v % 224; kb = v / 224; mode = 1; }
    else { const int u = (t < CT_TOTAL ? t : CT_TOTAL - 1) - CT_C; e = u / 7168; const int v = u % 7168; si = 9; di = 17; N = DM; K = EXD; nb = v & 31; kb = v >> 5; }
    const int n0 = nb * 64;
    int col0 = n0, nvalid = 64;
    if (mode) { col0 = (n0 >> 8) * 128 + (n0 & 127); si += (n0 >> 7) & 1; }
    if (npad) { nvalid = N - n0; if (nvalid <= 0) col0 = 0; }
    ConvTile c;
    const size_t KN = (size_t)K * N;
    c.src = (const float*)tab[si] + (size_t)e * KN + (size_t)(kb * 32) * N + col0;
    c.dst = (bf16_t*)tab[di] + (size_t)e * (mode ? 2 * KN : KN) + (size_t)n0 * K + kb * 32;
    c.N = N; c.K = K; c.nvalid = nvalid;
    return c;
}
#define CT_FORQ(X) X(0) X(1) X(2) X(3) X(4) X(5) X(6) X(7)
#define CT_LOAD1(q) cv##q = *(const float4*)(ct_.src + (size_t)(ckq_ * 8 + (q)) * ct_.N + ccol_);
#define CT_LOAD(T_) do { const int tt_ = (T_) < CT_TOTAL ? (T_) : CT_TOTAL - 1; const ConvTile ct_ = conv_tile_desc(cttab, tt_); const int ckq_ = lane >> 4, ccol_ = ((lane & 15) * 4 < ct_.nvalid) ? (lane & 15) * 4 : 0; CT_FORQ(CT_LOAD1) } while (0)
#define CT_ATOM(e, C) { uint4 a_; a_.x = cvt_pk_bf16(cv0.C, cv1.C); a_.y = cvt_pk_bf16(cv2.C, cv3.C); a_.z = cvt_pk_bf16(cv4.C, cv5.C); a_.w = cvt_pk_bf16(cv6.C, cv7.C); \
    if (!cok_) a_ = make_uint4(0u, 0u, 0u, 0u); *(uint4*)(cdst_ + (size_t)(e) * ct_.K) = a_; }
#define CT_STORE(T_, LDSW_) do { const int tt_ = (T_) < CT_TOTAL ? (T_) : CT_TOTAL - 1; const ConvTile ct_ = conv_tile_desc(cttab, tt_); const bool cok_ = (lane & 15) * 4 < ct_.nvalid; \
    bf16_t* cdst_ = ct_.dst + (size_t)((lane & 15) * 4) * ct_.K + (lane >> 4) * 8; CT_ATOM(0, x) CT_ATOM(1, y) CT_ATOM(2, z) CT_ATOM(3, w) } while (0)
__device__ __forceinline__ void ph_convert(const Params& p, float* lds, int wg, int nwg, int ct_end) {
    const int tid = ptid(), wave = __builtin_amdgcn_readfirstlane(tid >> 6), lane = tid & 63;
    const unsigned long long* cttab = (const unsigned long long*)((const char*)lds + CTTAB_OFF);
    float4 cv0, cv1, cv2, cv3, cv4, cv5, cv6, cv7;
    for (int t = wg * 8 + wave; t < ct_end; t += nwg * 8) { CT_LOAD(t); CT_STORE(t, 0); }
}

__device__ __forceinline__ void ph_mod(const Params& p, float* lds, int wg, int nwg) {
    float* cs = lds;
    float* red = lds + 3 * DM;
    const int tid = ptid(), wave = tid >> 6, lane = tid & 63;
    if (wg >= 4 * (MODW / 256)) return;
    for (int i = tid; i < 3 * DM; i += NTHR) {
        const int r = i / DM, k = i % DM;
        const float c = r < 2 ? p.in[1][r * DM + k] : p.in[3][k];
        cs[i] = siluf(c);
    }
    __syncthreads();
    for (int item = wg; item < 4 * (MODW / 256); item += nwg) {
        const int kh = item & 1, it2 = item >> 1, layer = it2 / (MODW / 256), cb = (it2 % (MODW / 256)) * 256;
        const float* w = (layer ? p.in[27] : p.in[4]) + cb + lane * 4;
        const float* b = layer ? p.in[28] : p.in[5];
        float* out = layer ? p.mod1 : p.mod0;
        float a0[4] = {0.f, 0.f, 0.f, 0.f}, a1[4] = {0.f, 0.f, 0.f, 0.f}, a2[4] = {0.f, 0.f, 0.f, 0.f};
        const int kbeg = kh * 1024 + wave * 128;
#pragma unroll 8
        for (int k = kbeg; k < kbeg + 128; ++k) {
            const float4 wv = *(const float4*)(w + (size_t)k * MODW);
            const float c0 = cs[k], c1 = cs[DM + k], c2 = cs[2 * DM + k];
            a0[0] += c0 * wv.x; a0[1] += c0 * wv.y; a0[2] += c0 * wv.z; a0[3] += c0 * wv.w;
            a1[0] += c1 * wv.x; a1[1] += c1 * wv.y; a1[2] += c1 * wv.z; a1[3] += c1 * wv.w;
            a2[0] += c2 * wv.x; a2[1] += c2 * wv.y; a2[2] += c2 * wv.z; a2[3] += c2 * wv.w;
        }
        *(float4*)(red + (wave * 3 + 0) * 256 + lane * 4) = make_float4(a0[0], a0[1], a0[2], a0[3]);
        *(float4*)(red + (wave * 3 + 1) * 256 + lane * 4) = make_float4(a1[0], a1[1], a1[2], a1[3]);
        *(float4*)(red + (wave * 3 + 2) * 256 + lane * 4) = make_float4(a2[0], a2[1], a2[2], a2[3]);
        __syncthreads();
        for (int q = tid; q < 768; q += NTHR) {
            const int r = q >> 8, c = q & 255;
            float sum = kh ? 0.f : b[cb + c];
#pragma unroll
            for (int w8 = 0; w8 < 8; ++w8) sum += red[(w8 * 3 + r) * 256 + c];
            unsafeAtomicAdd(out + r * MODW + cb + c, sum);
        }
        __syncthreads();
    }
}

__device__ __forceinline__ void ph_norm(const float* src_lat, const float* src_ctx, const float* gain, const float* mod, int shift_idx, int scale_idx,
                        bf16_t* out, int nrows, float* lds, int wg, int nwg,
                        const float* part = nullptr, int nparts = 0, const float* pgate = nullptr, float* wb = nullptr) {
    (void)lds;
    const int tid = ptid(), wave = tid >> 6, lane = tid & 63;
    for (int row = wg * 8 + wave; row < nrows; row += nwg * 8) {
        const float4* x = (const float4*)(row < NL ? src_lat + (size_t)row * DM : src_ctx + (size_t)(row - NL) * DM);
        float4 v[8];
#pragma unroll
        for (int q = 0; q < 8; ++q) v[q] = x[lane + 64 * q];
        if (part != nullptr && row >= NL) {
#pragma unroll
            for (int q = 0; q < 8; ++q) {
                float4 a = make_float4(0.f, 0.f, 0.f, 0.f);
                for (int sidx = 0; sidx < nparts; ++sidx) { const float4 t = ((const float4*)(part + ((size_t)sidx * NC + (row - NL)) * DM))[lane + 64 * q]; a.x += t.x; a.y += t.y; a.z += t.z; a.w += t.w; }
                const float4 g4 = ((const float4*)pgate)[lane + 64 * q];
                v[q].x += g4.x * a.x; v[q].y += g4.y * a.y; v[q].z += g4.z * a.z; v[q].w += g4.w * a.w;
                if (wb) ((float4*)(wb + (size_t)row * DM))[lane + 64 * q] = v[q];
            }
        }
        float ss = 0.f;
#pragma unroll
        for (int q = 0; q < 8; ++q) ss += v[q].x * v[q].x + v[q].y * v[q].y + v[q].z * v[q].z + v[q].w * v[q].w;
        ss = wave_sum(ss);
        const float rs = rsqrtf(ss * (1.f / DM) + 1e-6f);
        const int g = rowgrp(row);
#pragma unroll
        for (int q = 0; q < 8; ++q) {
            const float4 gn = ((const float4*)gain)[lane + 64 * q];
            const float4 sh = ((const float4*)(mod + g * MODW + shift_idx * DM))[lane + 64 * q];
            const float4 sc = ((const float4*)(mod + g * MODW + scale_idx * DM))[lane + 64 * q];
            uint2 o;
            o.x = cvt_pk_bf16(v[q].x * rs * gn.x * (1.f + sc.x) + sh.x, v[q].y * rs * gn.y * (1.f + sc.y) + sh.y);
            o.y = cvt_pk_bf16(v[q].z * rs * gn.z * (1.f + sc.z) + sh.z, v[q].w * rs * gn.w * (1.f + sc.w) + sh.w);
            ((uint2*)(out + (size_t)row * DM))[lane + 64 * q] = o;
        }
    }
}

struct EpiF32Store {
    static constexpr bool PERM = false, AFTER_DRAIN = false;
    float* C; int ldc; int nn;
    __device__ __forceinline__ void operator()(const pg8::f32x4 (&acc)[2][2][4][2], const pg8::Unit& u, int wr, int wc, int fr, int fq) const {
        const int row0 = u.pm * 256 + wr * 64 + fr, pnl = nn ? u.pn % nn : u.pn, col0 = pnl * 256 + wc * 32 + 4 * fq;
#pragma unroll
        for (int ai = 0; ai < 2; ++ai)
#pragma unroll
            for (int m = 0; m < 4; ++m) { float* rowp = C + (size_t)(row0 + ai * 128 + m * 16) * ldc + col0;
#pragma unroll
                for (int bj = 0; bj < 2; ++bj)
#pragma unroll
                    for (int n = 0; n < 2; ++n) *(pg8::f32x4*)(rowp + bj * 128 + n * 16) = acc[ai][bj][m][n]; }
    }
};
struct EpiResGate {
    static constexpr bool PERM = false, AFTER_DRAIN = false;
    const float* res_lat; const float* res_ctx; const float* gate; float* C;
    __device__ __forceinline__ void operator()(const pg8::f32x4 (&acc)[2][2][4][2], const pg8::Unit& u, int wr, int wc, int fr, int fq) const {
        const int row0 = u.pm * 256 + wr * 64 + fr, col0 = u.pn * 256 + wc * 32 + 4 * fq;
#pragma unroll
        for (int ai = 0; ai < 2; ++ai)
#pragma unroll
            for (int m = 0; m < 4; ++m) { const int row = row0 + ai * 128 + m * 16;
                const float* rp = (row < NL ? res_lat + (size_t)row * DM : res_ctx + (size_t)(row - NL) * DM) + col0;
                const float* gp = gate + rowgrp(row) * MODW + col0;
                float* cp = C + (size_t)row * DM + col0;
#pragma unroll
                for (int bj = 0; bj < 2; ++bj)
#pragma unroll
                    for (int n = 0; n < 2; ++n) { const pg8::f32x4 r = *(const pg8::f32x4*)(rp + bj * 128 + n * 16), g = *(const pg8::f32x4*)(gp + bj * 128 + n * 16);
                        *(pg8::f32x4*)(cp + bj * 128 + n * 16) = r + g * acc[ai][bj][m][n]; } }
    }
};
struct EpiCtxPartial {
    static constexpr bool PERM = false, AFTER_DRAIN = false;
    float* P; int ksub;
    __device__ __forceinline__ void operator()(const pg8::f32x4 (&acc)[2][2][4][2], const pg8::Unit& u, int wr, int wc, int fr, int fq) const {
        const int row0 = (u.pm - 32) * 256 + wr * 64 + fr, col0 = u.pn * 256 + wc * 32 + 4 * fq; float* base = P + (size_t)(u.k0 / ksub) * NC * DM;
#pragma unroll
        for (int ai = 0; ai < 2; ++ai)
#pragma unroll
            for (int m = 0; m < 4; ++m) { float* rowp = base + (size_t)(row0 + ai * 128 + m * 16) * DM + col0;
#pragma unroll
                for (int bj = 0; bj < 2; ++bj)
#pragma unroll
                    for (int n = 0; n < 2; ++n) *(pg8::f32x4*)(rowp + bj * 128 + n * 16) = acc[ai][bj][m][n]; }
    }
};
struct EpiTailPartial {
    static constexpr bool PERM = false, AFTER_DRAIN = false;
    float* P; int ntm, nN, lo, ntail, ksub;
    __device__ __forceinline__ void operator()(const pg8::f32x4 (&acc)[2][2][4][2], const pg8::Unit& u, int wr, int wc, int fr, int fq) const {
        const int pnl = u.pn % nN, t = pnl * ntm + u.pm - lo, ks = u.k0 / ksub;
        float* base = P + (size_t)(ks * ntail + t) * 65536 + (wr * 64 + fr) * 256 + wc * 32 + 4 * fq;
#pragma unroll
        for (int ai = 0; ai < 2; ++ai)
#pragma unroll
            for (int m = 0; m < 4; ++m) { float* rowp = base + (ai * 128 + m * 16) * 256;
#pragma unroll
                for (int bj = 0; bj < 2; ++bj)
#pragma unroll
                    for (int n = 0; n < 2; ++n) *(pg8::f32x4*)(rowp + bj * 128 + n * 16) = acc[ai][bj][m][n]; }
    }
};
struct EpiBf16Store {
    static constexpr bool PERM = true, AFTER_DRAIN = false;
    bf16_t* O; int ldc; float* side; int side_pn; int nn;
    __device__ __forceinline__ void operator()(const pg8::f32x4 (&acc)[2][2][4][2], const pg8::Unit& u, int wr, int wc, int fr, int fq) const {
        const int row0 = u.pm * 256 + wr * 64 + fr, col0 = (nn ? u.pn % nn : u.pn) * 256 + wc * 32 + 8 * fq;
#pragma unroll
        for (int ai = 0; ai < 2; ++ai)
#pragma unroll
            for (int m = 0; m < 4; ++m) { const int row = row0 + ai * 128 + m * 16; bf16_t* rowp = O + (size_t)row * ldc + col0;
#pragma unroll
                for (int bj = 0; bj < 2; ++bj) { const pg8::f32x4 v0 = acc[ai][bj][m][0], v1 = acc[ai][bj][m][1];
                    pg8::u32x4 w; w.x = cvt_pk_bf16(v0[0], v0[1]); w.y = cvt_pk_bf16(v0[2], v0[3]); w.z = cvt_pk_bf16(v1[0], v1[1]); w.w = cvt_pk_bf16(v1[2], v1[3]);
                    *(pg8::u32x4*)(rowp + bj * 128) = w;
                    if (side != nullptr && u.pn == side_pn) { float* sp = side + (size_t)row * 256 + bj * 128 + wc * 32 + 8 * fq; *(pg8::f32x4*)sp = v0; *(pg8::f32x4*)(sp + 4) = v1; } } }
    }
};
struct EpiSwiglu {
    static constexpr bool PERM = true, AFTER_DRAIN = false;
    bf16_t* O; int ldc; int nn;
    __device__ __forceinline__ void operator()(const pg8::f32x4 (&acc)[2][2][4][2], const pg8::Unit& u, int wr, int wc, int fr, int fq) const {
        const int row0 = u.pm * 256 + wr * 64 + fr, pnl = nn ? u.pn % nn : u.pn, col0 = pnl * 128 + wc * 32 + 8 * fq;
#pragma unroll
        for (int ai = 0; ai < 2; ++ai)
#pragma unroll
            for (int m = 0; m < 4; ++m) { bf16_t* rowp = O + (size_t)(row0 + ai * 128 + m * 16) * ldc + col0;
                const pg8::f32x4 g0 = acc[ai][0][m][0], g1 = acc[ai][0][m][1], u0 = acc[ai][1][m][0], u1 = acc[ai][1][m][1];
                pg8::u32x4 w;
                w.x = cvt_pk_bf16(silu_fast(g0[0]) * u0[0], silu_fast(g0[1]) * u0[1]); w.y = cvt_pk_bf16(silu_fast(g0[2]) * u0[2], silu_fast(g0[3]) * u0[3]);
                w.z = cvt_pk_bf16(silu_fast(g1[0]) * u1[0], silu_fast(g1[1]) * u1[1]); w.w = cvt_pk_bf16(silu_fast(g1[2]) * u1[2], silu_fast(g1[3]) * u1[3]);
                *(pg8::u32x4*)rowp = w; }
    }
};

__device__ __forceinline__ float rp_shift(const bf16_t* P, int row, int col, float mu) {
    int t, T;
    if (row < NL) { t = row % TL; T = TL; } else { t = (row - NL) % TC; T = TC; }
    const bf16_t* pc = P + (size_t)row * L0LD + col;
    const float c = bf2f(pc[0]), pv = t > 0 ? bf2f(pc[-L0LD]) : 0.f, nx = t < T - 1 ? bf2f(pc[L0LD]) : 0.f;
    return c + mu * (0.5f * (pv + nx) - c);
}
__device__ __forceinline__ void ph_lora_wt(const Params& p, int wg, int nwg) {
    const int tid = ptid();
    for (int idx = wg * NTHR + tid; idx < 384 * 1024; idx += nwg * NTHR) {
        const int ch = idx & 1023, j = idx >> 10;
        if (j < 128) p.WTd[((size_t)(j >> 6) * 1024 + ch) * 64 + (j & 63)] = f2bf(p.in[11][(size_t)j * 1024 + ch]);
        else if (j < 256) { const int q = j - 128; p.WTi[((size_t)(q >> 6) * 1024 + ch) * 64 + (q & 63)] = f2bf(p.in[13][(size_t)q * 1024 + ch]); }
        else { const int q = j - 256; p.WTg[(size_t)ch * 128 + q] = f2bf(p.in[14][(size_t)q * 1024 + ch]); }
    }
}
#define RPM_LD 392
__device__ __forceinline__ void ph_rwprep(const Params& p, float* lds, int wg, int nwg) {
    bf16_t* X = (bf16_t*)lds;
    const int tid = ptid(), wave = __builtin_amdgcn_readfirstlane(tid >> 6), lane = tid & 63, r16 = lane & 15, g = lane >> 4;
    for (int item = wg; item < NT / 34; item += nwg) {
        const int rowI = item * 34;
        for (int z = tid; z < 14 * RPM_LD / 2; z += NTHR) ((unsigned*)(X + 34 * RPM_LD))[z] = 0u;
#pragma unroll
        for (int q12 = 0; q12 < 4; ++q12) {
            const int idx = tid + q12 * NTHR; if (idx >= 34 * 48) break; const int rr = idx / 48, j = (idx % 48) * 8; const int row = rowI + rr;
            int t, T; if (row < NL) { t = row % TL; T = TL; } else { t = (row - NL) % TC; T = TC; }
            const bf16_t* pc = p.P + (size_t)row * L0LD + 3072 + j;
            const uint4 zc = *(const uint4*)pc, z0 = {0u, 0u, 0u, 0u};
            const uint4 zp = t > 0 ? *(const uint4*)(pc - L0LD) : z0, zn = t < T - 1 ? *(const uint4*)(pc + L0LD) : z0;
            const float4 mA = *(const float4*)(p.in[9] + 3072 + j), mB = *(const float4*)(p.in[9] + 3072 + j + 4);
            const unsigned cu[4] = {zc.x, zc.y, zc.z, zc.w}, pu[4] = {zp.x, zp.y, zp.z, zp.w}, nu[4] = {zn.x, zn.y, zn.z, zn.w};
            const float mu[8] = {mA.x, mA.y, mA.z, mA.w, mB.x, mB.y, mB.z, mB.w};
            unsigned ou[4];
#pragma unroll
            for (int e = 0; e < 4; ++e) {
                float vv[2];
#pragma unroll
                for (int hf = 0; hf < 2; ++hf) {
                    const float c = hf ? __uint_as_float(cu[e] & 0xffff0000u) : __uint_as_float(cu[e] << 16);
                    const float pv = hf ? __uint_as_float(pu[e] & 0xffff0000u) : __uint_as_float(pu[e] << 16);
                    const float nx = hf ? __uint_as_float(nu[e] & 0xffff0000u) : __uint_as_float(nu[e] << 16);
                    float v = c + mu[2 * e + hf] * (0.5f * (pv + nx) - c);
                    v = j < 128 ? (1.f - 2.f * __builtin_amdgcn_rcpf(1.f + __expf(2.f * v))) : (j < 256 ? v : sigm(v));
                    vv[hf] = v;
                }
                ou[e] = cvt_pk_bf16(vv[0], vv[1]);
            }
            *(uint4*)(X + rr * RPM_LD + j) = make_uint4(ou[0], ou[1], ou[2], ou[3]);
        }
        __syncthreads();
#pragma unroll 1
        for (int rt = 0; rt < 3; ++rt) {
        const int row0 = rowI + rt * 16, rowEnd = rowI + 34;
        pg8::bf16x8 af[12];
#pragma unroll
        for (int ks = 0; ks < 12; ++ks) af[ks] = *(const pg8::bf16x8*)(X + (rt * 16 + r16) * RPM_LD + ks * 32 + 8 * g);
#pragma unroll 1
        for (int hh = 0; hh < 2; ++hh) {
            const int h = wave * 2 + hh;
            pg8::f32x4 dA0[4], dA1[4], iA0[4], iA1[4], gG[4];
#pragma unroll
            for (int cb = 0; cb < 4; ++cb) {
                const int chb = h * 64 + cb * 16 + r16;
                pg8::f32x4 z = {0.f, 0.f, 0.f, 0.f};
                dA0[cb] = z; dA1[cb] = z; iA0[cb] = z; iA1[cb] = z; gG[cb] = z;
#pragma unroll
                for (int kk = 0; kk < 2; ++kk) {
                    dA0[cb] = __builtin_amdgcn_mfma_f32_16x16x32_bf16(af[kk], *(const pg8::bf16x8*)(p.WTd + ((size_t)chb) * 64 + kk * 32 + 8 * g), dA0[cb], 0, 0, 0);
                    dA1[cb] = __builtin_amdgcn_mfma_f32_16x16x32_bf16(af[2 + kk], *(const pg8::bf16x8*)(p.WTd + ((size_t)1024 + chb) * 64 + kk * 32 + 8 * g), dA1[cb], 0, 0, 0);
                    iA0[cb] = __builtin_amdgcn_mfma_f32_16x16x32_bf16(af[4 + kk], *(const pg8::bf16x8*)(p.WTi + ((size_t)chb) * 64 + kk * 32 + 8 * g), iA0[cb], 0, 0, 0);
                    iA1[cb] = __builtin_amdgcn_mfma_f32_16x16x32_bf16(af[6 + kk], *(const pg8::bf16x8*)(p.WTi + ((size_t)1024 + chb) * 64 + kk * 32 + 8 * g), iA1[cb], 0, 0, 0);
                }
#pragma unroll
                for (int kk = 0; kk < 4; ++kk)
                    gG[cb] = __builtin_amdgcn_mfma_f32_16x16x32_bf16(af[8 + kk], *(const pg8::bf16x8*)(p.WTg + (size_t)chb * 128 + kk * 32 + 8 * g), gG[cb], 0, 0, 0);
            }
            float* T = lds + 9472 + wave * 2560;
            const int ch = h * 64 + lane;
            const float mur = p.in[9][ch], muk = p.in[9][1024 + ch], muv = p.in[9][2048 + ch], kkc = p.in[15][ch], ka = p.in[16][ch];
            const float w00 = p.in[10][ch], w01 = p.in[10][1024 + ch], a00 = p.in[12][ch], a01 = p.in[12][1024 + ch];
            float nr_[6], nk_[6], nv_[6];
#define RP_LOADP(Q4) do { _Pragma("unroll") for (int q = 0; q < 6; ++q) { int rq = row0 + (Q4) * 4 - 1 + q; rq = rq < 0 ? 0 : (rq > NT - 1 ? NT - 1 : rq); \
                const bf16_t* pp = p.P + (size_t)rq * L0LD + ch; nr_[q] = bf2f(pp[0]); nk_[q] = bf2f(pp[1024]); nv_[q] = bf2f(pp[2048]); } } while (0)
            RP_LOADP(0);
#pragma unroll 1
            for (int q4 = 0; q4 < 4; ++q4) {
                if (row0 + q4 * 4 >= rowEnd) break;
                if ((q4 & 1) == 0 && (g >> 1) == (q4 >> 1)) {
#pragma unroll
                    for (int cb = 0; cb < 4; ++cb)
#pragma unroll
                        for (int reg = 0; reg < 4; ++reg) { const int o = (((4 * g + reg) & 7) * 64) + cb * 16 + r16;
                            T[o] = dA0[cb][reg]; T[512 + o] = dA1[cb][reg]; T[1024 + o] = iA0[cb][reg]; T[1536 + o] = iA1[cb][reg]; T[2048 + o] = gG[cb][reg]; }
                }
                float pr_[6], pk_[6], pv_[6];
#pragma unroll
                for (int q = 0; q < 6; ++q) { pr_[q] = nr_[q]; pk_[q] = nk_[q]; pv_[q] = nv_[q]; }
                RP_LOADP(q4 + 1);
#pragma unroll
                for (int r4 = 0; r4 < 4; ++r4) {
                    const int rr = (q4 & 1) * 4 + r4;
                    const int row = row0 + q4 * 4 + r4; const size_t o = (size_t)row * 1024 + ch;
                    if (row >= rowEnd) break;
                    const float d0 = T[rr * 64 + lane], d1 = T[512 + rr * 64 + lane], i0 = T[1024 + rr * 64 + lane], i1 = T[1536 + rr * 64 + lane], gv = T[2048 + rr * 64 + lane];
                    int tt, TT; if (row < NL) { tt = row % TL; TT = TL; } else { tt = (row - NL) % TC; TT = TC; }
                    const bool hp = tt > 0, hn = tt < TT - 1;
                    const float rv = pr_[r4 + 1] + mur * (0.5f * ((hp ? pr_[r4] : 0.f) + (hn ? pr_[r4 + 2] : 0.f)) - pr_[r4 + 1]);
                    const float k = pk_[r4 + 1] + muk * (0.5f * ((hp ? pk_[r4] : 0.f) + (hn ? pk_[r4 + 2] : 0.f)) - pk_[r4 + 1]);
                    const float v = pv_[r4 + 1] + muv * (0.5f * ((hp ? pv_[r4] : 0.f) + (hn ? pv_[r4 + 2] : 0.f)) - pv_[r4 + 1]);
                    const float kq = k * kkc; const float ssum = wave_sum(kq * kq); const float kkn = kq * rsqrtf(ssum + 1e-12f);
                    p.R[o] = f2bf(rv); p.V[o] = v; p.G[o] = gv; p.KK[o] = f2bf(kkn);
                    {   const float wlog = -softplusf(-(w00 + d0)) - 0.5f; const float a = sigm(a00 + i0);
                        p.W[0][o] = __expf(-__expf(wlog)); p.NB[0][o] = f2bf(-kkn * a); p.KD[0][o] = f2bf(k * (1.f + (a - 1.f) * ka)); }
                    {   const float wlog = -softplusf(-(w01 + d1)) - 0.5f; const float a = sigm(a01 + i1);
                        p.W[1][o] = __expf(-__expf(wlog)); p.NB[1][o] = f2bf(-kkn * a); p.KD[1][o] = f2bf(k * (1.f + (a - 1.f) * ka)); }
                }
            }
        }
        }
        __syncthreads();
    }
}

typedef float f2v __attribute__((ext_vector_type(2)));
#define RW_TB 32
#define RW_STEPF 336
#define RW_NBLK ((TC + TL) / RW_TB)
#define RW_LJ 11
__device__ __forceinline__ void ph_rwscan(const Params& p, float* lds, int wg, int nwg, int ct_begin) {
    const int tid = ptid(), wave = __builtin_amdgcn_readfirstlane(tid >> 6), lane = tid & 63;
    const bool loader = wave >= 4;
    for (int unit = wg; unit < 256; unit += nwg) {
        const int b = unit >> 7, h = (unit >> 3) & 15, dir = (unit >> 2) & 1, rg = unit & 3;
        const int lt = tid & 255;
        const float* const aW = dir ? p.W[1] : p.W[0]; const bf16_t* const aN = dir ? p.NB[1] : p.NB[0]; const bf16_t* const aD = dir ? p.KD[1] : p.KD[0];
        const int st0 = lt >> 4, st1 = 16 + (lt >> 4), c4l = lt & 15, sth = lt >> 3, c8l = lt & 7, qv = lt < 128 ? lt : 127, stv = qv >> 2, cvl = qv & 3;
        float4 rAW0, rAW1, rAV, rBW0, rBW1, rBV; uint4 rAK, rAN, rAD, rAR, rBK, rBN, rBD, rBR;
#define RW_LOAD_BLOCK(BLK, S) do { const int blk_ = (BLK) < RW_NBLK ? (BLK) : RW_NBLK - 1; const int T_ = blk_ < TC / RW_TB ? TC : TL, base_ = blk_ < TC / RW_TB ? NL + b * TC : b * TL, i0_ = blk_ < TC / RW_TB ? blk_ * RW_TB : (blk_ - TC / RW_TB) * RW_TB; \
        const int ta_ = dir ? T_ - 1 - (i0_ + st0) : i0_ + st0, tb_ = dir ? T_ - 1 - (i0_ + st1) : i0_ + st1, th_ = dir ? T_ - 1 - (i0_ + sth) : i0_ + sth, tv_ = dir ? T_ - 1 - (i0_ + stv) : i0_ + stv; \
        const size_t oa_ = (size_t)(base_ + ta_) * 1024 + h * 64 + c4l * 4, ob_ = (size_t)(base_ + tb_) * 1024 + h * 64 + c4l * 4, oh_ = (size_t)(base_ + th_) * 1024 + h * 64 + c8l * 8, ov_ = (size_t)(base_ + tv_) * 1024 + h * 64 + rg * 16 + cvl * 4; \
        r##S##W0 = *(const float4*)(aW + oa_); r##S##W1 = *(const float4*)(aW + ob_); r##S##K = *(const uint4*)(p.KK + oh_); r##S##N = *(const uint4*)(aN + oh_); \
        r##S##D = *(const uint4*)(aD + oh_); r##S##R = *(const uint4*)(p.R + oh_); r##S##V = *(const float4*)(p.V + ov_); } while (0)
#define RW_BF4LO(U) make_float4(__uint_as_float((U).x << 16), __uint_as_float((U).x & 0xffff0000u), __uint_as_float((U).y << 16), __uint_as_float((U).y & 0xffff0000u))
#define RW_BF4HI(U) make_float4(__uint_as_float((U).z << 16), __uint_as_float((U).z & 0xffff0000u), __uint_as_float((U).w << 16), __uint_as_float((U).w & 0xffff0000u))
#define RW_WRITE_BLOCK(BUF, S) do { float4* wq_ = (float4*)(BUF); wq_[st0 * 84 + c4l * 5] = r##S##W0; wq_[st1 * 84 + c4l * 5] = r##S##W1; \
        float4* wh_ = wq_ + sth * 84 + (2 * c8l) * 5 + 1; \
        wh_[0] = RW_BF4LO(r##S##K); wh_[5] = RW_BF4HI(r##S##K); wh_[1] = RW_BF4LO(r##S##N); wh_[6] = RW_BF4HI(r##S##N); \
        wh_[2] = RW_BF4LO(r##S##D); wh_[7] = RW_BF4HI(r##S##D); wh_[3] = RW_BF4LO(r##S##R); wh_[8] = RW_BF4HI(r##S##R); \
        wq_[stv * 84 + 80 + cvl] = r##S##V; } while (0)
        float* buf0 = lds; float* buf1 = lds + RW_TB * RW_STEPF;
        float4 cv0, cv1, cv2, cv3, cv4, cv5, cv6, cv7;
        const unsigned long long* cttab = (const unsigned long long*)((const char*)lds + CTTAB_OFF);
        const int cgw = wg * 4 + (wave - 4), cnw = nwg * 4;
        char* const ctlds = (char*)lds + 2 * RW_TB * RW_STEPF * 4 + (wave - 4) * CT_LDS_BYTES;
        if (loader) { RW_LOAD_BLOCK(0, A); RW_WRITE_BLOCK(buf0, A); RW_LOAD_BLOCK(1, A); RW_LOAD_BLOCK(2, B); CT_LOAD(ct_begin + cgw); }
        __syncthreads();
        f2v Sa = {0.f, 0.f}, Sb = {0.f, 0.f};
        float* const Yd = dir ? p.Y[1] : p.Y[0];
        const int seg = lane & 15, vrl = wave * 4 + (lane >> 4);
#define RW_LOADER_STEP(BLK, NXT, S) do { __builtin_amdgcn_s_setprio(0); RW_WRITE_BLOCK(NXT, S); RW_LOAD_BLOCK((BLK) + 3, S); \
        { const int tcur = ct_begin + (BLK) * cnw + cgw; CT_STORE(tcur, ctlds); CT_LOAD(tcur + cnw); } } while (0)
#define RW_CONSUME(BLK, CUR) do { __builtin_amdgcn_s_setprio(3); \
        float ylo = 0.f, yhi = 0.f; \
        const float* sp0 = (CUR) + seg * 20; const float* vp0 = (CUR) + 320 + vrl; \
        float4 w4 = *(const float4*)(sp0), k4 = *(const float4*)(sp0 + 4), n4 = *(const float4*)(sp0 + 8), d4 = *(const float4*)(sp0 + 12), r4 = *(const float4*)(sp0 + 16); \
        float v = vp0[0]; \
        _Pragma("unroll") for (int s = 0; s < RW_TB; ++s) { \
            float4 w4n = w4, k4n = k4, n4n = n4, d4n = d4, r4n = r4; float vn = v; \
            if (s + 1 < RW_TB) { const float* sp = sp0 + (s + 1) * RW_STEPF; \
                w4n = *(const float4*)(sp); k4n = *(const float4*)(sp + 4); n4n = *(const float4*)(sp + 8); d4n = *(const float4*)(sp + 12); r4n = *(const float4*)(sp + 16); \
                vn = vp0[(s + 1) * RW_STEPF]; } \
            const f2v wA = {w4.x, w4.y}, wB = {w4.z, w4.w}, kA = {k4.x, k4.y}, kB = {k4.z, k4.w}, nA = {n4.x, n4.y}, nB = {n4.z, n4.w}; \
            const f2v dA = {d4.x, d4.y}, dB = {d4.z, d4.w}, rA = {r4.x, r4.y}, rB = {r4.z, r4.w}; \
            f2v t = Sa * kA; t = __builtin_elementwise_fma(Sb, kB, t); \
            const float sa = dpp_add16(t.x + t.y); \
            const f2v sav = {sa, sa}, vv = {v, v}; \
            const f2v tA = __builtin_elementwise_fma(sav, nA, vv * dA), tB = __builtin_elementwise_fma(sav, nB, vv * dB); \
            Sa = __builtin_elementwise_fma(Sa, wA, tA); Sb = __builtin_elementwise_fma(Sb, wB, tB); \
            f2v yy = Sa * rA; yy = __builtin_elementwise_fma(Sb, rB, yy); \
            const float y = dpp_add16(yy.x + yy.y); \
            if (s < 16) ylo = (seg == s) ? y : ylo; else yhi = (seg == (s - 16)) ? y : yhi; \
            w4 = w4n; k4 = k4n; n4 = n4n; d4 = d4n; r4 = r4n; v = vn; } \
        const int blk_ = (BLK); const int T = blk_ < TC / RW_TB ? TC : TL, base = blk_ < TC / RW_TB ? NL + b * TC : b * TL, i0 = blk_ < TC / RW_TB ? blk_ * RW_TB : (blk_ - TC / RW_TB) * RW_TB; \
        const int ia = i0 + seg, ib = i0 + 16 + seg; \
        const int ta = dir ? T - 1 - ia : ia, tb = dir ? T - 1 - ib : ib; \
        Yd[(size_t)(base + ta) * 1024 + h * 64 + rg * 16 + vrl] = ylo; \
        Yd[(size_t)(base + tb) * 1024 + h * 64 + rg * 16 + vrl] = yhi; \
        __builtin_amdgcn_s_setprio(0); } while (0)
        for (int blk = 0; blk < RW_NBLK; blk += 2) {
            if (loader) RW_LOADER_STEP(blk, buf1, A); else RW_CONSUME(blk, buf0);
            lds_barrier();
            if (loader) RW_LOADER_STEP(blk + 1, buf0, B); else RW_CONSUME(blk + 1, buf1);
            lds_barrier();
        }
        __syncthreads();
    }
}

__device__ __forceinline__ void ph_rwout(const Params& p, int wg, int nwg) {
    const int tid_ = ptid(); const int wave = tid_ >> 6, lane = tid_ & 63;
    for (int row = wg; row < NT; row += nwg) {
#pragma unroll
        for (int hh = 0; hh < 2; ++hh) {
            const int h = wave * 2 + hh;
            const size_t o = (size_t)row * 1024 + h * 64 + lane;
            const float y = p.Y[0][o] + p.Y[1][o];
            const float mu = wave_sum(y) * (1.f / 64.f);
            const float dlt = y - mu;
            const float var = wave_sum(dlt * dlt) * (1.f / 64.f);
            const float yn = dlt * rsqrtf(var + 64e-5f) * p.in[18][h * 64 + lane] + p.in[19][h * 64 + lane];
            const float r = bf2f(p.R[o]), kb = 0.5f * (bf2f(p.KD[0][o]) + bf2f(p.KD[1][o]));
            const float bs = wave_sum(r * kb * p.in[17][h * 64 + lane]);
            p.MIXb[(size_t)row * DM + h * 64 + lane] = f2bf((yn + bs * p.V[o]) * p.G[o]);
        }
    }
}

__device__ __forceinline__ void ph_naprep(const Params& p, float* lds, int wg, int nwg) {
    const int tid = ptid(), wave = tid >> 6, lane = tid & 63;
    {
        const float kb = 8.f * wave_max(fabsf(p.in[21][lane]));
        float bmax[2];
#pragma unroll
        for (int hh = 0; hh < 2; ++hh) { float m = 0.f; for (int i = lane; i < 465; i += 64) m = fmaxf(m, fabsf(p.in[22][(wave * 2 + hh) * 465 + i])); bmax[hh] = wave_max(m); }
        const float qw = p.in[20][lane] * 0.125f, kw = p.in[21][lane];
        float nq[2], nk[2];
#define NAP_LOAD(ROW) do { const bf16_t* pp_ = p.P + (size_t)(ROW) * L0LD + RWC + wave * 128 + lane; \
        nq[0] = bf2f(pp_[0]); nq[1] = bf2f(pp_[64]); nk[0] = bf2f(pp_[1024]); nk[1] = bf2f(pp_[1088]); } while (0)
        NAP_LOAD(wg < NT ? wg : 0);
        for (int row = wg; row < NT; row += nwg) {
            const float cq[2] = {nq[0], nq[1]}, ck[2] = {nk[0], nk[1]};
            NAP_LOAD(row + nwg < NT ? row + nwg : row);
#pragma unroll
            for (int hh = 0; hh < 2; ++hh) {
                const int h = wave * 2 + hh;
                const float q = cq[hh], k = ck[hh];
                const float qs = wave_sum(q * q) * (1.f / 64.f), ks = wave_sum(k * k) * (1.f / 64.f);
                const float qn = q * rsqrtf(qs + 1e-6f) * qw, kn = k * rsqrtf(ks + 1e-6f) * kw;
                p.Qb[(size_t)row * 1024 + h * 64 + lane] = f2bf(qn);
                { const int kb_ = row < NL ? row / TL : (row - NL) / TC, tp_ = row < NL ? row % TL : TL + (row - NL) % TC;
                  p.Kb[((((size_t)(kb_ * 16 + h) * 136 + (tp_ >> 5)) * 4 + (lane >> 4)) * 64 + ((lane >> 3) & 1) * 32 + (tp_ & 31)) * 8 + (lane & 7)] = f2bf(kn); }
                const float qq = wave_sum(qn * qn);
                if (lane == 0) p.QM[row * 16 + h] = (sqrtf(qq) * kb * 1.01f + bmax[hh]) * 1.44269504f;
            }
        }
    }
    {
        bf16_t* T = (bf16_t*)lds;
        for (int item = wg; item < 136 * 8; item += nwg) {
            const int tb = item >> 3, hg = item & 7;
            const int row0 = tb < 128 ? tb * 64 : NL + (tb - 128) * 64;
            {
                const int tok = tid >> 3, c16 = (tid & 7) * 16;
                const bf16_t* src = p.P + (size_t)(row0 + tok) * L0LD + RWC + 2048 + hg * 128 + c16;
                const uint4 va4 = *(const uint4*)src, vb4 = *(const uint4*)(src + 8);
                const unsigned wv[8] = {va4.x, va4.y, va4.z, va4.w, vb4.x, vb4.y, vb4.z, vb4.w};
#pragma unroll
                for (int q = 0; q < 8; ++q) { T[(c16 + 2 * q) * 72 + tok] = (bf16_t)(wv[q] & 0xffffu); T[(c16 + 2 * q + 1) * 72 + tok] = (bf16_t)(wv[q] >> 16); }
            }
            __syncthreads();
            {
                const int b = tb < 128 ? tb >> 6 : (tb - 128) >> 2, tile0 = tb < 128 ? (tb & 63) * 2 : 128 + ((tb - 128) & 3) * 2;
#pragma unroll
                for (int q = 0; q < 2; ++q) {
                    const int idx = tid + NTHR * q, ln = idx & 63, sq = (idx >> 6) & 1, nt = (idx >> 7) & 1, tl = (idx >> 8) & 1, hl = idx >> 9;
                    const int rr = ln & 31, hh2 = ln >> 5, ch = hl * 64 + 32 * nt + rr, tk0 = tl * 32 + 16 * sq + 4 * hh2;
                    const uint2 lo = *(const uint2*)(T + ch * 72 + tk0), hi = *(const uint2*)(T + ch * 72 + tk0 + 8);
                    *(uint4*)(p.VTl + ((((size_t)(b * 16 + 2 * hg + hl) * 136 + tile0 + tl) * 2 + nt) * 2 + sq) * 512 + ln * 8) = make_uint4(lo.x, lo.y, hi.x, hi.y);
                }
            }
            __syncthreads();
        }
    }
}

typedef float f32x16 __attribute__((ext_vector_type(16)));
template <bool BAND>
__device__ __forceinline__ void na_tile(const Params& p, const float* tab, const pg8::bf16x8 (&qf)[4], int keyrow0, const bf16_t* vtp, int vstride, int h, int r, int hh,
                                        int kc0, int q, int c0, int browoff, float mq, f32x16& o0, f32x16& o1, float& l) {
    pg8::bf16x8 kf[4];
#pragma unroll
    for (int ks = 0; ks < 4; ++ks) kf[ks] = *(const pg8::bf16x8*)(p.Kb + ((size_t)keyrow0 * 4 + ks) * 512 + (hh * 32 + r) * 8);
    pg8::bf16x8 vf[2][2];
#pragma unroll
    for (int nt = 0; nt < 2; ++nt)
#pragma unroll
        for (int s = 0; s < 2; ++s) vf[nt][s] = *(const pg8::bf16x8*)(vtp + ((nt * 2 + s) * 64 + hh * 32 + r) * 8);
    f32x16 sacc;
#pragma unroll
    for (int i = 0; i < 16; ++i) sacc[i] = 0.f;
#pragma unroll
    for (int ks = 0; ks < 4; ++ks) sacc = __builtin_amdgcn_mfma_f32_32x32x16_bf16(kf[ks], qf[ks], sacc, 0, 0, 0);
    float pv[16];
#pragma unroll
    for (int reg = 0; reg < 16; ++reg) {
        float sc = sacc[reg];
        if (BAND) {
            const int kc = kc0 + (reg & 3) + 8 * (reg >> 2) + 4 * hh;
            const bool valid = (unsigned)(kc - c0) < 16u;
            const int bi = valid ? browoff + kc - q + 15 : 0;
            sc += tab[bi];
            pv[reg] = valid ? __builtin_amdgcn_exp2f(sc * 1.44269504f - mq) : 0.f;
        } else pv[reg] = __builtin_amdgcn_exp2f(sc * 1.44269504f - mq);
        l += pv[reg];
    }
    pg8::bf16x8 pf[2];
#pragma unroll
    for (int s = 0; s < 2; ++s) { const pg8::u32x4 w = {cvt_pk_bf16(pv[8 * s], pv[8 * s + 1]), cvt_pk_bf16(pv[8 * s + 2], pv[8 * s + 3]), cvt_pk_bf16(pv[8 * s + 4], pv[8 * s + 5]), cvt_pk_bf16(pv[8 * s + 6], pv[8 * s + 7])};
        pf[s] = __builtin_bit_cast(pg8::bf16x8, w); }
#pragma unroll
    for (int s = 0; s < 2; ++s) { o0 = __builtin_amdgcn_mfma_f32_32x32x16_bf16(vf[0][s], pf[s], o0, 0, 0, 0); o1 = __builtin_amdgcn_mfma_f32_32x32x16_bf16(vf[1][s], pf[s], o1, 0, 0, 0); }
}
__device__ __forceinline__ void ph_naattn(const Params& p, float* lds, int wg, int nwg) {
    const int tid = ptid(), wave = __builtin_amdgcn_readfirstlane(tid >> 6), lane = tid & 63, r = lane & 31, hh = lane >> 5;
    float* tab = lds + wave * 512;
    for (int u = wg * 8 + wave; u < 4096 + 256; u += nwg * 8) {
        int b, h, qrow0, nband = 0, gr = 0, r0 = 0, q0 = 0;
        if (u < 4096) { h = u & 15; int x = u >> 4; q0 = (x & 1) * 32; x >>= 1; gr = x & 63; b = x >> 6; qrow0 = b * TL + gr * 64 + q0; r0 = gr - 4; r0 = r0 < 0 ? 0 : (r0 > 56 ? 56 : r0); nband = 8; }
        else { int x = u - 4096; h = x & 15; x >>= 4; b = x >> 3; qrow0 = NL + b * TC + (x & 7) * 32; }
        if (nband) for (int i = lane; i < 465; i += 64) tab[i] = p.in[22][h * 465 + i];
        pg8::bf16x8 qf[4];
#pragma unroll
        for (int ks = 0; ks < 4; ++ks) qf[ks] = *(const pg8::bf16x8*)(p.Qb + (size_t)(qrow0 + r) * 1024 + h * 64 + 16 * ks + 8 * hh);
        const float mq = p.QM[(qrow0 + r) * 16 + h];
        f32x16 o0, o1;
#pragma unroll
        for (int i = 0; i < 16; ++i) { o0[i] = 0.f; o1[i] = 0.f; }
        float l = 0.f;
        const int q = q0 + r; int c0 = q - 8; c0 = c0 < 0 ? 0 : (c0 > 48 ? 48 : c0);
        for (int tl = 0; tl < nband * 2; ++tl) {
            const int i = tl >> 1, kt = tl & 1;
            { const int tid_ = (b * 16 + h) * 136 + (r0 + i) * 2 + kt; na_tile<true>(p, tab, qf, tid_, p.VTl + (size_t)tid_ * 2048, TL, h, r, hh, 32 * kt, q, c0, (r0 + i - gr + 7) * 31, mq, o0, o1, l); }
        }
        for (int kt = 0; kt < 8; ++kt)
            { const int tid_ = (b * 16 + h) * 136 + 128 + kt; na_tile<false>(p, tab, qf, tid_, p.VTl + (size_t)tid_ * 2048, TC, h, r, hh, 0, 0, 0, 0, mq, o0, o1, l); }
        l += __shfl_xor(l, 32);
        const float inv = 1.f / l;
        bf16_t* dst = p.MIXb + (size_t)(qrow0 + r) * DM + 1024 + h * 64 + 4 * hh;
#pragma unroll
        for (int g4 = 0; g4 < 4; ++g4) {
            uint2 w0, w1;
            w0.x = cvt_pk_bf16(o0[4 * g4] * inv, o0[4 * g4 + 1] * inv); w0.y = cvt_pk_bf16(o0[4 * g4 + 2] * inv, o0[4 * g4 + 3] * inv);
            w1.x = cvt_pk_bf16(o1[4 * g4] * inv, o1[4 * g4 + 1] * inv); w1.y = cvt_pk_bf16(o1[4 * g4 + 2] * inv, o1[4 * g4 + 3] * inv);
            *(uint2*)(dst + 8 * g4) = w0; *(uint2*)(dst + 32 + 8 * g4) = w1;
        }
    }
}

#define GLA_NCH 68
#define GLA_LDP 264
__device__ __forceinline__ void ph_glaprep(const Params& p, float* lds, int wg, int nwg) {
    bf16_t* Qs = (bf16_t*)lds;
    bf16_t* Ks = Qs + 64 * GLA_LDP;
    float* lrs = (float*)(Ks + 64 * GLA_LDP);
    float* hsum = lrs + 64 * 16;
    const int tid = ptid(), wave = __builtin_amdgcn_readfirstlane(tid >> 6), lane = tid & 63;
    for (int unit = wg; unit < 16 * GLA_NCH; unit += nwg) {
        const int bhd = unit / GLA_NCH, c = unit % GLA_NCH;
        const int b = bhd >> 3, h = (bhd >> 1) & 3, dir = bhd & 1;
        const bool isctx = c < 4;
        const int T = isctx ? TC : TL, base = isctx ? NL + b * TC : b * TL, cc = isctx ? c : c - 4;
        for (int q = tid; q < 64 * 16; q += NTHR) { const int i = q >> 4, j = q & 15, idx = cc * 64 + i, t = dir ? T - 1 - idx : idx;
            lrs[q] = p.LRs[(size_t)(base + t) * 256 + 16 * dir + j]; }
#pragma unroll
        for (int q4 = 0; q4 < 4; ++q4) { const int e = tid + q4 * NTHR, i = e >> 5, c8 = e & 31, idx = cc * 64 + i, t = dir ? T - 1 - idx : idx;
            const bf16_t* pr = p.P + (size_t)(base + t) * L1LD + h * 256 + c8 * 8;
            *(uint4*)(Ks + i * GLA_LDP + c8 * 8) = *(const uint4*)pr;
            if (!isctx) *(uint4*)(Qs + i * GLA_LDP + c8 * 8) = *(const uint4*)(pr + 3104); }
        __syncthreads();
        {
            const int d = tid & 255, hf = tid >> 8, ch = h * 256 + d;
            float w2[16];
#pragma unroll
            for (int j = 0; j < 16; ++j) w2[j] = p.in[32][(size_t)(dir * 16 + j) * 1024 + ch];
            const float bias = p.in[33][dir * 1024 + ch];
            float lg[32]; float ls = 0.f;
#pragma unroll
            for (int i = 0; i < 32; ++i) { float x = bias;
#pragma unroll
                for (int j = 0; j < 16; ++j) x += lrs[(32 * hf + i) * 16 + j] * w2[j];
                lg[i] = -softplusf(-x) * (1.f / 16.f); ls += lg[i]; }
            hsum[hf * 256 + d] = ls;
            __syncthreads();
            const float bend = hsum[d] + hsum[256 + d];
            float bb = hf ? hsum[d] : 0.f, prev = 0.f; unsigned khp[16];
#pragma unroll
            for (int i = 0; i < 32; ++i) {
                const int ii = 32 * hf + i, idx = cc * 64 + ii, t = dir ? T - 1 - idx : idx;
                bb += lg[i]; (void)t;
                const float k = bf2f(Ks[ii * GLA_LDP + d]);
                const float kh = k * __expf(bend - bb);
                if (!isctx) { const float qt = bf2f(Qs[ii * GLA_LDP + d]) * __expf(bb) * 0.0625f, kt = k * __expf(-bb);
                    const bf16_t qb = f2bf(qt); Qs[ii * GLA_LDP + d] = qb; Ks[ii * GLA_LDP + d] = f2bf(kt); p.QT[(size_t)unit * 16384 + ((((ii >> 4) * 8 + (d >> 5)) * 64 + ((d >> 3) & 3) * 16 + (ii & 15)) * 8) + (d & 7)] = qb; }
                if (i & 1) khp[i >> 1] = cvt_pk_bf16(prev, kh); else prev = kh;
            }
            bf16_t* kd = p.KHT + (size_t)unit * 16384 + ((size_t)(((d >> 4) * 2 + hf) * 64 + (d & 15))) * 8;
#pragma unroll
            for (int q = 0; q < 4; ++q) *(uint4*)(kd + q * 128) = make_uint4(khp[4 * q], khp[4 * q + 1], khp[4 * q + 2], khp[4 * q + 3]);
            if (hf == 0) p.DEC[unit * 256 + d] = __expf(bend);
        }
        {
            const int v0 = tid;
            unsigned va[32];
#pragma unroll
            for (int i = 0; i < 64; i += 2) {
                const int idx0 = cc * 64 + i, t0 = dir ? T - 1 - idx0 : idx0, t1 = dir ? t0 - 1 : t0 + 1;
                const unsigned x0 = p.P[(size_t)(base + t0) * L1LD + 1024 + h * 512 + v0];
                const unsigned x1 = p.P[(size_t)(base + t1) * L1LD + 1024 + h * 512 + v0];
                va[i >> 1] = x0 | (x1 << 16);
            }
            bf16_t* d0 = p.VT + (size_t)unit * 32768 + ((size_t)((v0 >> 4) * 2 * 64 + (v0 & 15))) * 8;
#pragma unroll
            for (int q = 0; q < 8; ++q) *(uint4*)(d0 + ((q >> 2) * 64 + (q & 3) * 16) * 8) = make_uint4(va[4 * q], va[4 * q + 1], va[4 * q + 2], va[4 * q + 3]);
        }
        __syncthreads();
        if (!isctx) {
            const int r = lane & 15, g = lane >> 4, ti = wave >> 1;
#pragma unroll
            for (int q = 0; q < 2; ++q) {
                const int tj = (wave & 1) * 2 + q;
                pg8::f32x4 acc = {0.f, 0.f, 0.f, 0.f};
                if (tj <= ti) {
#pragma unroll
                    for (int ks = 0; ks < 8; ++ks) {
                        const pg8::bf16x8 a = *(const pg8::bf16x8*)(Ks + (tj * 16 + r) * GLA_LDP + ks * 32 + 8 * g);
                        const pg8::bf16x8 bq = *(const pg8::bf16x8*)(Qs + (ti * 16 + r) * GLA_LDP + ks * 32 + 8 * g);
                        acc = __builtin_amdgcn_mfma_f32_16x16x32_bf16(a, bq, acc, 0, 0, 0);
                    }
                }
                const int i = ti * 16 + r, j0 = tj * 16 + 4 * g;
                uint2 o;
                o.x = cvt_pk_bf16(j0 + 0 <= i ? acc[0] : 0.f, j0 + 1 <= i ? acc[1] : 0.f);
                o.y = cvt_pk_bf16(j0 + 2 <= i ? acc[2] : 0.f, j0 + 3 <= i ? acc[3] : 0.f);
                *(uint2*)(p.AM + (size_t)unit * 4096 + ((((i >> 4) * 2 + (j0 >> 5)) * 64 + ((j0 >> 3) & 3) * 16 + (i & 15)) * 8) + (j0 & 7)) = o;
            }
        }
        __syncthreads();
    }
}

#define GLA_LOAD_O(QT_, AM_, C_) do { const int c_ = (C_) < GLA_NCH ? (C_) : GLA_NCH - 1; const size_t u = (size_t)(bhd * GLA_NCH + c_); \
        _Pragma("unroll") for (int ks = 0; ks < 8; ++ks) QT_[ks] = *(const pg8::bf16x8*)(p.QT + u * 16384 + ((it * 8 + ks) * 64 + lane) * 8); \
        _Pragma("unroll") for (int ks = 0; ks < 2; ++ks) AM_[ks] = *(const pg8::bf16x8*)(p.AM + u * 4096 + ((it * 2 + ks) * 64 + lane) * 8); } while (0)
#define GLA_LOAD_S(KH_, VT_, DEC_, C_) do { const int c_ = (C_) < GLA_NCH ? (C_) : GLA_NCH - 1; const size_t u = (size_t)(bhd * GLA_NCH + c_); \
    _Pragma("unroll") for (int dt = 0; dt < 2; ++dt) { \
        _Pragma("unroll") for (int ks = 0; ks < 2; ++ks) { \
            KH_[dt][ks] = *(const pg8::bf16x8*)(p.KHT + u * 16384 + (((2 * w + dt) * 2 + ks) * 64 + lane) * 8); \
            VT_[dt][ks] = *(const pg8::bf16x8*)(p.VT + u * 32768 + (((vs * 2 + dt) * 2 + ks) * 64 + lane) * 8); } \
        DEC_[dt] = *(const pg8::f32x4*)(p.DEC + u * 256 + (2 * w + dt) * 16 + 4 * g); } } while (0)
#define GLA_LOAD_OVT(OVT_, C_) do { const size_t u = (size_t)(bhd * GLA_NCH + (C_)); _Pragma("unroll") for (int ks = 0; ks < 2; ++ks) OVT_[ks] = *(const pg8::bf16x8*)(p.VT + (u * 512 + vs * 32 + vt * 16 + r) * 64 + ks * 32 + 8 * g); } while (0)
__device__ __forceinline__ void ph_glascan(const Params& p, float* lds, int wg, int nwg, int gct_begin) {
    const unsigned long long* cttab = (const unsigned long long*)((const char*)lds + CTTAB_OFF);
    bf16_t* ST0 = (bf16_t*)lds; bf16_t* ST1 = ST0 + 32 * GLA_LDP;
    const int tid = ptid(), w = __builtin_amdgcn_readfirstlane(tid >> 6), lane = tid & 63, r = lane & 15, g = lane >> 4;
    const int it = w >> 1, vt = w & 1;
    for (int unit = wg; unit < 256; unit += nwg) {
        const int bhd = (unit & 7) * 2 + ((unit >> 3) & 1), vs = unit >> 4;
        const int b = bhd >> 3, h = (bhd >> 1) & 3, dir = bhd & 1;
        float* const Od = dir ? p.O[1] : p.O[0];
        for (int q = tid; q < 32 * GLA_LDP / 2; q += NTHR) ((unsigned*)ST0)[q] = 0u;
        pg8::f32x4 acc[2][2];
#pragma unroll
        for (int a = 0; a < 2; ++a)
#pragma unroll
            for (int c2 = 0; c2 < 2; ++c2) acc[a][c2] = (pg8::f32x4){0.f, 0.f, 0.f, 0.f};
        __syncthreads();
        pg8::bf16x8 cqt[8], cam[2], ckh[2][2], cvt[2][2], nkh[2][2], nvt[2][2]; pg8::f32x4 cdec[2], ndec[2];
        const pg8::bf16x8 zz = {0, 0, 0, 0, 0, 0, 0, 0};
#pragma unroll
        for (int ks = 0; ks < 8; ++ks) cqt[ks] = zz;
#pragma unroll
        for (int ks = 0; ks < 2; ++ks) cam[ks] = zz;
        GLA_LOAD_S(ckh, cvt, cdec, 0);
        float4 cv0, cv1, cv2, cv3, cv4, cv5, cv6, cv7; CT_LOAD(gct_begin + wg * 8 + w);
        const int gct_nch = (CT_TOTAL - gct_begin + nwg * 8 - 1) / (nwg * 8);
        for (int c = 0; c < GLA_NCH; ++c) {
            GLA_LOAD_S(nkh, nvt, ndec, c + 1);
            bf16_t* STc = (c & 1) ? ST1 : ST0; bf16_t* STn = (c & 1) ? ST0 : ST1;
#pragma unroll
            for (int dt = 0; dt < 2; ++dt)
#pragma unroll
                for (int v2 = 0; v2 < 2; ++v2) {
                    pg8::f32x4 a = acc[dt][v2] * cdec[dt];
#pragma unroll
                    for (int ks = 0; ks < 2; ++ks) a = __builtin_amdgcn_mfma_f32_16x16x32_bf16(ckh[dt][ks], cvt[v2][ks], a, 0, 0, 0);
                    acc[dt][v2] = a;
                    uint2 sv; sv.x = cvt_pk_bf16(a[0], a[1]); sv.y = cvt_pk_bf16(a[2], a[3]);
                    *(uint2*)(STn + (v2 * 16 + r) * GLA_LDP + (2 * w + dt) * 16 + 4 * g) = sv;
                }
            if (c >= 4) {
                pg8::f32x4 o = {0.f, 0.f, 0.f, 0.f};
#pragma unroll
                for (int ks = 0; ks < 8; ++ks) { const pg8::bf16x8 sa = *(const pg8::bf16x8*)(STc + (vt * 16 + r) * GLA_LDP + ks * 32 + 8 * g);
                    o = __builtin_amdgcn_mfma_f32_16x16x32_bf16(sa, cqt[ks], o, 0, 0, 0); }
                if (vt == 0) {
#pragma unroll
                    for (int ks = 0; ks < 2; ++ks) o = __builtin_amdgcn_mfma_f32_16x16x32_bf16(cvt[0][ks], cam[ks], o, 0, 0, 0);
                } else {
#pragma unroll
                    for (int ks = 0; ks < 2; ++ks) o = __builtin_amdgcn_mfma_f32_16x16x32_bf16(cvt[1][ks], cam[ks], o, 0, 0, 0);
                }
                const int idx = (c - 4) * 64 + it * 16 + r, t = dir ? TL - 1 - idx : idx;
                *(pg8::f32x4*)(Od + (size_t)(b * TL + t) * DM + h * 512 + vs * 32 + vt * 16 + 4 * g) = o;
            }
            if (c >= 3) GLA_LOAD_O(cqt, cam, c + 1);
#pragma unroll
            for (int ks = 0; ks < 2; ++ks) { cdec[ks] = ndec[ks];
#pragma unroll
                for (int q = 0; q < 2; ++q) { ckh[ks][q] = nkh[ks][q]; cvt[ks][q] = nvt[ks][q]; } }
            {
                const int tconv = gct_begin + c * (nwg * 8) + wg * 8 + w;
                if (c < gct_nch) { CT_STORE(tconv, 0); if (c + 1 < gct_nch) CT_LOAD(tconv + nwg * 8); }
            }
            lds_barrier();
        }
    }
}

__device__ __forceinline__ void ph_glaout(const Params& p, float* lds, int wg, int nwg) {
    (void)lds;
    const int tid = ptid(), wave = tid >> 6, lane = tid & 63;
    for (int row = wg * 8 + wave; row < NL; row += nwg * 8) {
        float4 o[8]; float hs[4] = {0.f, 0.f, 0.f, 0.f};
#pragma unroll
        for (int q = 0; q < 8; ++q) { const float4 a = ((const float4*)(p.O[0] + (size_t)row * DM))[lane + 64 * q], c = ((const float4*)(p.O[1] + (size_t)row * DM))[lane + 64 * q];
            o[q] = make_float4(a.x + c.x, a.y + c.y, a.z + c.z, a.w + c.w); hs[q >> 1] += o[q].x * o[q].x + o[q].y * o[q].y + o[q].z * o[q].z + o[q].w * o[q].w; }
#pragma unroll
        for (int hd = 0; hd < 4; ++hd) hs[hd] = rsqrtf(wave_sum(hs[hd]) * (1.f / 512.f) + 1e-6f);
#pragma unroll
        for (int q = 0; q < 8; ++q) {
            const float rs = hs[q >> 1];
            const float4 gn = ((const float4*)p.in[34])[lane + 64 * (q & 1)];
            const uint2 ogr = ((const uint2*)(p.P + (size_t)row * L1LD + 4128))[lane + 64 * q];
            const float4 og = make_float4(__uint_as_float(ogr.x << 16), __uint_as_float(ogr.x & 0xffff0000u), __uint_as_float(ogr.y << 16), __uint_as_float(ogr.y & 0xffff0000u));
            uint2 r;
            r.x = cvt_pk_bf16(o[q].x * rs * gn.x * siluf(og.x), o[q].y * rs * gn.y * siluf(og.y));
            r.y = cvt_pk_bf16(o[q].z * rs * gn.z * siluf(og.z), o[q].w * rs * gn.w * siluf(og.w));
            ((uint2*)(p.MIXb + (size_t)row * DM))[lane + 64 * q] = r;
        }
    }
}

__device__ __forceinline__ void ph_route(const Params& p, float* lds, int wg, int nwg) {
    float* rt = lds;
    const int tid = ptid(), wave = tid >> 6, lane = tid & 63;
    for (int i = tid; i < DM * 2; i += NTHR) { const float4 r = ((const float4*)p.in[36])[i]; const int k = i >> 1, e0 = (i & 1) * 4;
        rt[(e0 + 0) * DM + k] = r.x; rt[(e0 + 1) * DM + k] = r.y; rt[(e0 + 2) * DM + k] = r.z; rt[(e0 + 3) * DM + k] = r.w; }
    __syncthreads();
    for (int row = wg * 8 + wave; row < NL; row += nwg * 8) {
        float ss = 0.f;
#pragma unroll
        for (int q = 0; q < 8; ++q) { const float4 t = ((const float4*)(p.XA + (size_t)row * DM))[lane + 64 * q]; ss += t.x * t.x + t.y * t.y + t.z * t.z + t.w * t.w; }
        ss = wave_sum(ss);
        const float rs = rsqrtf(ss * (1.f / DM) + 1e-6f);
        const int g = row / TL;
        float l[8];
#pragma unroll
        for (int e = 0; e < 8; ++e) l[e] = 0.f;
#pragma unroll 2
        for (int q = 0; q < 8; ++q) {
            const int idx = lane + 64 * q;
            const float4 vq = ((const float4*)(p.XA + (size_t)row * DM))[idx];
            const float4 gn = ((const float4*)p.in[30])[idx];
            const float4 sh = ((const float4*)(p.mod1 + g * MODW + 3 * DM))[idx];
            const float4 sc = ((const float4*)(p.mod1 + g * MODW + 4 * DM))[idx];
            float4 hv;
            hv.x = vq.x * rs * gn.x * (1.f + sc.x) + sh.x; hv.y = vq.y * rs * gn.y * (1.f + sc.y) + sh.y;
            hv.z = vq.z * rs * gn.z * (1.f + sc.z) + sh.z; hv.w = vq.w * rs * gn.w * (1.f + sc.w) + sh.w;
            uint2 hb; hb.x = cvt_pk_bf16(hv.x, hv.y); hb.y = cvt_pk_bf16(hv.z, hv.w);
            ((uint2*)(p.Hb + (size_t)row * DM))[idx] = hb;
#pragma unroll
            for (int e = 0; e < 8; ++e) { const float4 r = ((const float4*)(rt + e * DM))[idx]; l[e] += hv.x * r.x + hv.y * r.y + hv.z * r.z + hv.w * r.w; }
        }
#pragma unroll
        for (int e = 0; e < 8; ++e) l[e] = wave_sum(l[e]);
        if (lane == 0) {
            int e0 = 0; float v0 = l[0];
#pragma unroll
            for (int e = 1; e < 8; ++e) if (l[e] > v0) { v0 = l[e]; e0 = e; }
            int e1 = -1; float v1 = -3.0e38f;
#pragma unroll
            for (int e = 0; e < 8; ++e) if (e != e0 && l[e] > v1) { v1 = l[e]; e1 = e; }
            const float w1 = 1.f / (1.f + expf(v0 - v1)), w0 = 1.f - w1;
            p.tok_e[row * 2] = e0; p.tok_e[row * 2 + 1] = e1; p.tok_w[row * 2] = w0; p.tok_w[row * 2 + 1] = w1;
        }
    }
    __syncthreads();
}

__device__ __forceinline__ void ph_dispatch_permute(const Params& p, float* lds, int wg, int nwg) {
    int* wtot = (int*)lds;
    int* pairs = wtot + 64;
    const int tid = ptid(), wave = tid >> 6, lane = tid & 63;
    int c[8];
#pragma unroll
    for (int e = 0; e < 8; ++e) c[e] = 0;
    for (int i = 0; i < 16; ++i) { const int tok = tid * 16 + i; const int ea = p.tok_e[tok * 2], eb = p.tok_e[tok * 2 + 1];
#pragma unroll
        for (int e = 0; e < 8; ++e) c[e] += (e == ea) + (e == eb); }
    int inc[8];
#pragma unroll
    for (int e = 0; e < 8; ++e) { int v = c[e];
#pragma unroll
        for (int o = 1; o < 64; o <<= 1) { const int t = __shfl_up(v, o); if (lane >= o) v += t; }
        inc[e] = v; }
    if (lane == 63) {
#pragma unroll
        for (int e = 0; e < 8; ++e) wtot[wave * 8 + e] = inc[e]; }
    __syncthreads();
    int pos[8], off[8], tot[8]; int total = 0;
#pragma unroll
    for (int e = 0; e < 8; ++e) { int base = 0, t = 0;
#pragma unroll
        for (int w8 = 0; w8 < 8; ++w8) { const int x = wtot[w8 * 8 + e]; base += (w8 < wave) ? x : 0; t += x; }
        tot[e] = t; off[e] = total; pos[e] = total + base + inc[e] - c[e]; total += ((t + 255) >> 8) << 8; }
    if (wg == 0 && tid == 0) {
#pragma unroll
        for (int e = 0; e < 8; ++e) { p.meta[e * 2] = tot[e]; p.meta[e * 2 + 1] = off[e]; const int nt = (tot[e] + 255) >> 8; for (int t = 0; t < nt; ++t) p.tile_e[(off[e] >> 8) + t] = e; }
        p.meta[16] = total;
    }
    int sl[32];
#pragma unroll
    for (int i = 0; i < 16; ++i) {
        const int tok = tid * 16 + i;
#pragma unroll
        for (int k = 0; k < 2; ++k) { const int e = p.tok_e[tok * 2 + k]; int sv = 0;
#pragma unroll
            for (int q = 0; q < 8; ++q) if (q == e) { sv = pos[q]; pos[q]++; }
            sl[i * 2 + k] = sv; }
    }
    for (int g = wg; g < NL / 32; g += nwg) {
        __syncthreads();
        if ((tid >> 1) == g) {
#pragma unroll
            for (int i = 0; i < 16; ++i)
#pragma unroll
                for (int k = 0; k < 2; ++k) { const int tok = tid * 16 + i, idx = (tid & 1) * 32 + i * 2 + k; pairs[idx * 2] = tok; pairs[idx * 2 + 1] = sl[i * 2 + k]; p.tok_slot[tok * 2 + k] = sl[i * 2 + k]; }
        }
        __syncthreads();
        const int half = tid >> 8, t4 = tid & 255;
        for (int q = half; q < 64; q += 8) {
            const int tk0 = pairs[q * 2], sv0 = pairs[q * 2 + 1], tk1 = pairs[q * 2 + 4], sv1 = pairs[q * 2 + 5], tk2 = pairs[q * 2 + 8], sv2 = pairs[q * 2 + 9], tk3 = pairs[q * 2 + 12], sv3 = pairs[q * 2 + 13];
            const uint4 r0 = ((const uint4*)(p.Hb + (size_t)tk0 * DM))[t4], r1 = ((const uint4*)(p.Hb + (size_t)tk1 * DM))[t4], r2 = ((const uint4*)(p.Hb + (size_t)tk2 * DM))[t4], r3 = ((const uint4*)(p.Hb + (size_t)tk3 * DM))[t4];
            ((uint4*)(p.Xp + (size_t)sv0 * DM))[t4] = r0; ((uint4*)(p.Xp + (size_t)sv1 * DM))[t4] = r1; ((uint4*)(p.Xp + (size_t)sv2 * DM))[t4] = r2; ((uint4*)(p.Xp + (size_t)sv3 * DM))[t4] = r3;
        }
    }
    {
        const int half = tid >> 8, t4 = tid & 255; int idx = 0;
#pragma unroll
        for (int e = 0; e < 8; ++e) { const int s0 = off[e] + tot[e], s1 = off[e] + (((tot[e] + 255) >> 8) << 8);
            for (int sv = s0 + half; sv < s1; sv += 2) { if (((idx + sv - s0) >> 1) % nwg == wg) ((uint4*)(p.Xp + (size_t)sv * DM))[t4] = make_uint4(0u, 0u, 0u, 0u); }
            idx += s1 - s0; }
    }
}

__device__ __forceinline__ void moe_tail_split(int ntm, int G, int& nfull, int& ntail, int& KS) {
    const int T = ntm * (DM / 256); nfull = (T / G) * G; ntail = T - nfull; KS = ntail == 0 ? 1 : (ntail * 4 <= G ? 4 : (ntail * 2 <= G ? 2 : 1));
    if (KS == 1) { nfull = T; ntail = 0; }
}
__device__ __forceinline__ float4 moe_fetch(const Params& p, int slot, int tid, int ntm, int nfull, int ntail, int KS) {
    const int pm = slot >> 8, pn = tid >> 6, L = pn * ntm + pm;
    if (L < nfull) { const uint2 r = ((const uint2*)(p.YE + (size_t)slot * DM))[tid]; return make_float4(__uint_as_float(r.x << 16), __uint_as_float(r.x & 0xffff0000u), __uint_as_float(r.y << 16), __uint_as_float(r.y & 0xffff0000u)); }
    const int t = L - nfull; float4 a = make_float4(0.f, 0.f, 0.f, 0.f);
    for (int ks = 0; ks < KS; ++ks) { const float4 q = *(const float4*)(p.YEP + (size_t)(ks * ntail + t) * 65536 + (slot & 255) * 256 + (tid & 63) * 4); a.x += q.x; a.y += q.y; a.z += q.z; a.w += q.w; }
    return a;
}
__device__ __forceinline__ void ph_combine(const Params& p, int wg, int nwg) {
    const int tid = ptid(), wave = tid >> 6, lane = tid & 63;
    const int ntm = p.meta[16] >> 8; int nfull, ntail, KS; moe_tail_split(ntm, nwg, nfull, ntail, KS);
    for (int row = wg * 8 + wave; row < NL; row += nwg * 8) {
        const int s0 = p.tok_slot[row * 2], s1 = p.tok_slot[row * 2 + 1];
        const float w0 = p.tok_w[row * 2], w1 = p.tok_w[row * 2 + 1];
#pragma unroll 4
        for (int q = 0; q < 8; ++q) {
            const int idx = lane + 64 * q;
            const float4 x = ((const float4*)(p.XA + (size_t)row * DM))[idx];
            const float4 g = ((const float4*)(p.mod1 + (row / TL) * MODW + 5 * DM))[idx];
            const float4 a = moe_fetch(p, s0, idx, ntm, nfull, ntail, KS), c = moe_fetch(p, s1, idx, ntm, nfull, ntail, KS);
            float4 o;
            o.x = x.x + g.x * (w0 * a.x + w1 * c.x); o.y = x.y + g.y * (w0 * a.y + w1 * c.y);
            o.z = x.z + g.z * (w0 * a.z + w1 * c.z); o.w = x.w + g.w * (w0 * a.w + w1 * c.w);
            ((float4*)(p.out + (size_t)row * DM))[idx] = o;
        }
    }
}

#define GEMM_STATIC(Aptr, Bptr, Mrows, Ncols, Kdim, EPI) do { pg8::Gemm g_{Aptr, Bptr, Kdim, Kdim}; pg8::StaticOrder S_; S_.init(Mrows, Ncols, nwg, wg); \
    pg8::gemm_phase<decltype(EPI), pg8::StaticOrder, true, true>(ldsb, g_, S_, EPI); } while (0)

__global__ void __launch_bounds__(NTHR, 2) k_all(Params p) {
    extern __shared__ __attribute__((aligned(16))) unsigned char dyn_lds[];
    float* lds = (float*)dyn_lds;
    PG8_LAS unsigned char* ldsb = (PG8_LAS unsigned char*)dyn_lds;
    volatile LAS unsigned* xbw = (volatile LAS unsigned*)(dyn_lds + 131072);
    if (threadIdx.x < 4) xbw[threadIdx.x] = 0u;
    if (threadIdx.x == 64) ct_table_init(p, (unsigned long long*)(dyn_lds + CTTAB_OFF));
    __syncthreads();
    XcdBarrier bar = xcd_barrier_post(p.bar, xbw);
    const int wg = blockIdx.x, nwg = gridDim.x;
#ifndef PROBE
#define PROBE 0
#endif
#define RUN(grp, ...) do { for (int rep_ = 0; rep_ < ((PROBE == (grp)) ? 2 : 1); ++rep_) { __VA_ARGS__ } } while (0)
    const int ct_rest = CT_TOTAL - CT_L0 - RW_NBLK * nwg * 4 - GLA_NCH * nwg * 8;
    const int ct_split = CT_L0 + (ct_rest > 0 ? ct_rest : 0);
    RUN(2, ph_mod(p, lds, wg, nwg); __syncthreads(); ph_lora_wt(p, wg, nwg); ph_convert(p, lds, wg, nwg, ct_split);); xcd_barrier(bar);
    RUN(5, ph_norm(p.in[0], p.in[2], p.in[6], p.mod0, 0, 1, p.Hb, NT, lds, wg, nwg);); xcd_barrier(bar);
    RUN(1, { EpiBf16Store E{p.P, L0LD, nullptr, 0, 0}; GEMM_STATIC(p.Hb, p.Wt_in0, NT, L0LD, DM, E); }); xcd_barrier(bar);
    RUN(3, ph_rwprep(p, lds, wg, nwg); ph_naprep(p, lds, wg, nwg);); xcd_barrier(bar);
    RUN(3, ph_rwscan(p, lds, wg, nwg, ct_split); ph_naattn(p, lds, wg, nwg);); xcd_barrier(bar);
    RUN(3, ph_rwout(p, wg, nwg);); xcd_barrier(bar);
    RUN(1, { EpiResGate E{p.in[0], p.in[2], p.mod0 + 2 * DM, p.XA}; GEMM_STATIC(p.MIXb, p.Wt_out0, NL, DM, DM, E); __syncthreads();
      pg8::Gemm g2{p.MIXb, p.Wt_out0, 256, DM}; pg8::CtxSplitOrder S2{DM / 256, 8, 256, nwg, wg}; EpiCtxPartial E2{p.PC, 256};
      pg8::gemm_phase<EpiCtxPartial, pg8::CtxSplitOrder, true, true>(ldsb, g2, S2, E2); }); xcd_barrier(bar);
    RUN(5, ph_norm(p.XA, p.in[2], p.in[7], p.mod0, 3, 4, p.Hb, NT, lds, wg, nwg, p.PC, 8, p.mod0 + 2 * MODW + 2 * DM, p.XA);); xcd_barrier(bar);
    RUN(1, { EpiSwiglu E{p.H1b, FFN, 0}; GEMM_STATIC(p.Hb, p.Wt_ffnup, NT, 2 * FFN, DM, E); }); xcd_barrier(bar);
    RUN(1, { EpiResGate E{p.XA, p.XA + (size_t)NL * DM, p.mod0 + 5 * DM, p.XB}; GEMM_STATIC(p.H1b, p.Wt_ffndn, NL, DM, FFN, E); __syncthreads();
      pg8::Gemm g2{p.H1b, p.Wt_ffndn, 512, FFN}; pg8::CtxSplitOrder S2{DM / 256, 11, 512, nwg, wg}; EpiCtxPartial E2{p.PC, 512};
      pg8::gemm_phase<EpiCtxPartial, pg8::CtxSplitOrder, true, true>(ldsb, g2, S2, E2); }); xcd_barrier(bar);
    RUN(5, ph_norm(p.XB, p.XA + (size_t)NL * DM, p.in[29], p.mod1, 0, 1, p.Hb, NT, lds, wg, nwg, p.PC, 11, p.mod0 + 2 * MODW + 5 * DM, nullptr);); xcd_barrier(bar);
    RUN(1, { EpiBf16Store E{p.P, L1LD, p.LRs, 12, 0}; GEMM_STATIC(p.Hb, p.Wt_in1, NT, L1LD, DM, E); }); xcd_barrier(bar);
    RUN(4, ph_glaprep(p, lds, wg, nwg);); xcd_barrier(bar);
    RUN(4, ph_glascan(p, lds, wg, nwg, ct_split + RW_NBLK * nwg * 4);); xcd_barrier(bar);
    RUN(4, ph_glaout(p, lds, wg, nwg);); xcd_barrier(bar);
    RUN(1, { EpiResGate E{p.XB, p.XB + (size_t)NL * DM, p.mod1 + 2 * DM, p.XA}; GEMM_STATIC(p.MIXb, p.Wt_out1, NL, DM, DM, E); }); xcd_barrier(bar);
    RUN(5, ph_route(p, lds, wg, nwg);); xcd_barrier(bar);
    RUN(5, ph_dispatch_permute(p, lds, wg, nwg);); xcd_barrier(bar);
    RUN(1, { pg8::Gemm g{p.Xp, p.Wt_expup, DM, DM}; pg8::GroupedOrder S{p.meta[16] >> 8, 2 * EXD / 256, nwg, wg, p.tile_e}; EpiSwiglu E{p.H1Eb, EXD, 2 * EXD / 256};
      pg8::gemm_phase<EpiSwiglu, pg8::GroupedOrder, true, true>(ldsb, g, S, E); }); xcd_barrier(bar);
    RUN(1, { const int ntm = p.meta[16] >> 8; int nfull, ntail, KS; moe_tail_split(ntm, nwg, nfull, ntail, KS);
      { pg8::Gemm g{p.H1Eb, p.Wt_expdn, EXD, EXD}; pg8::GroupedRange S{ntm, DM / 256, 0, nfull, nwg, wg, p.tile_e}; EpiBf16Store E{p.YE, DM, nullptr, 0, DM / 256};
        pg8::gemm_phase<EpiBf16Store, pg8::GroupedRange, true, true>(ldsb, g, S, E); }
      __syncthreads();
      { pg8::Gemm g{p.H1Eb, p.Wt_expdn, EXD / KS, EXD}; pg8::GroupedTail S{ntm, DM / 256, nfull, ntail, KS, EXD / KS, nwg, wg, p.tile_e}; EpiTailPartial E{p.YEP, ntm, DM / 256, nfull, ntail, EXD / KS};
        pg8::gemm_phase<EpiTailPartial, pg8::GroupedTail, true, true>(ldsb, g, S, E); } }); xcd_barrier(bar);
    RUN(5, ph_combine(p, wg, nwg););
}

extern "C" void kernel_launch(void* const* d_in, const int* in_sizes, int n_in, void* d_out, int out_size, void* d_ws, size_t ws_size, hipStream_t stream) {
    (void)in_sizes; (void)out_size;
    if (n_in != 40) return;
    Params p;
    memset(&p, 0, sizeof(p));
    for (int i = 0; i < 40; ++i) p.in[i] = (const float*)d_in[i];
    p.out = (float*)d_out;
    char* w = (char*)d_ws;
    size_t o = 0;
    auto take = [&](size_t bytes) { char* r = w + o; o += (bytes + 255) & ~(size_t)255; return (void*)r; };
    p.bar = (unsigned*)take(XCD_BAR_WORDS * 4);
    p.mod0 = (float*)take(3 * MODW * 4); p.mod1 = (float*)take(3 * MODW * 4);
    p.tok_e = (int*)take(NL * 2 * 4); p.tok_w = (float*)take(NL * 2 * 4); p.meta = (int*)take(256); p.slot_token = (int*)take(MAXSLOT * 4); p.tok_slot = (int*)take(NL * 2 * 4);
    p.LRs = (float*)take((size_t)NT * 256 * 4); p.tile_e = (int*)take(128 * 4); p.WTd = (bf16_t*)take(2 * 1024 * 64 * 2); p.WTi = (bf16_t*)take(2 * 1024 * 64 * 2); p.WTg = (bf16_t*)take(1024 * 128 * 2);
    p.Wt_in0 = (bf16_t*)take((size_t)L0LD * DM * 2); p.Wt_out0 = (bf16_t*)take((size_t)DM * DM * 2); p.Wt_ffnup = (bf16_t*)take((size_t)2 * FFN * DM * 2);
    p.Wt_ffndn = (bf16_t*)take((size_t)DM * FFN * 2); p.Wt_in1 = (bf16_t*)take((size_t)L1LD * DM * 2); p.Wt_out1 = (bf16_t*)take((size_t)DM * DM * 2);
    p.Wt_expup = (bf16_t*)take((size_t)NEXP * 2 * EXD * DM * 2); p.Wt_expdn = (bf16_t*)take((size_t)NEXP * DM * EXD * 2);
    p.Hb = (bf16_t*)take((size_t)NT * DM * 2); p.MIXb = (bf16_t*)take((size_t)NT * DM * 2);
    p.XA = (float*)take((size_t)NT * DM * 4); p.XB = (float*)take((size_t)NT * DM * 4);
    p.P = (bf16_t*)take((size_t)NT * L0LD * 4); p.H1b = (bf16_t*)take((size_t)NT * FFN * 2);
    p.H1Eb = (bf16_t*)p.P;
    const size_t mark = o;
    p.PC = (float*)(w + mark);
    p.R = (bf16_t*)take((size_t)NT * 2048); p.V = (float*)take((size_t)NT * 4096); p.KK = (bf16_t*)take((size_t)NT * 2048); p.G = (float*)take((size_t)NT * 4096);
    for (int d = 0; d < 2; ++d) { p.W[d] = (float*)take((size_t)NT * 4096); p.KD[d] = (bf16_t*)take((size_t)NT * 2048); p.NB[d] = (bf16_t*)take((size_t)NT * 2048); p.Y[d] = (float*)take((size_t)NT * 4096); }
    p.Qb = (bf16_t*)take((size_t)NT * 2048); p.Kb = (bf16_t*)take((size_t)32 * 136 * 2048 * 2); p.VTl = (bf16_t*)take((size_t)32 * 136 * 2048 * 2); p.VTc = p.VTl; p.QM = (float*)take((size_t)NT * 16 * 4);
    const size_t end0 = o;
    o = mark;
    p.O[0] = (float*)take((size_t)NL * DM * 4); p.O[1] = (float*)take((size_t)NL * DM * 4);
    p.QT = (bf16_t*)take((size_t)16 * GLA_NCH * 64 * 256 * 2); p.KHT = (bf16_t*)take((size_t)16 * GLA_NCH * 256 * 64 * 2); p.AM = (bf16_t*)take((size_t)16 * GLA_NCH * 64 * 64 * 2);
    p.VT = (bf16_t*)take((size_t)16 * GLA_NCH * 512 * 64 * 2); p.DEC = (float*)take((size_t)16 * GLA_NCH * 256 * 4);
    const size_t end1a = o;
    o = mark;
    p.YE = (bf16_t*)take((size_t)MAXSLOT * DM * 2);
    p.Xp = (bf16_t*)take((size_t)MAXSLOT * DM * 2);
    p.YEP = (float*)take((size_t)256 * 65536 * 4);
    if (o < end1a) o = end1a;
    const size_t end1 = o;
    const size_t need = end0 > end1 ? end0 : end1;
    static int grid = 0;
    if (!grid) {
        int dev = 0, cus = 0, per_cu = 0;
        grid = -1;
        if (need <= ws_size && hipGetDevice(&dev) == hipSuccess && hipDeviceGetAttribute(&cus, hipDeviceAttributeMultiprocessorCount, dev) == hipSuccess &&
            hipFuncSetAttribute((const void*)k_all, hipFuncAttributeMaxDynamicSharedMemorySize, LDS_BYTES) == hipSuccess &&
            hipOccupancyMaxActiveBlocksPerMultiprocessor(&per_cu, (const void*)k_all, NTHR, LDS_BYTES) == hipSuccess && per_cu >= 1) grid = cus < 256 ? cus : 256;
    }
    if (grid < 0) return;
    (void)hipMemsetAsync(p.bar, 0, (size_t)((char*)(p.mod1 + 3 * MODW) - (char*)p.bar), stream);
    hipLaunchKernelGGL(k_all, dim3(grid), dim3(NTHR), LDS_BYTES, stream, p);
}
```
